# Optimizing an MI355X kernel written in HIP

```python
import jax, jax.numpy as jnp
from jax import lax
import numpy as np

D_MODEL = 1024
BATCH = 2
SEQ = 8192
DEPTH = 2
DEC_BATCH = 32
DEC_SEQ = 8
PAST_LEN = 16384
PAGE_SIZE = 128

D_CONV = D_MODEL // 4
CONV_W = 31
CONV_HIST = CONV_W - 1
HEAD_DIM = 64
D_ATTN = D_MODEL // 2
N_HEADS = D_ATTN // HEAD_DIM
N_KV_HEADS = 2
KV_DIM = N_KV_HEADS * HEAD_DIM
GROUP = N_HEADS // N_KV_HEADS
IDX_HEADS = 8
IDX_DIM = 64
TOPK_MAX = 256
Q_BLOCK = 128
D_POOL = D_MODEL // 4
POOL_WINDOWS = (2, 4, 8, 16)
N_POOL_GROUPS = len(POOL_WINDOWS)
POOL_GC = D_POOL // N_POOL_GROUPS
POOL_HIST = max(POOL_WINDOWS) - 1
N_BRANCH = 3
D_FF = 4 * D_MODEL
ROPE_THETA = 10000.0
RMS_EPS = 1e-6
LN_EPS = 1e-5
IN_SPLITS = (D_CONV, D_CONV, D_ATTN, KV_DIM, KV_DIM, IDX_HEADS * IDX_DIM, IDX_DIM, IDX_HEADS, D_POOL, N_BRANCH * D_MODEL)
D_IN = sum(IN_SPLITS)
SPLIT_AT = tuple(int(i) for i in np.cumsum(IN_SPLITS)[:-1])

kernel_name = "hybrid_gated_conv_dsa_pool_decoder_step"

F32 = jnp.float32


def rmsnorm(x, g):
    xf = x.astype(F32)
    y = xf * lax.rsqrt(jnp.mean(xf * xf, axis=-1, keepdims=True) + RMS_EPS)
    return (y * g.astype(F32)).astype(x.dtype)


def layernorm(x, g, b):
    xf = x.astype(F32)
    mu = jnp.mean(xf, axis=-1, keepdims=True)
    var = jnp.mean(jnp.square(xf - mu), axis=-1, keepdims=True)
    y = (xf - mu) * lax.rsqrt(var + LN_EPS)
    return (y * g.astype(F32) + b.astype(F32)).astype(x.dtype)


def rope(x, pos):
    half = x.shape[-1] // 2
    inv = ROPE_THETA ** (-jnp.arange(half, dtype=F32) / half)
    ang = pos.astype(F32)[:, None] * inv[None, :]
    cos = jnp.cos(ang)[None, :, None, :]
    sin = jnp.sin(ang)[None, :, None, :]
    xf = x.astype(F32)
    x1, x2 = xf[..., :half], xf[..., half:]
    return jnp.concatenate([x1 * cos - x2 * sin, x2 * cos + x1 * sin], axis=-1).astype(x.dtype)


def index_scores(qi, wi, ki, q_pos, k_pos):
    s = jnp.einsum('bthd,bsd->bths', qi, ki).astype(F32)
    s = jnp.einsum('bths,bth->bts', jax.nn.relu(s), wi.astype(F32))
    causal = k_pos[None, :] <= q_pos[:, None]
    return jnp.where(causal[None], s, -jnp.inf)


def sparse_attend(q, k_sel, v_sel, valid):
    B, T = q.shape[:2]
    qg = q.reshape(B, T, N_KV_HEADS, GROUP, HEAD_DIM)
    s = jnp.einsum('btngd,btknd->btngk', qg, k_sel).astype(F32) * (HEAD_DIM ** -0.5)
    s = jnp.where(valid[:, :, None, None, :], s, -jnp.inf)
    p = jax.nn.softmax(s, axis=-1).astype(v_sel.dtype)
    o = jnp.einsum('btngk,btknd->btngd', p, v_sel)
    return o.reshape(B, T, N_HEADS * HEAD_DIM)


def prompt_attend(q, k, v, qi, ki, wi, pos):
    B, T = q.shape[:2]
    nb = T // Q_BLOCK
    top = min(TOPK_MAX, T // 4)
    k_pos = jnp.arange(T)
    bi = jnp.arange(B)[:, None, None]

    def block(args):
        qb, qib, wib, pb = args
        s = index_scores(qib, wib, ki, pb, k_pos)
        _, idx = lax.top_k(s, top)
        valid = idx <= pb[None, :, None]
        return sparse_attend(qb, k[bi, idx], v[bi, idx], valid)

    def to_blocks(t):
        return jnp.moveaxis(t.reshape((B, nb, Q_BLOCK) + t.shape[2:]), 1, 0)

    out = lax.map(block, (to_blocks(q), to_blocks(qi), to_blocks(wi), pos.reshape(nb, Q_BLOCK)))
    return jnp.moveaxis(out, 0, 1).reshape(B, T, D_ATTN)


def make_sample_attend(ck, cv, cki, page_table):
    def attend(q, k, v, qi, ki, wi, pos):
        B, T = q.shape[:2]
        L = PAST_LEN + T
        top = min(TOPK_MAX, L // 4)
        ki_past = cki[page_table].reshape(B, PAST_LEN, IDX_DIM)
        ki_all = jnp.concatenate([ki_past, ki], axis=1)
        s = index_scores(qi, wi, ki_all, pos, jnp.arange(L))
        _, idx = lax.top_k(s, top)
        bi = jnp.arange(B)[:, None, None]
        in_past = (idx < PAST_LEN)[..., None, None]
        pidx = jnp.minimum(idx, PAST_LEN - 1)
        phys = page_table[bi, pidx // PAGE_SIZE]
        off = pidx % PAGE_SIZE
        nidx = jnp.clip(idx - PAST_LEN, 0, T - 1)
        k_sel = jnp.where(in_past, ck[phys, off], k[bi, nidx])
        v_sel = jnp.where(in_past, cv[phys, off], v[bi, nidx])
        valid = idx <= pos[None, :, None]
        return sparse_attend(q, k_sel, v_sel, valid)
    return attend


def depthwise_causal_conv(ext, w, b):
    y = lax.conv_general_dilated(ext, w[:, None, :].astype(ext.dtype), window_strides=(1,), padding='VALID',
                                 dimension_numbers=('NWC', 'WIO', 'NWC'), feature_group_count=ext.shape[-1])
    return y + b


def pool_mix(xc, hist, pos, pool_w, pool_scale):
    B, T, _ = xc.shape
    ext = jnp.concatenate([hist, xc], axis=1).astype(F32)
    cs = jnp.concatenate([jnp.zeros((B, 1, D_POOL), F32), jnp.cumsum(ext, axis=1)], axis=1)
    end = cs[:, POOL_HIST + 1:]
    means = []
    for g, w in enumerate(POOL_WINDOWS):
        sl = slice(g * POOL_GC, (g + 1) * POOL_GC)
        start = cs[:, POOL_HIST + 1 - w: POOL_HIST + 1 - w + T, sl]
        cnt = jnp.minimum(pos + 1, w).astype(F32)[None, :, None]
        means.append((end[..., sl] - start) / cnt)
    d = (jnp.concatenate(means, axis=-1) - xc.astype(F32)).astype(xc.dtype)
    d = d.reshape(B, T, N_POOL_GROUPS, POOL_GC)
    y = jnp.einsum('btgc,gcd->btgd', d, pool_w).reshape(B, T, D_POOL)
    return y * pool_scale


def mixer(h, pos, conv_hist, pool_hist, attend, w_in, conv_w, conv_b, conv_ln_g, conv_ln_b,
          w_conv_out, w_attn_out, pool_w, pool_scale, w_pool_out, w_out):
    B, T, _ = h.shape
    z = h @ w_in
    a_in, a_gate, q, k, v, qi, ki, wi, xc, gates = jnp.split(z, SPLIT_AT, axis=-1)
    u = a_in * jax.nn.sigmoid(a_gate)
    ext = jnp.concatenate([conv_hist, u], axis=1)
    c = layernorm(depthwise_causal_conv(ext, conv_w, conv_b), conv_ln_g, conv_ln_b)
    y_a = (c * jax.nn.sigmoid(c)) @ w_conv_out
    new_conv = ext[:, -CONV_HIST:]
    q = rope(q.reshape(B, T, N_HEADS, HEAD_DIM), pos)
    k = rope(k.reshape(B, T, N_KV_HEADS, HEAD_DIM), pos)
    v = v.reshape(B, T, N_KV_HEADS, HEAD_DIM)
    qi = rope(qi.reshape(B, T, IDX_HEADS, IDX_DIM), pos)
    ki = rope(ki[:, :, None, :], pos)[:, :, 0, :]
    wi = wi * (IDX_HEADS ** -0.5 * IDX_DIM ** -0.5)
    y_b = attend(q, k, v, qi, ki, wi, pos) @ w_attn_out
    y_c = pool_mix(xc, pool_hist, pos, pool_w, pool_scale) @ w_pool_out
    new_pool = jnp.concatenate([pool_hist, xc], axis=1)[:, -POOL_HIST:]
    g_a, g_b, g_c = jnp.split(jax.nn.sigmoid(gates), N_BRANCH, axis=-1)
    out = (g_a * y_a + g_b * y_b + g_c * y_c) @ w_out
    return out, (k, v, ki, new_conv, new_pool)


def ffn(h, w1, w2):
    r = jax.nn.relu(h @ w1)
    return (r * r) @ w2


def setup_inputs(seed: int = 0) -> dict:
    key = jax.random.key(seed)
    ks = jax.random.split(key, 24)
    n_pages = PAST_LEN // PAGE_SIZE
    used = DEC_BATCH * n_pages
    n_pool = used + max(1, used // 4)

    def nrm(k, shape, scale):
        return jax.random.normal(k, shape, F32) * scale

    page_table = jax.random.permutation(ks[7], n_pool)[:used].reshape(DEC_BATCH, n_pages).astype(jnp.int32)
    return {
        "x_prompt": nrm(ks[0], (BATCH, SEQ, D_MODEL), 1.0),
        "x_sample": nrm(ks[1], (DEC_BATCH, DEC_SEQ, D_MODEL), 1.0),
        "cache_k": nrm(ks[2], (DEPTH, n_pool, PAGE_SIZE, N_KV_HEADS, HEAD_DIM), 1.0),
        "cache_v": nrm(ks[3], (DEPTH, n_pool, PAGE_SIZE, N_KV_HEADS, HEAD_DIM), 1.0),
        "cache_kidx": nrm(ks[4], (DEPTH, n_pool, PAGE_SIZE, IDX_DIM), 1.0),
        "state_conv": nrm(ks[5], (DEPTH, DEC_BATCH, CONV_HIST, D_CONV), 0.5),
        "state_pool": nrm(ks[6], (DEPTH, DEC_BATCH, POOL_HIST, D_POOL), 1.0),
        "page_table": page_table,
        "g_mix": 1.0 + nrm(ks[8], (DEPTH, D_MODEL), 0.1),
        "w_in": nrm(ks[9], (DEPTH, D_MODEL, D_IN), D_MODEL ** -0.5),
        "conv_w": nrm(ks[10], (DEPTH, CONV_W, D_CONV), CONV_W ** -0.5),
        "conv_b": nrm(ks[11], (DEPTH, D_CONV), 0.02),
        "conv_ln_g": 1.0 + nrm(ks[12], (DEPTH, D_CONV), 0.1),
        "conv_ln_b": nrm(ks[13], (DEPTH, D_CONV), 0.02),
        "w_conv_out": nrm(ks[14], (DEPTH, D_CONV, D_MODEL), D_CONV ** -0.5),
        "w_attn_out": nrm(ks[15], (DEPTH, D_ATTN, D_MODEL), D_ATTN ** -0.5),
        "pool_w": nrm(ks[16], (DEPTH, N_POOL_GROUPS, POOL_GC, POOL_GC), POOL_GC ** -0.5),
        "pool_scale": 1.0 + nrm(ks[17], (DEPTH, D_POOL), 0.1),
        "w_pool_out": nrm(ks[18], (DEPTH, D_POOL, D_MODEL), D_POOL ** -0.5),
        "w_out": nrm(ks[19], (DEPTH, D_MODEL, D_MODEL), D_MODEL ** -0.5),
        "g_ffn": 1.0 + nrm(ks[20], (DEPTH, D_MODEL), 0.1),
        "w_ff1": nrm(ks[21], (DEPTH, D_MODEL, D_FF), D_MODEL ** -0.5),
        "w_ff2": nrm(ks[22], (DEPTH, D_FF, D_MODEL), D_FF ** -0.5),
        "g_final": 1.0 + nrm(ks[23], (D_MODEL,), 0.1),
    }


def reference(x_prompt, x_sample, cache_k, cache_v, cache_kidx, state_conv, state_pool, page_table,
              g_mix, w_in, conv_w, conv_b, conv_ln_g, conv_ln_b, w_conv_out, w_attn_out,
              pool_w, pool_scale, w_pool_out, w_out, g_ffn, w_ff1, w_ff2, g_final):
    xp, xs = x_prompt, x_sample
    B, T = xp.shape[:2]
    pos_p = jnp.arange(T)
    pos_s = PAST_LEN + jnp.arange(xs.shape[1])
    conv_hist_p = jnp.zeros((B, CONV_HIST, D_CONV), xp.dtype)
    pool_hist_p = jnp.zeros((B, POOL_HIST, D_POOL), xp.dtype)
    st_p = [[] for _ in range(5)]
    st_s = [[] for _ in range(5)]
    for l in range(DEPTH):
        lw = (w_in[l], conv_w[l], conv_b[l], conv_ln_g[l], conv_ln_b[l], w_conv_out[l], w_attn_out[l],
              pool_w[l], pool_scale[l], w_pool_out[l], w_out[l])
        m_p, new_p = mixer(rmsnorm(xp, g_mix[l]), pos_p, conv_hist_p, pool_hist_p, prompt_attend, *lw)
        xp = xp + m_p
        xp = xp + ffn(rmsnorm(xp, g_ffn[l]), w_ff1[l], w_ff2[l])
        attend_s = make_sample_attend(cache_k[l], cache_v[l], cache_kidx[l], page_table)
        m_s, new_s = mixer(rmsnorm(xs, g_mix[l]), pos_s, state_conv[l], state_pool[l], attend_s, *lw)
        xs = xs + m_s
        xs = xs + ffn(rmsnorm(xs, g_ffn[l]), w_ff1[l], w_ff2[l])
        for i in range(5):
            st_p[i].append(new_p[i])
            st_s[i].append(new_s[i])
    y_prompt = rmsnorm(xp, g_final)
    y_sample = rmsnorm(xs, g_final)
    sp = [jnp.stack(a, axis=0) for a in st_p]
    ss = [jnp.stack(a, axis=0) for a in st_s]
    return (y_prompt, y_sample, sp[0], sp[1], sp[2], sp[3], sp[4], ss[0], ss[1], ss[2], ss[3], ss[4])
```

```cpp
#include <hip/hip_runtime.h>
#include <cstdio>
#include <cstdint>

constexpr int DM = 1024, NB = 2, T = 8192, DEPTH = 2, SB = 32, ST = 8, PAST = 16384, PAGE = 128, NPAGES = PAST / PAGE;
constexpr int NPOOL = 5120;
constexpr int DCONV = 256, CONVW = 31, CHIST = 30, HD = 64, DATT = 512, NH = 8, NKV = 2, KVD = 128, IH = 8, ID = 64, TOPK = 256;
constexpr int DPOOL = 256, PHIST = 15, DFF = 4096, DIN = 5192;
constexpr int MP = NB * T, MS = SB * ST, M = MP + MS;
constexpr int C_AIN = 0, C_AGATE = 256, C_Q = 512, C_K = 1024, C_V = 1152, C_QI = 1280, C_KI = 1792, C_WI = 1856, C_XC = 1864, C_G = 2120;
constexpr int SCS_LD = 16896;
constexpr float RMS_EPS = 1e-6f, LN_EPS = 1e-5f;
constexpr float WI_SCALE = 0.04419417382415922f;

constexpr size_t O_YP = 0, O_YS = O_YP + (size_t)MP * DM, O_KP = O_YS + (size_t)MS * DM, O_VP = O_KP + (size_t)DEPTH * MP * KVD,
                 O_KIP = O_VP + (size_t)DEPTH * MP * KVD, O_CP = O_KIP + (size_t)DEPTH * MP * ID, O_PP = O_CP + (size_t)DEPTH * NB * CHIST * DCONV,
                 O_KS = O_PP + (size_t)DEPTH * NB * PHIST * DPOOL, O_VS = O_KS + (size_t)DEPTH * MS * KVD, O_KIS = O_VS + (size_t)DEPTH * MS * KVD,
                 O_CS = O_KIS + (size_t)DEPTH * MS * ID, O_PS = O_CS + (size_t)DEPTH * SB * CHIST * DCONV, O_END = O_PS + (size_t)DEPTH * SB * PHIST * DPOOL;

constexpr size_t MiB = 1u << 20;
constexpr size_t WS_ROPE = 64 * MiB;
constexpr size_t WS_X = 80 * MiB;
constexpr size_t WS_H = 160 * MiB;
constexpr size_t WS_U = 200 * MiB;
constexpr size_t WS_XC = 220 * MiB;
constexpr size_t WS_QB = 240 * MiB;
constexpr size_t WS_KV = 260 * MiB;
constexpr size_t WS_QI = 272 * MiB;
constexpr size_t WS_KI = 292 * MiB;
constexpr size_t WS_WI = 296 * MiB;
constexpr size_t WS_G = 300 * MiB;
constexpr size_t WS_CA = 404 * MiB;
constexpr size_t WS_PA = 414 * MiB;
constexpr size_t WS_AT = 424 * MiB;
constexpr size_t WS_MB = 444 * MiB;
constexpr size_t WS_R = 480 * MiB;
constexpr size_t WS_SC = 620 * MiB;
constexpr size_t WS_SCS = 880 * MiB;
constexpr size_t WS_TMP = 900 * MiB;
constexpr size_t WS_TMP2 = 1260 * MiB;
constexpr size_t WS_END = 1500 * MiB;

typedef unsigned short bf16_t;
__device__ __forceinline__ float bf2f(bf16_t v) { return __builtin_bit_cast(float, (unsigned)v << 16); }
__device__ __forceinline__ bf16_t f2bf(float f) { unsigned u = __builtin_bit_cast(unsigned, f); return (bf16_t)((u + 0x7fffu + ((u >> 16) & 1u)) >> 16); }
__device__ __forceinline__ float sigmoidf_(float x) { return 1.f / (1.f + __expf(-x)); }

__device__ __forceinline__ int rope_row(int m) { return m < MP ? (m & (T - 1)) : T + ((m - MP) & (ST - 1)); }

struct Bufs { float* X; bf16_t* H; float* U; float* XC; bf16_t* QB; bf16_t* KV; bf16_t* QI; bf16_t* KI; float* WI; _Float16* G; bf16_t* CA; bf16_t* PA; bf16_t* AT; bf16_t* MB; bf16_t* R;
              _Float16* SC; _Float16* SCS; const float* rc; const float* rs; float* out; };

namespace pg8 {
#define PG8_LAS __attribute__((address_space(3)))
typedef unsigned short bf16_t;
typedef short bf16x8 __attribute__((ext_vector_type(8)));
typedef float f32x4 __attribute__((ext_vector_type(4)));
typedef unsigned u32x4 __attribute__((ext_vector_type(4)));
constexpr int BM = 256, BK = 64, HALF = 128, HTB = HALF * BK * 2  , STAGE_BYTES = 8 * HTB, NXCD = 8, WGM = 8;

__host__ __device__ __forceinline__ int lds_byte(int r, int c) { const int st = (r >> 4) * 2 + (c >> 5), rr = r & 15, cc = c & 31, ob = rr * 64 + cc * 2; return st * 1024 + (ob ^ (((ob >> 9) & 1) << 5)); }
__host__ __device__ __forceinline__ void stage_rc(int b, int& R, int& C) { const int st = b / 1024, sb = b % 1024, swz = sb ^ (((sb >> 9) & 1) << 5); R = (st >> 1) * 16 + swz / 64; C = (st & 1) * 32 + (swz % 64) / 2; }
__host__ __device__ __forceinline__ int perm32(int rho) { const int n = rho >> 4, i = rho & 15; return 8 * (i >> 2) + 4 * n + (i & 3); }

struct Unit { int pm, pn, idx; };
struct Gemm { const bf16_t* A; const bf16_t* Bt; int M, N, K; };

struct StaticOrder {
    int nM, nN, nwg, G, c;
    __host__ __device__ __forceinline__ void init(int M, int N, int G_, int c_) { nM = M / BM; nN = N / BM; nwg = nM * nN; G = G_; c = c_; }
    __host__ __device__ __forceinline__ bool next(int i, Unit& u) const {
        const long L = (long)i * G + c; if (L >= nwg) return false;
        int wgid = (int)L; { const int q = nwg / NXCD, r = nwg % NXCD, xcd = wgid % NXCD, off = wgid / NXCD; wgid = (xcd < r ? xcd * (q + 1) : r * (q + 1) + (xcd - r) * q) + off; }
        const int nig = WGM * nN, gid = wgid / nig, fm = gid * WGM, gsz = (nM - fm) < WGM ? (nM - fm) : WGM;
        u.pm = fm + ((wgid % nig) % gsz); u.pn = (wgid % nig) / gsz; u.idx = i; return true;
    }
    __device__ __forceinline__ void a_ready(const Unit&) const {}
    __device__ __forceinline__ void done(const Unit&) const {}
};
typedef float f32x2 __attribute__((ext_vector_type(2)));
__device__ __forceinline__ unsigned cvt_pk_bf16(float lo, float hi) { unsigned r; asm volatile("v_cvt_pk_bf16_f32 %0, %1, %2" : "=v"(r) : "v"(lo), "v"(hi)); return r; }
template <class Epi, class Sched, bool ALIGN_EPI = false, bool SP2 = false>
__device__ __forceinline__ void gemm_phase(PG8_LAS unsigned char* lds, const Gemm g, const Sched& S, const Epi& E) {
    int tid = threadIdx.x; asm volatile("" : "+v"(tid));
    const int wid = __builtin_amdgcn_readfirstlane(tid >> 6), lane = tid & 63, wr = wid >> 2, wc = wid & 3, fr = lane & 15, fq = lane >> 4;
    const int K = g.K, nt = K / BK;
    unsigned voffA[2], voffB[2];
#pragma unroll
    for (int i = 0; i < 2; ++i) { int R, C; stage_rc(tid * 16 + i * 8192, R, C); const int Rb = Epi::COLMAP2 ? (64 * (R >> 5) + perm32(R & 31)) : (Epi::PERM ? ((R & ~31) + perm32(R & 31)) : R);
        voffA[i] = (unsigned)(R * K + C) * 2u; voffB[i] = (unsigned)(Rb * K + C) * 2u; }
    const size_t kstep = (size_t)(BK * 2);
    const size_t hstep = (size_t)HALF * K * 2;
    const size_t hstepB = Epi::COLMAP2 ? (size_t)32 * K * 2 : hstep;
    const size_t tstep = 2 * hstep;
    const unsigned ldsw = (unsigned)wid * 1024u;
    const int aoff = lds_byte(wr * 64 + fr, fq * 8), boff = lds_byte(wc * 32 + fr, fq * 8);
#define PG8_SA(b, h) (((b) * 2 + (h)) * HTB)
#define PG8_SB(b, h) ((4 + (b) * 2 + (h)) * HTB)
#define PG8_STAGE(bufoff, gbase, voff) do { _Pragma("unroll") for (int _i = 0; _i < 2; ++_i) \
        __builtin_amdgcn_global_load_lds((const unsigned*)((const char*)(gbase) + (voff)[_i]), (PG8_LAS unsigned*)(lds + (bufoff) + ldsw + _i * 8192), 16, 0, 0); } while (0)
#define PG8_LDA(dst, b, h) do { _Pragma("unroll") for (int m = 0; m < 4; ++m) _Pragma("unroll") for (int k = 0; k < 2; ++k) dst[m][k] = *(const PG8_LAS bf16x8*)(lds + PG8_SA(b, h) + aoff + m * 2048 + k * 1024); } while (0)
#define PG8_LDB(dst, b, h) do { _Pragma("unroll") for (int n = 0; n < 2; ++n) _Pragma("unroll") for (int k = 0; k < 2; ++k) dst[n][k] = *(const PG8_LAS bf16x8*)(lds + PG8_SB(b, h) + boff + n * 2048 + k * 1024); } while (0)
#define PG8_MMA(ai, bj, At, Bt) do { __builtin_amdgcn_s_setprio(1); _Pragma("unroll") for (int m = 0; m < 4; ++m) _Pragma("unroll") for (int n = 0; n < 2; ++n) _Pragma("unroll") for (int k = 0; k < 2; ++k) \
        acc[ai][bj][m][n] = __builtin_amdgcn_mfma_f32_16x16x32_bf16(Bt[n][k], At[m][k], acc[ai][bj][m][n], 0, 0, 0); __builtin_amdgcn_s_setprio(0); } while (0)
#define PG8_WAIT_V(n) asm volatile("s_waitcnt vmcnt(" #n ")" ::: "memory")
#define PG8_WAIT_L(n) asm volatile("s_waitcnt lgkmcnt(" #n ")" ::: "memory")
#define PG8_BAR __builtin_amdgcn_s_barrier()
#define PG8_SCHED __builtin_amdgcn_sched_barrier(0)
    Unit cur, nxt; int ui = 0;
    if (!S.next(0, cur)) return;
    f32x4 acc[2][2][4][2];
#pragma unroll
    for (int a = 0; a < 2; ++a)
#pragma unroll
        for (int b = 0; b < 2; ++b)
#pragma unroll
            for (int m = 0; m < 4; ++m)
#pragma unroll
                for (int n = 0; n < 2; ++n) acc[a][b][m][n] = (f32x4){0.f, 0.f, 0.f, 0.f};
    bf16x8 At[4][2], B0[2][2], B1[2][2];
    const char* cA = (const char*)g.A + (size_t)cur.pm * tstep; const char* cB = (const char*)g.Bt + (size_t)cur.pn * tstep;
    S.a_ready(cur);
    if constexpr (SP2) {
        PG8_STAGE(PG8_SB(0, 0), cB, voffB); PG8_STAGE(PG8_SB(0, 1), cB + hstepB, voffB); PG8_STAGE(PG8_SA(0, 0), cA, voffA); PG8_STAGE(PG8_SA(0, 1), cA + hstep, voffA);
        if (wr == 1) PG8_BAR;
        PG8_WAIT_V(2); PG8_BAR;
        PG8_STAGE(PG8_SB(1, 0), cB + kstep, voffB); PG8_STAGE(PG8_SA(1, 0), cA + kstep, voffA); PG8_STAGE(PG8_SB(1, 1), cB + hstepB + kstep, voffB);
        PG8_WAIT_V(6); PG8_BAR;
    } else {
        PG8_STAGE(PG8_SB(0, 0), cB, voffB); PG8_STAGE(PG8_SA(0, 0), cA, voffA); PG8_STAGE(PG8_SB(0, 1), cB + hstepB, voffB); PG8_STAGE(PG8_SA(0, 1), cA + hstep, voffA);
        if (wr == 1) PG8_BAR;
        PG8_WAIT_V(4); PG8_BAR;
        PG8_STAGE(PG8_SB(1, 0), cB + kstep, voffB); PG8_STAGE(PG8_SA(1, 0), cA + kstep, voffA); PG8_STAGE(PG8_SB(1, 1), cB + hstepB + kstep, voffB);
        PG8_WAIT_V(6); PG8_BAR;
    }
    for (;;) {
        const bool has_next = S.next(ui + 1, nxt);
        const char* nA = has_next ? (const char*)g.A + (size_t)nxt.pm * tstep : cA; const char* nB = has_next ? (const char*)g.Bt + (size_t)nxt.pn * tstep : cB;
        for (int t = 0; t < nt; t += 2) {
            if constexpr (Epi::HOOK) { if (t == Epi::HOOK_T0 || t == Epi::HOOK_T1) E.hook(acc, cur, t, wr, wc, fr, fq); }
            const bool last = (t == nt - 2);
            const char* a1 = cA + (size_t)(t + 1) * kstep;
            const char* a2 = last ? nA : cA + (size_t)(t + 2) * kstep; const char* b2 = last ? nB : cB + (size_t)(t + 2) * kstep;
            const char* a3 = a2 + kstep; const char* b3 = b2 + kstep;
            if (last && has_next) S.a_ready(nxt);
            if constexpr (SP2) {
            PG8_LDB(B0, 0, 0); PG8_LDB(B1, 0, 1); PG8_SCHED; PG8_LDA(At, 0, 0); PG8_STAGE(PG8_SA(1, 1), a1 + hstep, voffA);
            PG8_WAIT_V(8); PG8_WAIT_L(0); PG8_BAR; PG8_MMA(0, 0, At, B0); PG8_MMA(0, 1, At, B1); PG8_BAR; PG8_SCHED;
            PG8_LDA(At, 0, 1); PG8_STAGE(PG8_SB(0, 0), b2, voffB); PG8_STAGE(PG8_SB(0, 1), b2 + hstepB, voffB); PG8_STAGE(PG8_SA(0, 0), a2, voffA);
            PG8_WAIT_V(8); PG8_WAIT_L(0); PG8_BAR; PG8_MMA(1, 0, At, B0); PG8_MMA(1, 1, At, B1); PG8_BAR; PG8_SCHED;
            PG8_LDB(B0, 1, 0); PG8_LDB(B1, 1, 1); PG8_SCHED; PG8_LDA(At, 1, 0); PG8_STAGE(PG8_SA(0, 1), a2 + hstep, voffA);
            PG8_WAIT_V(8); PG8_WAIT_L(0); PG8_BAR; PG8_MMA(0, 0, At, B0); PG8_MMA(0, 1, At, B1); PG8_BAR; PG8_SCHED;
            PG8_LDA(At, 1, 1); PG8_STAGE(PG8_SB(1, 0), b3, voffB); PG8_STAGE(PG8_SB(1, 1), b3 + hstepB, voffB); PG8_STAGE(PG8_SA(1, 0), a3, voffA);
            PG8_WAIT_V(8); PG8_WAIT_L(0); PG8_BAR; PG8_MMA(1, 0, At, B0); PG8_MMA(1, 1, At, B1); PG8_BAR; PG8_SCHED;
            } else {
            PG8_LDB(B0, 0, 0); PG8_SCHED; PG8_LDA(At, 0, 0); PG8_STAGE(PG8_SA(1, 1), a1 + hstep, voffA);
            PG8_WAIT_L(8); PG8_BAR; PG8_WAIT_L(0); PG8_MMA(0, 0, At, B0); PG8_BAR; PG8_SCHED;
            PG8_LDB(B1, 0, 1); PG8_STAGE(PG8_SB(0, 0), b2, voffB);
            PG8_BAR; PG8_WAIT_L(0); PG8_MMA(0, 1, At, B1); PG8_BAR;
            PG8_LDA(At, 0, 1); PG8_STAGE(PG8_SA(0, 0), a2, voffA);
            PG8_BAR; PG8_WAIT_L(0); PG8_MMA(1, 0, At, B0); PG8_BAR; PG8_SCHED;
            PG8_STAGE(PG8_SB(0, 1), b2 + hstepB, voffB);
            PG8_WAIT_V(6); PG8_BAR; PG8_MMA(1, 1, At, B1); PG8_BAR;
            PG8_LDB(B0, 1, 0); PG8_SCHED; PG8_LDA(At, 1, 0); PG8_STAGE(PG8_SA(0, 1), a2 + hstep, voffA);
            PG8_WAIT_L(8); PG8_BAR; PG8_WAIT_L(0); PG8_MMA(0, 0, At, B0); PG8_BAR; PG8_SCHED;
            PG8_LDB(B1, 1, 1); PG8_STAGE(PG8_SB(1, 0), b3, voffB);
            PG8_BAR; PG8_WAIT_L(0); PG8_MMA(0, 1, At, B1); PG8_BAR;
            PG8_LDA(At, 1, 1); PG8_STAGE(PG8_SA(1, 0), a3, voffA);
            PG8_BAR; PG8_WAIT_L(0); PG8_MMA(1, 0, At, B0); PG8_BAR; PG8_SCHED;
            PG8_STAGE(PG8_SB(1, 1), b3 + hstepB, voffB);
            PG8_WAIT_V(6); PG8_BAR; PG8_MMA(1, 1, At, B1); PG8_BAR;
            }
        }
        if constexpr (ALIGN_EPI) { if (wr == 0) PG8_BAR; }
        if constexpr (!Epi::AFTER_DRAIN) { E(acc, cur, wr, wc, fr, fq); S.done(cur); }
        if (!has_next) break;
#pragma unroll
        for (int a = 0; a < 2; ++a)
#pragma unroll
            for (int b = 0; b < 2; ++b)
#pragma unroll
                for (int m = 0; m < 4; ++m)
#pragma unroll
                    for (int n = 0; n < 2; ++n) acc[a][b][m][n] = (f32x4){0.f, 0.f, 0.f, 0.f};
        cur = nxt; cA = nA; cB = nB; ++ui;
        if constexpr (ALIGN_EPI) { if (wr == 1) PG8_BAR; }
    }
    PG8_WAIT_V(0);
    if constexpr (!ALIGN_EPI) { if (wr == 0) PG8_BAR; }
    PG8_BAR;
    if constexpr (Epi::AFTER_DRAIN) { E.fused(acc, cur, wr, wc, fr, fq, lds, wid, lane); S.done(cur); }
#undef PG8_SA
#undef PG8_SB
#undef PG8_STAGE
#undef PG8_LDA
#undef PG8_LDB
#undef PG8_MMA
#undef PG8_WAIT_V
#undef PG8_WAIT_L
#undef PG8_BAR
#undef PG8_SCHED
}
}
#define LAS __attribute__((address_space(3)))
#define XB_TMO      128
#define XB_XCNT(j)  (256  + 64 * (j))
#define XB_XSUB(j)  (1280 + 64 * (j))
#define XB_XGEN(j)  (2304 + 64 * (j))
#define XB_TOP      3328
#define XB_TOPGEN   3392
#define XCD_BAR_WORDS 3456
#define XB_SPIN_CAP (1u << 23)

__device__ __forceinline__ unsigned xb_ld(unsigned* p)              { return __hip_atomic_load(p, __ATOMIC_RELAXED, __HIP_MEMORY_SCOPE_AGENT); }
__device__ __forceinline__ unsigned xb_add(unsigned* p, unsigned v) { return __hip_atomic_fetch_add(p, v, __ATOMIC_RELAXED, __HIP_MEMORY_SCOPE_AGENT); }
__device__ __forceinline__ unsigned xb_xcc_id() { return (unsigned)__builtin_amdgcn_s_getreg((3 << 11) | 20) & 0xFu; }
#define XB_SPIN(cond, bar) do { unsigned _sp = 0; while (cond) { __builtin_amdgcn_s_sleep(1); \
    if ((++_sp & 255u) == 0u) { if (xb_ld(&(bar)[XB_TMO])) break; if (_sp > XB_SPIN_CAP) { atomicAdd(&(bar)[XB_TMO], 1u); break; } } } } while (0)

struct XcdBarrier {
    unsigned* bar; unsigned x;
    volatile LAS unsigned* st;
};

__device__ __forceinline__ XcdBarrier xcd_barrier_post(unsigned* bar, volatile LAS unsigned* st) {
    XcdBarrier b; b.bar = bar; b.x = xb_xcc_id(); b.st = st;
    if (threadIdx.x == 0) (void)xb_add(&bar[XB_XCNT(b.x)], 1u);
    return b;
}
__device__ __forceinline__ void xcd_barrier_complete(unsigned* bar, unsigned x, unsigned& nloc, unsigned& nx) {
    const unsigned G = gridDim.x * gridDim.y * gridDim.z;
    unsigned sum, cnt, mine, sp = 0u;
    for (;;) {
        sum = 0u; cnt = 0u; mine = 0u;
#pragma unroll
        for (unsigned j = 0; j < 16; ++j) { const unsigned c = xb_ld(&bar[XB_XCNT(j)]); sum += c; cnt += (c > 0u) ? 1u : 0u; mine = (j == x) ? c : mine; }
        if (sum == G) break;
        __builtin_amdgcn_s_sleep(1);
        if ((++sp & 255u) == 0u) { if (xb_ld(&bar[XB_TMO])) break; if (sp > XB_SPIN_CAP) { atomicAdd(&bar[XB_TMO], 1u); break; } }
    }
    nloc = mine > 0u ? mine : 1u; nx = cnt > 0u ? cnt : 1u;
}

__device__ __attribute__((noinline)) void xcd_barrier(const XcdBarrier b) {
    asm volatile("s_waitcnt vmcnt(0)" ::: "memory");
    __syncthreads();
    if (threadIdx.x == 0) {
        unsigned* bar = b.bar;
        __builtin_amdgcn_s_waitcnt(0);
        unsigned nloc = b.st[0], nx = b.st[1];
        if (nloc == 0u) { xcd_barrier_complete(bar, b.x, nloc, nx); b.st[0] = nloc; b.st[1] = nx; }
        const unsigned old = xb_add(&bar[XB_XSUB(b.x)], 1u);
        const unsigned gen = old / nloc;
        if (old + 1u == (gen + 1u) * nloc) {
            __builtin_amdgcn_fence(__ATOMIC_RELEASE, "agent");
            asm volatile("s_waitcnt vmcnt(0)" ::: "memory");
            const unsigned og = xb_add(&bar[XB_TOP], 1u);
            const unsigned tg = og / nx;
            if (og + 1u == (tg + 1u) * nx) xb_add(&bar[XB_TOPGEN], 1u);
            else XB_SPIN(xb_ld(&bar[XB_TOPGEN]) == tg, bar);
            __builtin_amdgcn_fence(__ATOMIC_ACQUIRE, "agent");
            xb_add(&bar[XB_XGEN(b.x)], 1u);
            asm volatile("s_waitcnt vmcnt(0)" ::: "memory");
        } else {
            XB_SPIN(xb_ld(&bar[XB_XGEN(b.x)]) == gen, bar);
            __builtin_amdgcn_fence(__ATOMIC_ACQUIRE, "agent");
            asm volatile("s_waitcnt vmcnt(0)" ::: "memory");
        }
    }
    __syncthreads();
}
#define GAS __attribute__((address_space(1)))
#ifndef LAS
#define LAS __attribute__((address_space(3)))
#endif
typedef unsigned v4u __attribute__((ext_vector_type(4)));
typedef unsigned v2u __attribute__((ext_vector_type(2)));
typedef float f32x4 __attribute__((ext_vector_type(4)));
typedef short bf16x8 __attribute__((ext_vector_type(8)));
typedef _Float16 f16x2 __attribute__((ext_vector_type(2)));
typedef _Float16 f16x4 __attribute__((ext_vector_type(4)));
typedef _Float16 f16x8 __attribute__((ext_vector_type(8)));
#define LDS_WAIT() asm volatile("s_waitcnt lgkmcnt(0)" ::: "memory")
#define VM_WAIT() asm volatile("s_waitcnt vmcnt(0)" ::: "memory")

constexpr int NWAVES = 8, NTHR = 512;
constexpr int NIN = 5376;
constexpr size_t WS_CTL = 0, CTL_ZERO_BYTES = 64 * 1024;
constexpr size_t WS_W = 2 * MiB, W_LSTRIDE = 31 * MiB;
constexpr size_t WO_IN = 0, WO_C = WO_IN + (size_t)NIN * DM * 2, WO_A = WO_C + (size_t)DM * DCONV * 2, WO_P = WO_A + (size_t)DM * DATT * 2,
                 WO_O = WO_P + (size_t)DM * DPOOL * 2, WO_1 = WO_O + (size_t)DM * DM * 2, WO_2 = WO_1 + (size_t)DFF * DM * 2, WO_END = WO_2 + (size_t)DM * DFF * 2;
static_assert(WO_END <= W_LSTRIDE && WS_W + 2 * W_LSTRIDE <= WS_ROPE, "weight map");
constexpr size_t WS_SSQA = 900 * MiB, WS_SSQB = 902 * MiB, WS_SSQAS = 904 * MiB, WS_SSQBS = 905 * MiB;
constexpr int CW_BAR = 4096;
constexpr int RING_BYTES = 131072, LDSCTL_OFF = RING_BYTES, MISC_OFF = LDSCTL_OFF + 320, LDS_BYTES = 147456;
constexpr int RST_OFF = 132096;

__device__ __forceinline__ float fast_sigmoid(float x) { return __builtin_amdgcn_rcpf(1.f + __expf(-x)); }
typedef __bf16 bf16x2_t __attribute__((ext_vector_type(2)));
typedef float f32x2_t __attribute__((ext_vector_type(2)));
__device__ __forceinline__ unsigned pk_bf16(float lo, float hi) { const f32x2_t v = {lo, hi}; const bf16x2_t b = __builtin_convertvector(v, bf16x2_t); return __builtin_bit_cast(unsigned, b); }
__device__ __forceinline__ unsigned pk_f16(float lo, float hi) { f16x2 v = {(_Float16)lo, (_Float16)hi}; return __builtin_bit_cast(unsigned, v); }
__device__ __forceinline__ float wave_sum(float v) {
#pragma unroll
    for (int o = 1; o < 64; o <<= 1) v += __shfl_xor(v, o);
    return v;
}


__device__ __forceinline__ float row_ms_inv(const unsigned char* ws, size_t off_p, size_t off_s, unsigned row) {
    float s = 0.f;
    if (row < (unsigned)MP) { const f32x4* p = (const f32x4*)(ws + off_p) + (size_t)row * 4;
#pragma unroll
        for (int j = 0; j < 4; ++j) { const f32x4 v = p[j]; s += (v.x + v.y) + (v.z + v.w); } }
    else { const f32x4* p = (const f32x4*)(ws + off_s) + (size_t)(row - MP) * 16;
#pragma unroll
        for (int j = 0; j < 16; ++j) { const f32x4 v = p[j]; s += (v.x + v.y) + (v.z + v.w); } }
    return 1.f / (s * (1.f / DM) + RMS_EPS);
}

__host__ __device__ __forceinline__ int rope_perm(int d) { return 8 * ((d & 31) >> 2) + 4 * (d >> 5) + (d & 3); }
__host__ __device__ __forceinline__ int win_row(int n) {
    if (n < C_AGATE) { return 256 * (n >> 7) + 8 * ((n & 127) >> 2) + (n & 3); }
    if (n < C_Q) { int c = n - C_AGATE; return 256 * (c >> 7) + 8 * ((c & 127) >> 2) + 4 + (c & 3); }
    if (n < C_K) { int i = n - C_Q, hh = i >> 6; return 256 * (2 + (hh >> 2)) + 64 * (hh & 3) + rope_perm(i & 63); }
    if (n < C_V) { int i = n - C_K; return 256 * 4 + 64 * (i >> 6) + rope_perm(i & 63); }
    if (n < C_QI) { return 256 * 4 + 128 + (n - C_V); }
    if (n < C_KI) { int i = n - C_QI, hh = i >> 6; return 256 * (5 + (hh >> 2)) + 64 * (hh & 3) + rope_perm(i & 63); }
    if (n < C_WI) { return 256 * 7 + rope_perm(n - C_KI); }
    if (n < C_XC) { return 256 * 7 + 64 + (n - C_WI); }
    if (n < C_G) { return 256 * 8 + (n - C_XC); }
    return 256 * 9 + (n - C_G);
}

struct EpiRelu2 {
    static constexpr bool PERM = true, AFTER_DRAIN = false, HOOK = false, COLMAP2 = true; static constexpr int HOOK_T0 = -1, HOOK_T1 = -1; bf16_t* O; int ldc; const LAS float* rst;
    __device__ __forceinline__ void operator()(const pg8::f32x4 (&acc)[2][2][4][2], const pg8::Unit& u, int wr, int wc, int fr, int fq) const {
        asm volatile("" : "+v"(fr), "+v"(fq), "+s"(wr), "+s"(wc));
#pragma unroll
        for (int ai = 0; ai < 2; ++ai)
#pragma unroll
            for (int m = 0; m < 4; ++m) { const unsigned row = (unsigned)(u.pm * 256 + ai * 128 + wr * 64 + m * 16 + fr); bf16_t* rowp = O + (size_t)row * ldc + u.pn * 256 + wc * 64 + 8 * fq;
                const float r2 = rst[u.idx * 256 + ai * 128 + wr * 64 + m * 16 + fr];
#pragma unroll
                for (int bj = 0; bj < 2; ++bj) { pg8::f32x4 a = acc[ai][bj][m][0], b = acc[ai][bj][m][1]; float r[8];
#pragma unroll
                    for (int e = 0; e < 4; ++e) { float x = fmaxf(a[e], 0.f), y = fmaxf(b[e], 0.f); r[e] = x * x * r2; r[4 + e] = y * y * r2; }
                    v4u w; w.x = pk_bf16(r[0], r[1]); w.y = pk_bf16(r[2], r[3]); w.z = pk_bf16(r[4], r[5]); w.w = pk_bf16(r[6], r[7]);
                    *(v4u*)(rowp + bj * 32) = w; } }
    }
};
struct EpiResid {
    static constexpr bool PERM = true, AFTER_DRAIN = false, HOOK = false, COLMAP2 = true; static constexpr int HOOK_T0 = -1, HOOK_T1 = -1; bf16_t* H; float* SSQ;
    __device__ __forceinline__ void operator()(const pg8::f32x4 (&acc)[2][2][4][2], const pg8::Unit& u, int wr, int wc, int fr, int fq) const {
        asm volatile("" : "+v"(fr), "+v"(fq), "+s"(wr), "+s"(wc));
#pragma unroll
        for (int ai = 0; ai < 2; ++ai)
#pragma unroll
            for (int m = 0; m < 4; ++m) { const size_t row = (size_t)(u.pm * 256 + ai * 128 + wr * 64 + m * 16 + fr); const int col = u.pn * 256 + wc * 64 + 8 * fq; float ss = 0.f;
#pragma unroll
                for (int bj = 0; bj < 2; ++bj) { v4u* p = (v4u*)(H + row * DM + col + bj * 32); const v4u h = *p; const pg8::f32x4 a = acc[ai][bj][m][0], b = acc[ai][bj][m][1];
                    const float o0 = __uint_as_float(h.x << 16) + a[0], o1 = __uint_as_float(h.x & 0xffff0000u) + a[1], o2 = __uint_as_float(h.y << 16) + a[2], o3 = __uint_as_float(h.y & 0xffff0000u) + a[3];
                    const float o4 = __uint_as_float(h.z << 16) + b[0], o5 = __uint_as_float(h.z & 0xffff0000u) + b[1], o6 = __uint_as_float(h.w << 16) + b[2], o7 = __uint_as_float(h.w & 0xffff0000u) + b[3];
                    ss += ((o0 * o0 + o1 * o1) + (o2 * o2 + o3 * o3)) + ((o4 * o4 + o5 * o5) + (o6 * o6 + o7 * o7));
                    v4u w; w.x = pk_bf16(o0, o1); w.y = pk_bf16(o2, o3); w.z = pk_bf16(o4, o5); w.w = pk_bf16(o6, o7);
                    *p = w; }
                ss += __shfl_xor(ss, 16); ss += __shfl_xor(ss, 32);
                if (fq == 0) SSQ[row * 16 + u.pn * 4 + wc] = ss;
                if (m == 3) asm volatile("" ::: "memory"); }
    }
};
struct EpiGate {
    static constexpr bool PERM = true, AFTER_DRAIN = false, HOOK = true, COLMAP2 = true; static constexpr int HOOK_T0 = 4, HOOK_T1 = 12;
    bf16_t* MBp; const _Float16* G;
    __device__ __forceinline__ void hook(pg8::f32x4 (&acc)[2][2][4][2], const pg8::Unit& u, int t, int wr, int wc, int fr, int fq) const {
        asm volatile("" : "+v"(fr), "+v"(fq), "+s"(wr), "+s"(wc));
        const int br = t == HOOK_T0 ? 0 : 1;
#pragma unroll
        for (int ai = 0; ai < 2; ++ai)
#pragma unroll
            for (int m = 0; m < 4; ++m) { const size_t row = (size_t)(u.pm * 256 + ai * 128 + wr * 64 + m * 16 + fr); const int col = u.pn * 256 + wc * 64 + 8 * fq;
#pragma unroll
                for (int bj = 0; bj < 2; ++bj) { const _Float16* gp = G + row * 3072 + 1024 * br + col + bj * 32;
                    const f16x8 gn = *(const f16x8*)gp, gd = *(const f16x8*)(gp + 1024);
#pragma unroll
                    for (int e = 0; e < 4; ++e) { acc[ai][bj][m][0][e] *= (float)gn[e] * __builtin_amdgcn_rcpf(fmaxf((float)gd[e], 1e-7f)); acc[ai][bj][m][1][e] *= (float)gn[4 + e] * __builtin_amdgcn_rcpf(fmaxf((float)gd[4 + e], 1e-7f)); } }
                if (m == 3) asm volatile("" ::: "memory"); }
    }
    __device__ __forceinline__ void operator()(const pg8::f32x4 (&acc)[2][2][4][2], const pg8::Unit& u, int wr, int wc, int fr, int fq) const {
        asm volatile("" : "+v"(fr), "+v"(fq), "+s"(wr), "+s"(wc));
#pragma unroll
        for (int ai = 0; ai < 2; ++ai)
#pragma unroll
            for (int m = 0; m < 4; ++m) { const size_t row = (size_t)(u.pm * 256 + ai * 128 + wr * 64 + m * 16 + fr); const int col = u.pn * 256 + wc * 64 + 8 * fq;
#pragma unroll
                for (int bj = 0; bj < 2; ++bj) { pg8::f32x4 a = acc[ai][bj][m][0], b = acc[ai][bj][m][1];
                    const f16x8 gv = *(const f16x8*)(G + row * 3072 + 2048 + col + bj * 32); float r[8];
#pragma unroll
                    for (int e = 0; e < 4; ++e) { r[e] = (float)gv[e] * a[e]; r[4 + e] = (float)gv[4 + e] * b[e]; }
                    v4u w; w.x = pk_bf16(r[0], r[1]); w.y = pk_bf16(r[2], r[3]); w.z = pk_bf16(r[4], r[5]); w.w = pk_bf16(r[6], r[7]);
                    *(v4u*)(MBp + row * DM + col + bj * 32) = w; }
                if (m == 3) asm volatile("" ::: "memory"); }
    }
};
struct EpiNull {
    static constexpr bool PERM = true, AFTER_DRAIN = false, HOOK = false, COLMAP2 = false; static constexpr int HOOK_T0 = -1, HOOK_T1 = -1; float* sink;
    __device__ __forceinline__ void operator()(const pg8::f32x4 (&acc)[2][2][4][2], const pg8::Unit& u, int wr, int wc, int fr, int fq) const {
        float s = 0.f;
#pragma unroll
        for (int ai = 0; ai < 2; ++ai)
#pragma unroll
            for (int bj = 0; bj < 2; ++bj)
#pragma unroll
                for (int m = 0; m < 4; ++m) s += acc[ai][bj][m][0][0] + acc[ai][bj][m][1][3];
        if (s == 1234.5678f) sink[0] = s;
    }
};
struct EpiInproj {
    static constexpr bool PERM = true, AFTER_DRAIN = false, HOOK = false, COLMAP2 = true; static constexpr int HOOK_T0 = -1, HOOK_T1 = -1; unsigned char* ws; unsigned char* outb; int layer; const LAS float* rst;
    __device__ __forceinline__ void operator()(const pg8::f32x4 (&acc)[2][2][4][2], const pg8::Unit& u, int wr, int wc, int fr, int fq) const {
        const int pn = u.pn; const bool smp = (u.pm == MP / 256);
        asm volatile("" : "+v"(fr), "+v"(fq), "+s"(wr), "+s"(wc));
#pragma unroll
        for (int ai = 0; ai < 2; ++ai)
#pragma unroll
            for (int m = 0; m < 4; ++m) {
                const unsigned row = (unsigned)(u.pm * 256 + ai * 128 + wr * 64 + m * 16 + fr);
                const unsigned orow = smp ? (unsigned)layer * MS + (row - MP) : (unsigned)layer * MP + row;
                const float rsc = rst[u.idx * 256 + ai * 128 + wr * 64 + m * 16 + fr];
#pragma unroll
                for (int bj = 0; bj < 2; ++bj) {
                    const pg8::f32x4 a = acc[ai][bj][m][0] * rsc, b = acc[ai][bj][m][1] * rsc;
                    const unsigned cb = 64 * wc + 32 * bj + 8 * fq;
                    if (pn < 2) {
                        f32x4 o; o.x = a[0] * fast_sigmoid(b[0]); o.y = a[1] * fast_sigmoid(b[1]); o.z = a[2] * fast_sigmoid(b[2]); o.w = a[3] * fast_sigmoid(b[3]);
                        *(f32x4*)(ws + (unsigned)(WS_U + (row * 256u + 128u * pn + (cb >> 1)) * 4u)) = o;
                    } else if (pn == 8) {
                        const unsigned off = (unsigned)(WS_XC + (row * 256u + cb) * 4u);
                        *(f32x4*)(ws + off) = (f32x4){a[0], a[1], a[2], a[3]}; *(f32x4*)(ws + off + 16u) = (f32x4){b[0], b[1], b[2], b[3]};
                    } else if (pn >= 9) {
                        v4u w; w.x = pk_f16(fast_sigmoid(a[0]), fast_sigmoid(a[1])); w.y = pk_f16(fast_sigmoid(a[2]), fast_sigmoid(a[3]));
                        w.z = pk_f16(fast_sigmoid(b[0]), fast_sigmoid(b[1])); w.w = pk_f16(fast_sigmoid(b[2]), fast_sigmoid(b[3]));
                        __builtin_nontemporal_store(w, (v4u*)(ws + (unsigned)(WS_G + (row * 3072u + 256u * (pn - 9) + cb) * 2u)));
                    } else if (pn == 4 && wc >= 2) {
                        const unsigned idx = cb - 128u; v4u w; w.x = pk_bf16(a[0], a[1]); w.y = pk_bf16(a[2], a[3]); w.z = pk_bf16(b[0], b[1]); w.w = pk_bf16(b[2], b[3]);
                        *(v4u*)(ws + (unsigned)(WS_KV + (row * 256u + 128u + idx) * 2u)) = w;
                        const unsigned oo = (unsigned)(((smp ? O_VS : O_VP) + (size_t)orow * KVD + idx) * 4u);
                        *(f32x4*)(outb + oo) = (f32x4){a[0], a[1], a[2], a[3]}; *(f32x4*)(outb + oo + 16u) = (f32x4){b[0], b[1], b[2], b[3]};
                    } else if (pn == 7 && wc >= 1) {
                        if (bj == 0 && wc == 1 && fq == 0) { const unsigned off = (unsigned)(WS_WI + row * 32u);
                            *(f32x4*)(ws + off) = (f32x4){a[0] * WI_SCALE, a[1] * WI_SCALE, a[2] * WI_SCALE, a[3] * WI_SCALE};
                            *(f32x4*)(ws + off + 16u) = (f32x4){b[0] * WI_SCALE, b[1] * WI_SCALE, b[2] * WI_SCALE, b[3] * WI_SCALE}; }
                    } else {
                        const unsigned rr = smp ? T + (row & (ST - 1)) : (row & (T - 1)); const unsigned d0 = (cb & 56u) >> 1, hl = cb >> 6;
                        const unsigned roff = (unsigned)(WS_ROPE + (rr * 32u + d0) * 4u);
                        const f32x4 c4 = *(const f32x4*)(ws + roff), s4 = *(const f32x4*)(ws + roff + (unsigned)((T + ST) * 32 * 4));
                        float o1[4], o2[4];
#pragma unroll
                        for (int e = 0; e < 4; ++e) { o1[e] = a[e] * c4[e] - b[e] * s4[e]; o2[e] = b[e] * c4[e] + a[e] * s4[e]; }
                        unsigned dst; float sc = 1.f; unsigned of = 0u;
                        if (pn < 4) { dst = (unsigned)(WS_QB + (row * 512u + 64u * (4u * (pn - 2) + hl) + d0) * 2u); sc = 0.125f; }
                        else if (pn == 4) { dst = (unsigned)(WS_KV + (row * 256u + 64u * hl + d0) * 2u); of = (unsigned)(((smp ? O_KS : O_KP) + (size_t)orow * KVD + 64u * hl + d0) * 4u); }
                        else if (pn < 7) { dst = (unsigned)(WS_QI + (row * 512u + 64u * (4u * (pn - 5) + hl) + d0) * 2u); }
                        else { dst = (unsigned)(WS_KI + (row * 64u + d0) * 2u); of = (unsigned)(((smp ? O_KIS : O_KIP) + (size_t)orow * ID + d0) * 4u); }
                        v2u w1, w2; w1.x = pk_bf16(o1[0] * sc, o1[1] * sc); w1.y = pk_bf16(o1[2] * sc, o1[3] * sc); w2.x = pk_bf16(o2[0] * sc, o2[1] * sc); w2.y = pk_bf16(o2[2] * sc, o2[3] * sc);
                        *(v2u*)(ws + dst) = w1; *(v2u*)(ws + dst + 64u) = w2;
                        if (pn == 4 || pn == 7) { *(f32x4*)(outb + of) = (f32x4){o1[0], o1[1], o1[2], o1[3]}; *(f32x4*)(outb + of + 128u) = (f32x4){o2[0], o2[1], o2[2], o2[3]}; }
                    }
                }
                if (m == 3) asm volatile("" ::: "memory");
            }
    }
};

__device__ __forceinline__ f32x4 sg_tile(const bf16_t* A, int lda, const bf16_t* Bt, int K, int mt, int nt, int lane, int ldb = 0) {
    const bf16_t* ap = A + (size_t)(16 * mt + (lane & 15)) * lda + 8 * (lane >> 4);
    const bf16_t* bp = Bt + (size_t)(16 * nt + (lane & 15)) * (ldb ? ldb : K) + 8 * (lane >> 4);
    f32x4 acc = {0.f, 0.f, 0.f, 0.f};
    if (K >= 512) {
#pragma unroll 1
        for (int k = 0; k < K; k += 512) { bf16x8 a[16], b[16];
#pragma unroll
            for (int i = 0; i < 16; ++i) { a[i] = *(const bf16x8*)(ap + k + 32 * i); b[i] = *(const bf16x8*)(bp + k + 32 * i); }
#pragma unroll
            for (int i = 0; i < 16; ++i) acc = __builtin_amdgcn_mfma_f32_16x16x32_bf16(b[i], a[i], acc, 0, 0, 0); }
    } else {
#pragma unroll 1
        for (int k = 0; k < K; k += 256) { bf16x8 a[8], b[8];
#pragma unroll
            for (int i = 0; i < 8; ++i) { a[i] = *(const bf16x8*)(ap + k + 32 * i); b[i] = *(const bf16x8*)(bp + k + 32 * i); }
#pragma unroll
            for (int i = 0; i < 8; ++i) acc = __builtin_amdgcn_mfma_f32_16x16x32_bf16(b[i], a[i], acc, 0, 0, 0); }
    }
    return acc;
}

template <bool MAPPED>
__device__ __forceinline__ void transpose_item(const float* W, int K, int N, bf16_t* WT, LAS float* scr, int item, int lane, const float* gain = nullptr, int ldt = 0, int koff = 0) {
    const int nblk = (N + 31) / 32, kb = item / nblk, nb = item % nblk, k0 = 64 * kb, n0 = 32 * nb; const int nn = n0 + (lane & 31);
    (void)nn;
    f32x4 wv[8];
    const int np = n0 + 4 * (lane & 7);
#pragma unroll
    for (int i = 0; i < 8; ++i) { const int kk = 8 * i + (lane >> 3); wv[i] = np < N ? *(const f32x4*)(W + (size_t)(k0 + kk) * N + np) : (f32x4){0.f, 0.f, 0.f, 0.f}; }
#pragma unroll
    for (int i = 0; i < 8; ++i) { const int kk = 8 * i + (lane >> 3); f32x4 v = wv[i]; if (gain) { const float gk = gain[k0 + kk]; v.x *= gk; v.y *= gk; v.z *= gk; v.w *= gk; }
        LAS float* d = scr + kk * 33 + 4 * (lane & 7); d[0] = v.x; d[1] = v.y; d[2] = v.z; d[3] = v.w; }
    LDS_WAIT(); asm volatile("" ::: "memory");
    const int c = lane & 7;
#pragma unroll
    for (int j = 0; j < 4; ++j) { const int nl = (lane >> 3) + 8 * j, n = n0 + nl; const LAS float* s = scr + (8 * c) * 33 + nl;
        v4u o; o.x = pk_bf16(s[0 * 33], s[1 * 33]); o.y = pk_bf16(s[2 * 33], s[3 * 33]); o.z = pk_bf16(s[4 * 33], s[5 * 33]); o.w = pk_bf16(s[6 * 33], s[7 * 33]);
        if (n < N) { const int r = MAPPED ? win_row(n) : n; *(v4u*)(WT + (size_t)r * (ldt ? ldt : K) + koff + k0 + 8 * c) = o; } }
    LDS_WAIT(); asm volatile("" ::: "memory");
}
__device__ __forceinline__ void rms_row(const float* xrow, const float* g, float* xcopy, bf16_t* hout, float* yout, int lane) {
    const f32x4* xr = (const f32x4*)xrow + lane; f32x4 v[4]; float s = 0.f;
#pragma unroll
    for (int j = 0; j < 4; ++j) { v[j] = xr[64 * j]; s += (v[j].x * v[j].x + v[j].y * v[j].y) + (v[j].z * v[j].z + v[j].w * v[j].w); }
    const float r = 1.f / sqrtf(wave_sum(s) * (1.f / DM) + RMS_EPS);
#pragma unroll
    for (int j = 0; j < 4; ++j) { const f32x4 gg = *((const f32x4*)g + lane + 64 * j);
        if (xcopy) *((f32x4*)xcopy + lane + 64 * j) = v[j];
        f32x4 y; y.x = v[j].x * r * gg.x; y.y = v[j].y * r * gg.y; y.z = v[j].z * r * gg.z; y.w = v[j].w * r * gg.w;
        if (hout) { v2u w; w.x = pk_bf16(y.x, y.y); w.y = pk_bf16(y.z, y.w); *((v2u*)hout + lane + 64 * j) = w; }
        if (yout) *((f32x4*)yout + lane + 64 * j) = y; }
}

__device__ __forceinline__ void rms_row_bf(const bf16_t* hrow, const float* g, float* yout, int lane) {
    float v[16]; float s = 0.f;
#pragma unroll
    for (int j = 0; j < 2; ++j) { const v4u h = *((const v4u*)hrow + lane + 64 * j);
        v[8 * j + 0] = __uint_as_float(h.x << 16); v[8 * j + 1] = __uint_as_float(h.x & 0xffff0000u); v[8 * j + 2] = __uint_as_float(h.y << 16); v[8 * j + 3] = __uint_as_float(h.y & 0xffff0000u);
        v[8 * j + 4] = __uint_as_float(h.z << 16); v[8 * j + 5] = __uint_as_float(h.z & 0xffff0000u); v[8 * j + 6] = __uint_as_float(h.w << 16); v[8 * j + 7] = __uint_as_float(h.w & 0xffff0000u); }
#pragma unroll
    for (int e = 0; e < 16; ++e) s += v[e] * v[e];
    const float r = 1.f / sqrtf(wave_sum(s) * (1.f / DM) + RMS_EPS);
#pragma unroll
    for (int j = 0; j < 2; ++j) { const f32x4 g0 = *((const f32x4*)g + 2 * lane + 128 * j), g1 = *((const f32x4*)g + 2 * lane + 128 * j + 1);
        f32x4 y0, y1; y0.x = v[8 * j + 0] * r * g0.x; y0.y = v[8 * j + 1] * r * g0.y; y0.z = v[8 * j + 2] * r * g0.z; y0.w = v[8 * j + 3] * r * g0.w;
        y1.x = v[8 * j + 4] * r * g1.x; y1.y = v[8 * j + 5] * r * g1.y; y1.z = v[8 * j + 6] * r * g1.z; y1.w = v[8 * j + 7] * r * g1.w;
        *((f32x4*)yout + 2 * lane + 128 * j) = y0; *((f32x4*)yout + 2 * lane + 128 * j + 1) = y1; }
}
__device__ __forceinline__ void prep_row(const float* xrow, bf16_t* hout, float* ssq, int nslot, int lane) {
    const f32x4* xr = (const f32x4*)xrow + lane; float s = 0.f;
#pragma unroll
    for (int j = 0; j < 4; ++j) { const f32x4 v = xr[64 * j]; s += (v.x * v.x + v.y * v.y) + (v.z * v.z + v.w * v.w);
        v2u w; w.x = pk_bf16(v.x, v.y); w.y = pk_bf16(v.z, v.w); *((v2u*)hout + lane + 64 * j) = w; }
    s = wave_sum(s);
    if (lane < nslot) ssq[lane] = lane == 0 ? s : 0.f;
}

__device__ __forceinline__ void rms_row_bf2(const bf16_t* ha, float* ya, const bf16_t* hb, float* yb, bool has_b, const float* g, int lane) {
    v4u ra[2], rb[2];
#pragma unroll
    for (int j = 0; j < 2; ++j) ra[j] = *((const v4u*)ha + lane + 64 * j);
#pragma unroll
    for (int j = 0; j < 2; ++j) rb[j] = has_b ? *((const v4u*)hb + lane + 64 * j) : (v4u){0u, 0u, 0u, 0u};
    f32x4 gg[4];
#pragma unroll
    for (int j = 0; j < 2; ++j) { gg[2 * j] = *((const f32x4*)g + 2 * lane + 128 * j); gg[2 * j + 1] = *((const f32x4*)g + 2 * lane + 128 * j + 1); }
#pragma unroll
    for (int rw = 0; rw < 2; ++rw) { if (rw == 1 && !has_b) break;
        float v[16]; float s = 0.f;
#pragma unroll
        for (int j = 0; j < 2; ++j) { const v4u h = rw ? rb[j] : ra[j];
            v[8 * j + 0] = __uint_as_float(h.x << 16); v[8 * j + 1] = __uint_as_float(h.x & 0xffff0000u); v[8 * j + 2] = __uint_as_float(h.y << 16); v[8 * j + 3] = __uint_as_float(h.y & 0xffff0000u);
            v[8 * j + 4] = __uint_as_float(h.z << 16); v[8 * j + 5] = __uint_as_float(h.z & 0xffff0000u); v[8 * j + 6] = __uint_as_float(h.w << 16); v[8 * j + 7] = __uint_as_float(h.w & 0xffff0000u); }
#pragma unroll
        for (int e = 0; e < 16; ++e) s += v[e] * v[e];
        const float r = 1.f / sqrtf(wave_sum(s) * (1.f / DM) + RMS_EPS);
        float* yout = rw ? yb : ya;
#pragma unroll
        for (int j = 0; j < 2; ++j) { const f32x4 g0 = gg[2 * j], g1 = gg[2 * j + 1];
            f32x4 y0, y1; y0.x = v[8 * j + 0] * r * g0.x; y0.y = v[8 * j + 1] * r * g0.y; y0.z = v[8 * j + 2] * r * g0.z; y0.w = v[8 * j + 3] * r * g0.w;
            y1.x = v[8 * j + 4] * r * g1.x; y1.y = v[8 * j + 5] * r * g1.y; y1.z = v[8 * j + 6] * r * g1.z; y1.w = v[8 * j + 7] * r * g1.w;
            *((f32x4*)yout + 2 * lane + 128 * j) = y0; *((f32x4*)yout + 2 * lane + 128 * j + 1) = y1; } }
}
__device__ __forceinline__ void prep_row2(const float* xa, bf16_t* ha, float* sa, int na, const float* xb, bf16_t* hb, float* sb, int nb, bool has_b, int lane) {
    f32x4 va[4], vb[4];
#pragma unroll
    for (int j = 0; j < 4; ++j) va[j] = *((const f32x4*)xa + lane + 64 * j);
#pragma unroll
    for (int j = 0; j < 4; ++j) vb[j] = has_b ? *((const f32x4*)xb + lane + 64 * j) : (f32x4){0.f, 0.f, 0.f, 0.f};
    float s = 0.f, t = 0.f;
#pragma unroll
    for (int j = 0; j < 4; ++j) { const f32x4 v = va[j]; s += (v.x * v.x + v.y * v.y) + (v.z * v.z + v.w * v.w);
        v2u w; w.x = pk_bf16(v.x, v.y); w.y = pk_bf16(v.z, v.w); *((v2u*)ha + lane + 64 * j) = w; }
    s = wave_sum(s);
    if (lane < na) sa[lane] = lane == 0 ? s : 0.f;
    if (has_b) {
#pragma unroll
        for (int j = 0; j < 4; ++j) { const f32x4 v = vb[j]; t += (v.x * v.x + v.y * v.y) + (v.z * v.z + v.w * v.w);
            v2u w; w.x = pk_bf16(v.x, v.y); w.y = pk_bf16(v.z, v.w); *((v2u*)hb + lane + 64 * j) = w; }
        t = wave_sum(t);
        if (lane < nb) sb[lane] = lane == 0 ? t : 0.f; }
}

struct Args { const float* in[24]; float* out; unsigned char* ws; int ph_lo, ph_hi; };
typedef float f32x16 __attribute__((ext_vector_type(16)));
struct P2Args { const float* state_conv; const float* state_pool; const float* conv_w; const float* conv_b; const float* ln_g; const float* ln_b; const float* cache_kidx; const int* page_table; };

__device__ __forceinline__ void conv_task(const Bufs& B, const P2Args& P, int layer, int task, int lane, const LAS float* wl  ) {
    const bool smp = task >= MP / 8; const int b = smp ? task - MP / 8 : task / (T / 8); const int t0 = smp ? 0 : (task % (T / 8)) * 8; const int row0 = smp ? MP + b * ST : b * T;
    const f32x4 bias = *((const f32x4*)(P.conv_b + layer * DCONV) + lane);
    f32x4 acc[8];
#pragma unroll
    for (int i = 0; i < 8; ++i) acc[i] = bias;
#define CONV_LOADROW(dst, r_) do { const int r__ = (r_), tau__ = t0 - 30 + r__; (dst) = (f32x4){0.f, 0.f, 0.f, 0.f}; \
        if (r__ < 38) { if (tau__ >= 0) (dst) = *((const f32x4*)(B.U + (size_t)(row0 + tau__) * 256) + lane); \
            else if (smp) (dst) = *((const f32x4*)(P.state_conv + (((size_t)layer * SB + b) * CHIST + (30 + tau__)) * DCONV) + lane); } } while (0)
    f32x4 xa[4], xb[4], xd[4];
#pragma unroll
    for (int rr = 0; rr < 4; ++rr) CONV_LOADROW(xa[rr], rr);
#pragma unroll
    for (int rr = 0; rr < 4; ++rr) CONV_LOADROW(xb[rr], 4 + rr);
#define CONV_GROUP(XC, XL, r0_) do { const int r0 = (r0_); asm volatile("" ::: "memory");       \
        _Pragma("unroll") for (int rr = 0; rr < 4; ++rr) CONV_LOADROW(XL[rr], r0 + 8 + rr); \
        asm volatile("" ::: "memory"); \
        const LAS f32x4* wb = (const LAS f32x4*)(wl + (r0 + 8) * DCONV) + lane;       \
        _Pragma("unroll") for (int rr = 0; rr < 4; ++rr) { \
            _Pragma("unroll") for (int i = 0; i < 8; ++i) { const f32x4 w = wb[(rr - i) * (DCONV / 4)]; \
                acc[i].x += w.x * XC[rr].x; acc[i].y += w.y * XC[rr].y; acc[i].z += w.z * XC[rr].z; acc[i].w += w.w * XC[rr].w; } } } while (0)
#pragma nounroll
    for (int rg = 0; rg < 36; rg += 12) {
        CONV_GROUP(xa, xd, rg);
        CONV_GROUP(xb, xa, rg + 4);
        CONV_GROUP(xd, xb, rg + 8);
    }
    CONV_GROUP(xa, xd, 36);
#undef CONV_GROUP
#undef CONV_LOADROW
    const f32x4 lg = *((const f32x4*)(P.ln_g + layer * DCONV) + lane), lb = *((const f32x4*)(P.ln_b + layer * DCONV) + lane);
#pragma unroll
    for (int i = 0; i < 8; ++i) {
        const float mu = wave_sum((acc[i].x + acc[i].y) + (acc[i].z + acc[i].w)) * (1.f / 256);
        const f32x4 d = {acc[i].x - mu, acc[i].y - mu, acc[i].z - mu, acc[i].w - mu};
        const float var = wave_sum((d.x * d.x + d.y * d.y) + (d.z * d.z + d.w * d.w)) * (1.f / 256);
        const float rs = 1.f / sqrtf(var + LN_EPS);
        float y0 = d.x * rs * lg.x + lb.x, y1 = d.y * rs * lg.y + lb.y, y2 = d.z * rs * lg.z + lb.z, y3 = d.w * rs * lg.w + lb.w;
        y0 *= fast_sigmoid(y0); y1 *= fast_sigmoid(y1); y2 *= fast_sigmoid(y2); y3 *= fast_sigmoid(y3);
        v2u w; w.x = pk_bf16(y0, y1); w.y = pk_bf16(y2, y3);
        *((v2u*)(B.CA + (size_t)(row0 + t0 + i) * DM) + lane) = w; }
}
__device__ __forceinline__ void pool_task(const Bufs& B, const P2Args& P, int layer, int task, int lane) {
    const bool smp = task >= MP / 8; const int b = smp ? task - MP / 8 : task / (T / 8); const int t0 = smp ? 0 : (task % (T / 8)) * 8; const int row0 = smp ? MP + b * ST : b * T;
    f32x4 cs[24];
    f32x4 xr[8];
    cs[0] = (f32x4){0.f, 0.f, 0.f, 0.f};
#pragma unroll
    for (int r = 0; r < 23; ++r) { const int tau = t0 - 15 + r; f32x4 v;
        if (tau >= 0) v = *((const f32x4*)(B.XC + (size_t)(row0 + tau) * 256) + lane);
        else if (smp) v = *((const f32x4*)(P.state_pool + (((size_t)layer * SB + b) * PHIST + (15 + tau)) * DPOOL) + lane);
        else v = (f32x4){0.f, 0.f, 0.f, 0.f};
        cs[r + 1] = (f32x4){cs[r].x + v.x, cs[r].y + v.y, cs[r].z + v.z, cs[r].w + v.w}; if (r >= 15) xr[r - 15] = v; }
    const int g = lane >> 4, w = 2 << g;
#pragma unroll
    for (int i = 0; i < 8; ++i) {
        const f32x4 s2 = cs[14 + i], s4 = cs[12 + i], s8 = cs[8 + i], s16 = cs[i];
        const f32x4 st = g == 0 ? s2 : (g == 1 ? s4 : (g == 2 ? s8 : s16)); const f32x4 e = cs[16 + i];
        const int t = t0 + i; const float cnt = smp ? (float)w : (float)((t + 1) < w ? (t + 1) : w); const float ic = 1.f / cnt;
        v2u o; o.x = pk_bf16((e.x - st.x) * ic - xr[i].x, (e.y - st.y) * ic - xr[i].y); o.y = pk_bf16((e.z - st.z) * ic - xr[i].z, (e.w - st.w) * ic - xr[i].w);
        *((v2u*)(B.CA + (size_t)(row0 + t) * DM + (DCONV + DATT)) + lane) = o; }
}
__device__ __forceinline__ void states_task(const Bufs& B, const P2Args& P, int layer, int i, int lane) {
    const float* src; float* dst;
    if (i < NB * 30) { const int b = i / 30, r = i % 30; dst = B.out + O_CP + (((size_t)layer * NB + b) * CHIST + r) * DCONV; src = B.U + (size_t)(b * T + T - 30 + r) * 256; }
    else if ((i -= NB * 30) < NB * 15) { const int b = i / 15, r = i % 15; dst = B.out + O_PP + (((size_t)layer * NB + b) * PHIST + r) * DPOOL; src = B.XC + (size_t)(b * T + T - 15 + r) * 256; }
    else if ((i -= NB * 15) < SB * 30) { const int b = i / 30, r = i % 30; dst = B.out + O_CS + (((size_t)layer * SB + b) * CHIST + r) * DCONV;
        src = (ST + r < CHIST) ? P.state_conv + (((size_t)layer * SB + b) * CHIST + ST + r) * DCONV : B.U + (size_t)(MP + b * ST + (ST + r - CHIST)) * 256; }
    else { i -= SB * 30; const int b = i / 15, r = i % 15; dst = B.out + O_PS + (((size_t)layer * SB + b) * PHIST + r) * DPOOL;
        src = (ST + r < PHIST) ? P.state_pool + (((size_t)layer * SB + b) * PHIST + ST + r) * DPOOL : B.XC + (size_t)(MP + b * ST + (ST + r - PHIST)) * 256; }
    *((f32x4*)dst + lane) = *((const f32x4*)src + lane);
}

__device__ __forceinline__ void rho_map(int rho, int& qq, int& head) { const int hf = (rho >> 2) & 1, i = (rho & 3) + 4 * (rho >> 3); qq = 2 * hf + (i >> 3); head = i & 7; }
typedef float f32x2 __attribute__((ext_vector_type(2)));
__device__ __forceinline__ void head_reduce(const f32x16& acc, const float (&wv)[16], float& s0, float& s1) {
    f32x2 a = {0.f, 0.f}, c = {0.f, 0.f};
#pragma unroll
    for (int h = 0; h < 8; h += 2) {
        const float f0 = acc[h], f1 = acc[h + 1], f2 = acc[8 + h], f3 = acc[9 + h];
        const int i0 = __float_as_int(f0), i1 = __float_as_int(f1), i2 = __float_as_int(f2), i3 = __float_as_int(f3);
        const f32x2 x01 = {__int_as_float(i0 > 0 ? i0 : 0), __int_as_float(i1 > 0 ? i1 : 0)}, x23 = {__int_as_float(i2 > 0 ? i2 : 0), __int_as_float(i3 > 0 ? i3 : 0)};
        const f32x2 w01 = {wv[h], wv[h + 1]}, w23 = {wv[8 + h], wv[9 + h]};
        a = __builtin_elementwise_fma(w01, x01, a); c = __builtin_elementwise_fma(w23, x23, c); }
    s0 = a.x + a.y; s1 = c.x + c.y;
}
typedef short s16x2 __attribute__((ext_vector_type(2)));
__device__ __forceinline__ void wfrag_build(const float* wrow  , int lane, bf16x8 (&wf)[2]) {
    const int r = lane & 31, hh = lane >> 5, ssel = r - 2 * hh; v4u pk = {0u, 0u, 0u, 0u};
    if (r < 4) { const f32x4 w0 = *(const f32x4*)(wrow + r * 8), w1 = *(const f32x4*)(wrow + r * 8 + 4); pk.x = pk_bf16(w0.x, w0.y); pk.y = pk_bf16(w0.z, w0.w); pk.z = pk_bf16(w1.x, w1.y); pk.w = pk_bf16(w1.z, w1.w); }
    const v4u z = {0u, 0u, 0u, 0u};
    wf[0] = __builtin_bit_cast(bf16x8, (r < 4 && ssel == 0) ? pk : z); wf[1] = __builtin_bit_cast(bf16x8, (r < 4 && ssel == 1) ? pk : z);
}
__device__ __forceinline__ f32x16 head_reduce_mfma(const f32x16& acc, const bf16x8 (&wf)[2]) {
    f32x16 y;
#pragma unroll
    for (int i = 0; i < 16; ++i) y[i] = 0.f;
#pragma unroll
    for (int st = 0; st < 2; ++st) { unsigned d[4];
#pragma unroll
        for (int p = 0; p < 4; ++p) { const float f0 = acc[8 * st + 2 * p], f1 = acc[8 * st + 2 * p + 1]; const unsigned w = pk_bf16(f0, f1);
            const s16x2 v = {(short)(w & 0xFFFFu), (short)(w >> 16)}; const s16x2 m = __builtin_elementwise_max(v, (s16x2){0, 0});
            d[p] = (unsigned)(unsigned short)m.x | ((unsigned)(unsigned short)m.y << 16); }
        const v4u pk = {d[0], d[1], d[2], d[3]};
        y = __builtin_amdgcn_mfma_f32_32x32x16_bf16(wf[st], __builtin_bit_cast(bf16x8, pk), y, 0, 0, 0); }
    return y;
}
constexpr int KI_LD = 144;
constexpr int KI_BUF = 128 * KI_LD;

__device__ __forceinline__ void scores_prompt_unit(const Bufs& B, LAS unsigned char* lds, int b, int qb, int tid, int abl = 0) {
    const int lane = tid & 63, wave = __builtin_amdgcn_readfirstlane(tid >> 6), hf = lane >> 5, qg = wave & 3, kh = wave >> 2;
    const int t0 = qb * 32; const size_t mrow = (size_t)b * T + t0 + 8 * qg;
    int qq, head; rho_map(lane & 31, qq, head);
    bf16x8 af[2][4]; bf16x8 wf[2][2];
#pragma unroll
    for (int a = 0; a < 2; ++a) {
#pragma unroll
        for (int ks = 0; ks < 4; ++ks) af[a][ks] = *(const bf16x8*)(B.QI + (mrow + 4 * a + qq) * 512 + head * 64 + 16 * ks + 8 * hf);
        wfrag_build(B.WI + (mrow + 4 * a) * 8, lane, wf[a]); }
    const int nchunk = (t0 + 32 + 127) >> 7;
    const bf16_t* kbase = B.KI + (size_t)b * T * 64;
    const int p0 = tid, p1 = tid + 512; const unsigned so0 = (unsigned)((p0 >> 3) * KI_LD + (p0 & 7) * 16), so1 = (unsigned)((p1 >> 3) * KI_LD + (p1 & 7) * 16);
    const bf16_t* kp0 = kbase + (size_t)(p0 >> 3) * 64 + (p0 & 7) * 8; const bf16_t* kp1 = kbase + (size_t)(p1 >> 3) * 64 + (p1 & 7) * 8;
    v4u rA0 = *(const v4u*)kp0, rA1 = *(const v4u*)kp1, rB0 = rA0, rB1 = rA1;
    if (nchunk > 1) { rB0 = *(const v4u*)(kp0 + 128 * 64); rB1 = *(const v4u*)(kp1 + 128 * 64); }
    *(LAS v4u*)(lds + so0) = rA0; *(LAS v4u*)(lds + so1) = rA1;
    if (nchunk > 1) { *(LAS v4u*)(lds + KI_BUF + so0) = rB0; *(LAS v4u*)(lds + KI_BUF + so1) = rB1; }
    if (nchunk > 2) { rA0 = *(const v4u*)(kp0 + 2 * 128 * 64); rA1 = *(const v4u*)(kp1 + 2 * 128 * 64); }
    __syncthreads();
    constexpr int ST_OFF = 98304;
    _Float16* const scblk = B.SC + ((size_t)b * T + t0 + (tid >> 4)) * T + 8 * (tid & 15);
    const unsigned fro = (unsigned)((64 * kh + (lane & 31)) * KI_LD + 16 * hf);
    bf16x8 bqA[2][4], bqB[2][4];
#pragma unroll
    for (int kbl = 0; kbl < 2; ++kbl)
#pragma unroll
        for (int ks = 0; ks < 4; ++ks) bqA[kbl][ks] = *(const LAS bf16x8*)(lds + fro + (32 * kbl) * KI_LD + 32 * ks);
#define SCORE_MM(dst, a_, kbl_, BQ) do { _Pragma("unroll") for (int i = 0; i < 16; ++i) (dst)[i] = 0.f; \
            _Pragma("unroll") for (int ks = 0; ks < 4; ++ks) (dst) = __builtin_amdgcn_mfma_f32_32x32x16_bf16(af[a_][ks], BQ[kbl_][ks], (dst), 0, 0, 0); } while (0)
#define SCORE_HR(acc_, a_, j_) do { const f32x16 y = head_reduce_mfma(acc_, wf[a_]); LAS _Float16* sp = stile + (4 * ((j_) & 1)) * 128 + 32 * ((j_) >> 1); \
            sp[0] = (_Float16)y[0]; sp[128] = (_Float16)y[1]; sp[256] = (_Float16)y[2]; sp[384] = (_Float16)y[3]; } while (0)
#define SCORE_BODY(c_, BQC, BQN, RW0, RW1, RL0, RL1) { const int c = (c_); \
        if (c + 3 < nchunk && !(abl & 2)) { RL0 = *(const v4u*)(kp0 + (size_t)(c + 3) * 128 * 64); RL1 = *(const v4u*)(kp1 + (size_t)(c + 3) * 128 * 64); } \
        if (c > 0) { const v4u sv = *(const LAS v4u*)(lds + ST_OFF + ((c - 1) & 1) * 8192 + (tid >> 4) * 256 + (tid & 15) * 16); if (!(abl & 1)) __builtin_nontemporal_store(sv, (v4u*)(scblk + (size_t)(c - 1) * 128)); else if (sv.x == 0x12345u) *(v4u*)(scblk) = sv; } \
        if (c == nchunk) break; \
        LAS unsigned char* nxt = lds + ((c + 1) & 1) * KI_BUF; \
        if (c + 1 < nchunk) { _Pragma("unroll") for (int kbl = 0; kbl < 2; ++kbl) _Pragma("unroll") for (int ks = 0; ks < 4; ++ks) BQN[kbl][ks] = *(const LAS bf16x8*)(nxt + fro + (32 * kbl) * KI_LD + 32 * ks); } \
        f32x16 a0, a1; \
        LAS _Float16* stile = (LAS _Float16*)(lds + ST_OFF + (hf ? 2 : (c & 1)) * 8192) + (8 * qg) * 128 + 64 * kh + (lane & 31);        \
        { \
        SCORE_MM(a0, 0, 0, BQC); \
        SCORE_MM(a1, 1, 0, BQC); SCORE_HR(a0, 0, 0); \
        SCORE_MM(a0, 0, 1, BQC); SCORE_HR(a1, 1, 1); \
        SCORE_MM(a1, 1, 1, BQC); SCORE_HR(a0, 0, 2); \
        SCORE_HR(a1, 1, 3); } \
        if (c + 2 < nchunk) { LAS unsigned char* wb = lds + (c & 1) * KI_BUF; *(LAS v4u*)(wb + so0) = RW0; *(LAS v4u*)(wb + so1) = RW1; }        \
        __syncthreads(); }
    for (int c2 = 0; ; c2 += 2) { SCORE_BODY(c2, bqA, bqB, rA0, rA1, rB0, rB1) SCORE_BODY(c2 + 1, bqB, bqA, rB0, rB1, rA0, rA1) }
#undef SCORE_BODY
#undef SCORE_HR
#undef SCORE_MM
}
__device__ __forceinline__ void scores_sample_task(const Bufs& B, const P2Args& P, int layer, int task, int lane, LAS unsigned char* swl  ) {
    const int hf = lane >> 5; const bool newk = task >= SB * NPAGES; const int b = newk ? task - SB * NPAGES : task / NPAGES, pg = newk ? 0 : task % NPAGES;
    const size_t mrow = (size_t)MP + b * ST;
    int qq, head; rho_map(lane & 31, qq, head);
    bf16x8 af[2][4]; bf16x8 wf[2][2];
#pragma unroll
    for (int a = 0; a < 2; ++a) {
#pragma unroll
        for (int ks = 0; ks < 4; ++ks) af[a][ks] = *(const bf16x8*)(B.QI + (mrow + 4 * a + qq) * 512 + head * 64 + 16 * ks + 8 * hf);
        wfrag_build(B.WI + (mrow + 4 * a) * 8, lane, wf[a]); }
    _Float16* sc0 = B.SCS + (size_t)(b * ST) * SCS_LD + (lane & 31);
    if (!newk) {
        const float* pgp = P.cache_kidx + (((size_t)layer * NPOOL + P.page_table[b * NPAGES + pg]) * PAGE + (lane >> 4)) * ID + 4 * (lane & 15);
        f32x4 u[4][8];
#pragma unroll
        for (int kb = 0; kb < 4; ++kb)
#pragma unroll
            for (int q = 0; q < 8; ++q) u[kb][q] = *(const f32x4*)(pgp + (size_t)(32 * kb + 4 * q) * ID);
#pragma unroll
        for (int kb = 0; kb < 4; ++kb) {
            asm volatile("" ::: "memory");
#pragma unroll
            for (int q = 0; q < 8; ++q) { v2u p; p.x = pk_bf16(u[kb][q].x, u[kb][q].y); p.y = pk_bf16(u[kb][q].z, u[kb][q].w); *(LAS v2u*)(swl + (4 * q + (lane >> 4)) * KI_LD + (lane & 15) * 8) = p; }
            asm volatile("" ::: "memory");
            bf16x8 bfg[4];
#pragma unroll
            for (int ks = 0; ks < 4; ++ks) bfg[ks] = *(const LAS bf16x8*)(swl + (lane & 31) * KI_LD + 32 * ks + 16 * hf);
            asm volatile("" ::: "memory");
#pragma unroll
            for (int a = 0; a < 2; ++a) { f32x16 acc;
#pragma unroll
                for (int i = 0; i < 16; ++i) acc[i] = 0.f;
#pragma unroll
                for (int ks = 0; ks < 4; ++ks) acc = __builtin_amdgcn_mfma_f32_32x32x16_bf16(af[a][ks], bfg[ks], acc, 0, 0, 0);
                const f32x16 y = head_reduce_mfma(acc, wf[a]);
                if (hf == 0) { _Float16* sp = sc0 + (size_t)(4 * a) * SCS_LD + pg * PAGE + 32 * kb; sp[0] = (_Float16)y[0]; sp[SCS_LD] = (_Float16)y[1]; sp[2 * SCS_LD] = (_Float16)y[2]; sp[3 * SCS_LD] = (_Float16)y[3]; } }
        }
    } else {
        const int kr = (lane & 31) < ST ? (lane & 31) : 0;
        bf16x8 bfg[4];
#pragma unroll
        for (int ks = 0; ks < 4; ++ks) bfg[ks] = *(const bf16x8*)(B.KI + (mrow + kr) * 64 + 16 * ks + 8 * hf);
#pragma unroll
        for (int a = 0; a < 2; ++a) { f32x16 acc;
#pragma unroll
            for (int i = 0; i < 16; ++i) acc[i] = 0.f;
#pragma unroll
            for (int ks = 0; ks < 4; ++ks) acc = __builtin_amdgcn_mfma_f32_32x32x16_bf16(af[a][ks], bfg[ks], acc, 0, 0, 0);
            const f32x16 y = head_reduce_mfma(acc, wf[a]);
            if (lane < ST) { _Float16* sp = sc0 + (size_t)(4 * a) * SCS_LD + PAST; sp[0] = (_Float16)y[0]; sp[SCS_LD] = (_Float16)y[1]; sp[2 * SCS_LD] = (_Float16)y[2]; sp[3 * SCS_LD] = (_Float16)y[3]; } }
    }
}

struct P3Args { const float* cache_k; const float* cache_v; const int* page_table; };
typedef short s16x4 __attribute__((ext_vector_type(4)));
constexpr int WL_BYTES = 16384, WL_LIST = 4096, WL_VB = 5120, VB_LD = 160, NHC = 4;
__device__ __forceinline__ unsigned f16_sortkey(unsigned h) { return (h & 0x8000u) ? (~h & 0xFFFFu) : (h | 0x8000u); }
__device__ __forceinline__ void find_bin(const LAS unsigned* hist, int ncopy, int K, int lane, int& bin, int& above) {
    unsigned c0 = 0, c1 = 0, c2 = 0, c3 = 0;
    for (int cp = 0; cp < ncopy; ++cp) { const v4u h = *(const LAS v4u*)(hist + cp * 256 + 4 * lane); c0 += h.x; c1 += h.y; c2 += h.z; c3 += h.w; }
    const int tot = (int)(c0 + c1 + c2 + c3); int v = tot;
#pragma unroll
    for (int o = 1; o < 64; o <<= 1) { const int tmp = __shfl_down(v, o); if (lane + o < 64) v += tmp; }
    const int S = v - tot;
    const bool mine = (S < K) && (v >= K);
    const unsigned long long mk = __ballot(mine); const int L = mk ? (int)__builtin_ctzll(mk) : 0;
    int run = S, lb = 4 * lane, la = S; bool found = false;
    if (run + (int)c3 >= K) { lb = 4 * lane + 3; la = run; found = true; } else run += (int)c3;
    if (!found) { if (run + (int)c2 >= K) { lb = 4 * lane + 2; la = run; found = true; } else run += (int)c2; }
    if (!found) { if (run + (int)c1 >= K) { lb = 4 * lane + 1; la = run; found = true; } else run += (int)c1; }
    if (!found) { lb = 4 * lane; la = run; }
    bin = __shfl(lb, L); above = __shfl(la, L);
}
__device__ __forceinline__ unsigned sortkey2(unsigned x) { const unsigned sgn = (x >> 15) & 0x00010001u; return x ^ ((sgn * 0x7FFFu) | 0x80008000u); }
template <bool SMP, int MODE = 0>
__device__ __forceinline__ void select_attend_task(const Bufs& B, const P3Args& P, int layer, int m_in, int lane_in, LAS unsigned char* wl) {
    int m = m_in, lane = lane_in; asm volatile("" : "+s"(m)); asm volatile("" : "+v"(lane));
    constexpr int CIT = SMP ? 11 : 16, NCH = SMP ? 3 : 1;
    const int b = SMP ? (m - MP) / ST : m / T, t = SMP ? (m - MP) % ST : m % T; const int n = SMP ? PAST + t + 1 : t + 1;
    const unsigned char* scb = (const unsigned char*)(SMP ? B.SCS + (size_t)(m - MP) * SCS_LD : B.SC + (size_t)m * T);
    LAS unsigned* hist = (LAS unsigned*)wl; LAS unsigned* list = (LAS unsigned*)(wl + WL_LIST);
    const int cnt = n < TOPK ? n : TOPK;
    asm volatile("" ::: "memory");
    if (MODE == 2 || MODE == 3) {
#pragma unroll
        for (int q = 0; q < 4; ++q) list[lane + 64 * q] = (unsigned)((lane + 64 * q) * 29 % (n > 1 ? n : 1));
    } else if (n <= TOPK) {
#pragma unroll
        for (int q = 0; q < 4; ++q) { const int i = lane + 64 * q; list[i] = i < n ? (unsigned)i : 0u; }
    } else {
        const int nIt = (n + 511) >> 9;
        v4u kk[CIT];
#define LOADCHUNK(ch_) do { _Pragma("unroll") for (int it = 0; it < CIT; ++it) { kk[it] = (v4u){0u, 0u, 0u, 0u}; if ((ch_) * CIT + it < nIt) kk[it] = __builtin_nontemporal_load((const v4u*)(scb + ((ch_) * CIT + it) * 1024 + (unsigned)(lane * 16))); } \
        _Pragma("unroll") for (int it = 0; it < CIT; ++it) { const int e0 = ((ch_) * CIT + it) * 512 + lane * 8; unsigned w[4] = {kk[it].x, kk[it].y, kk[it].z, kk[it].w}; \
            _Pragma("unroll") for (int d = 0; d < 4; ++d) { unsigned k2 = sortkey2(w[d]); if (e0 + 2 * d >= n) k2 = 0u; else if (e0 + 2 * d + 1 >= n) k2 &= 0xFFFFu; w[d] = k2; } \
            kk[it] = (v4u){w[0], w[1], w[2], w[3]}; } } while (0)
#define FOR_KEYS(ch_) _Pragma("unroll") for (int it = 0; it < CIT; ++it) if ((ch_) * CIT + it < nIt) { const int e0 = ((ch_) * CIT + it) * 512 + lane * 8; (void)e0; unsigned w[4] = {kk[it].x, kk[it].y, kk[it].z, kk[it].w}; \
            asm volatile("" : "+v"(w[0]), "+v"(w[1]), "+v"(w[2]), "+v"(w[3])); _Pragma("unroll") for (int d = 0; d < 4; ++d) { const unsigned k0 = w[d] & 0xFFFFu, k1 = w[d] >> 16; (void)k0; (void)k1;
#define END_KEYS } }
#pragma unroll
        for (int q = 0; q < 4 * NHC; ++q) hist[lane + 64 * q] = 0u;
        if (NCH == 1) LOADCHUNK(0);
        asm volatile("s_waitcnt lgkmcnt(0)" ::: "memory");
        LAS unsigned* hc = hist + (lane & (NHC - 1)) * 256;
#pragma unroll 1
        for (int ch = 0; ch < NCH; ++ch) { if (NCH > 1) LOADCHUNK(ch);
            FOR_KEYS(ch) __hip_atomic_fetch_add(hc + (k0 >> 8), 1u, __ATOMIC_RELAXED, __HIP_MEMORY_SCOPE_WORKGROUP); __hip_atomic_fetch_add(hc + (k1 >> 8), 1u, __ATOMIC_RELAXED, __HIP_MEMORY_SCOPE_WORKGROUP); END_KEYS }
        asm volatile("s_waitcnt lgkmcnt(0)" ::: "memory");
        int B1, above1; find_bin(hist, NHC, TOPK, lane, B1, above1);
        if (MODE == 11) { if (B1 == 12345) list[lane] = (unsigned)above1; return; }
        asm volatile("" ::: "memory");
#pragma unroll
        for (int q = 0; q < 4; ++q) hist[lane + 64 * q] = 0u;
        asm volatile("s_waitcnt lgkmcnt(0)" ::: "memory");
#pragma unroll 1
        for (int ch = 0; ch < NCH; ++ch) { if (NCH > 1) LOADCHUNK(ch);
            FOR_KEYS(ch) if ((int)(k0 >> 8) == B1) __hip_atomic_fetch_add(hist + (k0 & 255u), 1u, __ATOMIC_RELAXED, __HIP_MEMORY_SCOPE_WORKGROUP);
                         if ((int)(k1 >> 8) == B1) __hip_atomic_fetch_add(hist + (k1 & 255u), 1u, __ATOMIC_RELAXED, __HIP_MEMORY_SCOPE_WORKGROUP); END_KEYS }
        asm volatile("s_waitcnt lgkmcnt(0)" ::: "memory");
        int B2, above2; find_bin(hist, 1, TOPK - above1, lane, B2, above2);
        const unsigned tau = ((unsigned)B1 << 8) | (unsigned)B2; const int cnt_gt = above1 + above2;
        if (MODE == 12) { if (tau == 0x12345u) list[lane] = (unsigned)cnt_gt; return; }
        constexpr int NMW = (CIT + 3) / 4;
#define BUILD_MASKS(ch_) do { _Pragma("unroll") for (int wq = 0; wq < NMW; ++wq) { mg[wq] = 0u; me[wq] = 0u; } \
            FOR_KEYS(ch_) const unsigned g2 = ((tau - k0) >> 31) | (((tau - k1) >> 31) << 1), q2 = (((k0 ^ tau) - 1u) >> 31) | ((((k1 ^ tau) - 1u) >> 31) << 1); \
                mg[it >> 2] |= g2 << (8 * (it & 3) + 2 * d); me[it >> 2] |= q2 << (8 * (it & 3) + 2 * d); END_KEYS } while (0)
        unsigned mg[NMW], me[NMW];
        int cg = 0, ce = 0;
#pragma unroll 1
        for (int ch = 0; ch < NCH; ++ch) { if (NCH > 1) LOADCHUNK(ch);
            BUILD_MASKS(ch);
#pragma unroll
            for (int wq = 0; wq < NMW; ++wq) { cg += __popc(mg[wq]); ce += __popc(me[wq]); } }
        if (MODE == 13) { if (cg == 12345) list[lane] = (unsigned)ce; return; }
        int pg = cg, pe = ce;
#pragma unroll
        for (int o = 1; o < 64; o <<= 1) { const int tg = __shfl_up(pg, o), te = __shfl_up(pe, o); if (lane >= o) { pg += tg; pe += te; } }
        pg -= cg; pe = cnt_gt + (pe - ce);
        asm volatile("" ::: "memory");
#pragma unroll 1
        for (int ch = 0; ch < NCH; ++ch) { if (NCH > 1) { LOADCHUNK(ch); BUILD_MASKS(ch); }
#pragma unroll
            for (int wq = 0; wq < NMW; ++wq) { const int ebase = ((ch * CIT + 4 * wq) * 512) + lane * 8;
                unsigned m = mg[wq];
                while (m) { const int bb = __builtin_ctz(m); m &= m - 1u; list[pg] = (unsigned)(ebase + ((bb >> 3) << 9) + (bb & 7)); ++pg; }
                m = me[wq];
                while (m) { const int bb = __builtin_ctz(m); m &= m - 1u; if (pe < TOPK) list[pe] = (unsigned)(ebase + ((bb >> 3) << 9) + (bb & 7)); ++pe; } } }
#undef BUILD_MASKS
#undef LOADCHUNK
#undef FOR_KEYS
#undef END_KEYS
    }
    asm volatile("s_waitcnt lgkmcnt(0)" ::: "memory");
    if (MODE == 1) return;
    const int hcol = lane & 15, g = lane >> 4;
    const float* ckb = nullptr; const float* cvb = nullptr; const int* ptb = nullptr;
    if (SMP) { ckb = P.cache_k + (size_t)layer * NPOOL * PAGE * KVD; cvb = P.cache_v + (size_t)layer * NPOOL * PAGE * KVD; ptb = P.page_table + b * NPAGES; }
    const unsigned char* kvb = (const unsigned char*)(SMP ? B.KV + (size_t)(MP + b * ST) * 256 : B.KV + (size_t)b * T * 256);
    LAS unsigned char* vb = wl + WL_VB;
    constexpr float LOG2E = 1.4426950408889634f;
#pragma unroll 1
    for (int nk = 0; nk < 2; ++nk) {
        bf16x8 qf[2];
#pragma unroll
        for (int ks = 0; ks < 2; ++ks) { qf[ks] = (bf16x8){0, 0, 0, 0, 0, 0, 0, 0}; if (hcol < 4) qf[ks] = *(const bf16x8*)(B.QB + (size_t)m * 512 + (4 * nk + hcol) * 64 + 32 * ks + 8 * g); }
        f32x4 S[16];
        if (SMP) {
#pragma unroll
            for (int tl = 0; tl < 16; ++tl) {
                const unsigned kidx = list[16 * tl + hcol]; bf16x8 a0, a1;
                if (kidx < (unsigned)PAST) { const float* kp = ckb + ((size_t)ptb[kidx >> 7] * PAGE + (kidx & 127u)) * KVD + 64 * nk + 8 * g;
                    const f32x4 u0 = *(const f32x4*)kp, u1 = *(const f32x4*)(kp + 4), u2 = *(const f32x4*)(kp + 32), u3 = *(const f32x4*)(kp + 36);
                    v4u p0, p1; p0.x = pk_bf16(u0.x, u0.y); p0.y = pk_bf16(u0.z, u0.w); p0.z = pk_bf16(u1.x, u1.y); p0.w = pk_bf16(u1.z, u1.w);
                    p1.x = pk_bf16(u2.x, u2.y); p1.y = pk_bf16(u2.z, u2.w); p1.z = pk_bf16(u3.x, u3.y); p1.w = pk_bf16(u3.z, u3.w);
                    a0 = __builtin_bit_cast(bf16x8, p0); a1 = __builtin_bit_cast(bf16x8, p1);
                } else { const unsigned off = (kidx - PAST) * 512u + (unsigned)(128 * nk + 16 * g); a0 = *(const bf16x8*)(kvb + off); a1 = *(const bf16x8*)(kvb + off + 64u); }
                f32x4 s = {0.f, 0.f, 0.f, 0.f};
                s = __builtin_amdgcn_mfma_f32_16x16x32_bf16(a0, qf[0], s, 0, 0, 0);
                S[tl] = __builtin_amdgcn_mfma_f32_16x16x32_bf16(a1, qf[1], s, 0, 0, 0);
            }
        } else {
#define KLOAD(dst, kb_, q_) do { const int kl_ = (lane >> 3) + 8 * (q_), part_ = lane & 7; const unsigned kidx_ = list[32 * (kb_) + kl_]; \
                (dst) = *(const v4u*)(kvb + (kidx_ * 512u + (unsigned)(128 * nk + 16 * part_))); } while (0)
            v4u pk[2][8];
#pragma unroll
            for (int i = 0; i < 8; ++i) KLOAD(pk[0][i], i >> 2, i & 3);
#pragma unroll
            for (int kb = 0; kb < 8; ++kb) {
                asm volatile("" ::: "memory");
                if ((kb & 1) == 0 && kb + 2 < 8) {
#pragma unroll
                    for (int i = 0; i < 8; ++i) KLOAD(pk[((kb >> 1) + 1) & 1][i], kb + 2 + (i >> 2), i & 3);
                }
#pragma unroll
                for (int q = 0; q < 4; ++q) *(LAS v4u*)(vb + ((lane >> 3) + 8 * q) * VB_LD + (lane & 7) * 16) = pk[(kb >> 1) & 1][4 * (kb & 1) + q];
                asm volatile("" ::: "memory");
#pragma unroll
                for (int t2 = 0; t2 < 2; ++t2) { const LAS unsigned char* kr = vb + (16 * t2 + hcol) * VB_LD + 16 * g;
                    const bf16x8 a0 = *(const LAS bf16x8*)kr, a1 = *(const LAS bf16x8*)(kr + 64);
                    f32x4 s = {0.f, 0.f, 0.f, 0.f};
                    s = __builtin_amdgcn_mfma_f32_16x16x32_bf16(a0, qf[0], s, 0, 0, 0);
                    S[2 * kb + t2] = __builtin_amdgcn_mfma_f32_16x16x32_bf16(a1, qf[1], s, 0, 0, 0); }
                asm volatile("" ::: "memory");
            }
#undef KLOAD
        }
        if (cnt < TOPK) {
#pragma unroll
            for (int tl = 0; tl < 16; ++tl) { const int p0i = 16 * tl + 4 * g;
                S[tl].x = p0i + 0 < cnt ? S[tl].x : -INFINITY; S[tl].y = p0i + 1 < cnt ? S[tl].y : -INFINITY; S[tl].z = p0i + 2 < cnt ? S[tl].z : -INFINITY; S[tl].w = p0i + 3 < cnt ? S[tl].w : -INFINITY; } }
        if (MODE == 3) { float sacc = 0.f;
#pragma unroll
            for (int tl = 0; tl < 16; ++tl) sacc += S[tl].x + S[tl].w; if (sacc == 1234.5f) *(float*)(B.X) = sacc; continue; }
#define VLOAD(dst, kb_, q_) do { const int kl_ = (lane >> 3) + 8 * (q_), part_ = lane & 7; const unsigned kidx_ = list[32 * (kb_) + kl_]; \
            if (SMP && kidx_ < (unsigned)PAST) { const float* vp_ = cvb + ((size_t)ptb[kidx_ >> 7] * PAGE + (kidx_ & 127u)) * KVD + 64 * nk + 8 * part_; \
                const f32x4 u0_ = *(const f32x4*)vp_, u1_ = *(const f32x4*)(vp_ + 4); (dst).x = pk_bf16(u0_.x, u0_.y); (dst).y = pk_bf16(u0_.z, u0_.w); (dst).z = pk_bf16(u1_.x, u1_.y); (dst).w = pk_bf16(u1_.z, u1_.w); \
            } else (dst) = *(const v4u*)(kvb + ((SMP ? kidx_ - PAST : kidx_) * 512u + (unsigned)(256 + 128 * nk + 16 * part_))); } while (0)
        v4u pv[2][8];
        if (!SMP) {
#pragma unroll
            for (int i = 0; i < 8; ++i) VLOAD(pv[0][i], i >> 2, i & 3);
        }
        float mx = -INFINITY;
#pragma unroll
        for (int tl = 0; tl < 16; ++tl) mx = fmaxf(fmaxf(mx, fmaxf(S[tl].x, S[tl].y)), fmaxf(S[tl].z, S[tl].w));
        mx = fmaxf(mx, __shfl_xor(mx, 16)); mx = fmaxf(mx, __shfl_xor(mx, 32));
        const float mx2 = mx * LOG2E; float sum = 0.f;
#pragma unroll
        for (int tl = 0; tl < 16; ++tl) { S[tl].x = __builtin_amdgcn_exp2f(S[tl].x * LOG2E - mx2); S[tl].y = __builtin_amdgcn_exp2f(S[tl].y * LOG2E - mx2); S[tl].z = __builtin_amdgcn_exp2f(S[tl].z * LOG2E - mx2); S[tl].w = __builtin_amdgcn_exp2f(S[tl].w * LOG2E - mx2);
            sum += (S[tl].x + S[tl].y) + (S[tl].z + S[tl].w); }
        sum += __shfl_xor(sum, 16); sum += __shfl_xor(sum, 32);
        f32x4 O[4];
#pragma unroll
        for (int dt = 0; dt < 4; ++dt) O[dt] = (f32x4){0.f, 0.f, 0.f, 0.f};
#pragma unroll
        for (int kb = 0; kb < 8; ++kb) {
            asm volatile("" ::: "memory");
            if (SMP) {
#pragma unroll
                for (int q = 0; q < 4; ++q) VLOAD(pv[0][q], kb, q);
            } else if ((kb & 1) == 0 && kb + 2 < 8) {
#pragma unroll
                for (int i = 0; i < 8; ++i) VLOAD(pv[((kb >> 1) + 1) & 1][i], kb + 2 + (i >> 2), i & 3);
            }
#pragma unroll
            for (int q = 0; q < 4; ++q) *(LAS v4u*)(vb + ((lane >> 3) + 8 * q) * VB_LD + (lane & 7) * 16) = SMP ? pv[0][q] : pv[(kb >> 1) & 1][4 * (kb & 1) + q];
            asm volatile("" ::: "memory");
            v4u pw; pw.x = pk_bf16(S[2 * kb].x, S[2 * kb].y); pw.y = pk_bf16(S[2 * kb].z, S[2 * kb].w); pw.z = pk_bf16(S[2 * kb + 1].x, S[2 * kb + 1].y); pw.w = pk_bf16(S[2 * kb + 1].z, S[2 * kb + 1].w);
            const bf16x8 pf = __builtin_bit_cast(bf16x8, pw);
#pragma unroll
            for (int dt = 0; dt < 4; ++dt) {
                const LAS unsigned char* ta = vb + (4 * g + (hcol >> 2)) * VB_LD + (16 * dt + 4 * (hcol & 3)) * 2;
                const s16x4 lo = __builtin_bit_cast(s16x4, __builtin_amdgcn_ds_read_tr16_b64_v4i16((LAS s16x4*)ta));
                const s16x4 hi = __builtin_bit_cast(s16x4, __builtin_amdgcn_ds_read_tr16_b64_v4i16((LAS s16x4*)(ta + 16 * VB_LD)));
                const bf16x8 af = {lo.x, lo.y, lo.z, lo.w, hi.x, hi.y, hi.z, hi.w};
                O[dt] = __builtin_amdgcn_mfma_f32_16x16x32_bf16(af, pf, O[dt], 0, 0, 0); }
            asm volatile("" ::: "memory");
        }
#undef VLOAD
        if (hcol < 4 && (MODE == 0 || sum == 123.456f)) { const float inv = 1.f / sum;
#pragma unroll
            for (int dt = 0; dt < 4; ++dt) { v2u w; w.x = pk_bf16(O[dt].x * inv, O[dt].y * inv); w.y = pk_bf16(O[dt].z * inv, O[dt].w * inv);
                *(v2u*)(B.CA + (size_t)m * DM + DCONV + (4 * nk + hcol) * 64 + 16 * dt + 4 * g) = w; } }
    }
    asm volatile("s_waitcnt lgkmcnt(0)" ::: "memory");
}
constexpr int NPHASE = 1 + 9 * DEPTH;
constexpr int I_IN = (DM / 64) * ((DIN + 31) / 32), I_C = (DCONV / 64) * (DM / 32), I_A = (DATT / 64) * (DM / 32), I_O = (DM / 64) * (DM / 32), I_1 = (DM / 64) * (DFF / 32), I_2 = (DFF / 64) * (DM / 32);
constexpr int I_L = I_IN + I_C + I_A + I_O + I_1 + I_2;
#ifndef PH_MASK
#define PH_MASK 0x3FF
#endif
#define PH_ON(k) (((PH_MASK) >> (k)) & 1)
#ifndef REP_PH
#define REP_PH -1
#endif
#ifndef REP_N
#define REP_N 1
#endif
#define REPS(k) for (int rep_ = 0; rep_ <= ((REP_PH) == (k) ? (REP_N) : 0); ++rep_)
__global__ void __launch_bounds__(NTHR, 2) fwd(Args args) {
    extern __shared__ __attribute__((aligned(16))) unsigned char lds_[];
    LAS unsigned char* lds = (LAS unsigned char*)lds_;
    volatile LAS unsigned* MISC = (volatile LAS unsigned*)(lds + MISC_OFF);
    const int tid = threadIdx.x, lane = tid & 63, wave = __builtin_amdgcn_readfirstlane(tid >> 6);
    const int G = gridDim.x; const int bx = blockIdx.x; const int vcu = (G % 8 == 0) ? (bx % 8) * (G / 8) + bx / 8 : bx;
    const int gw = vcu * NWAVES + wave, NGW = G * NWAVES;
    unsigned* ctl = (unsigned*)(args.ws + WS_CTL);
    for (int u = tid; u < (LDS_BYTES - LDSCTL_OFF) / 4; u += NTHR) ((LAS unsigned*)(lds + LDSCTL_OFF))[u] = 0u;
    __syncthreads();
    (void)xcd_barrier_post(ctl + CW_BAR, MISC + 8);
#define KAS __attribute__((address_space(4)))
#define ARGP(i) (*(const float* KAS const*)(ka_ + 8 * (i)))
#define MKBUFS() int tid_ = threadIdx.x; asm volatile("" : "+v"(tid_)); const int lane = tid_ & 63; (void)lane; const int wave = __builtin_amdgcn_readfirstlane(tid_ >> 6); (void)wave; \
    int G = gridDim.x, bx = blockIdx.x; asm volatile("" : "+s"(G), "+s"(bx)); const int vcu = (G % 8 == 0) ? (bx % 8) * (G / 8) + bx / 8 : bx; const int gw = vcu * NWAVES + wave, NGW = G * NWAVES; (void)gw; (void)NGW; \
    const KAS unsigned char* ka_ = (const KAS unsigned char*)__builtin_amdgcn_kernarg_segment_ptr(); asm volatile("" : "+s"(ka_)); \
    unsigned char* ws = *(unsigned char* KAS const*)(ka_ + 200); float* outp_ = *(float* KAS const*)(ka_ + 192); \
    Bufs B{}; B.X = (float*)(ws + WS_X); B.H = (bf16_t*)(ws + WS_H); B.U = (float*)(ws + WS_U); B.XC = (float*)(ws + WS_XC); B.QB = (bf16_t*)(ws + WS_QB); B.KV = (bf16_t*)(ws + WS_KV); \
    B.QI = (bf16_t*)(ws + WS_QI); B.KI = (bf16_t*)(ws + WS_KI); B.WI = (float*)(ws + WS_WI); B.G = (_Float16*)(ws + WS_G); B.CA = (bf16_t*)(ws + WS_CA); B.PA = (bf16_t*)(ws + WS_PA); \
    B.AT = (bf16_t*)(ws + WS_AT); B.MB = (bf16_t*)(ws + WS_MB); B.R = (bf16_t*)(ws + WS_R); B.SC = (_Float16*)(ws + WS_SC); B.SCS = (_Float16*)(ws + WS_SCS); \
    B.rc = (const float*)(ws + WS_ROPE); B.rs = B.rc + (T + ST) * 32; B.out = outp_;
#define IN(k) (args.ph_lo <= (k) && (k) < args.ph_hi)
#define GRIDBAR() do { XcdBarrier b_; b_.bar = (unsigned*)(args.ws + WS_CTL) + CW_BAR; b_.x = xb_xcc_id(); b_.st = (volatile LAS unsigned*)(lds + MISC_OFF) + 8; xcd_barrier(b_); } while (0)
#define SEAM(k) do { if (IN(k) && IN((k) + 1)) GRIDBAR(); } while (0)

    REPS(9) if (PH_ON(9) && IN(0)) { MKBUFS();
        LAS float* scr = (LAS float*)(lds + wave * 16384);
#define WCONV_ITEM(l_, r_in, scr_) do { const int wl_ = (l_); int r = (r_in); unsigned char* wb = ws + WS_W + (size_t)wl_ * W_LSTRIDE; \
            if (r < I_IN) { transpose_item<true>(ARGP(9) + (size_t)wl_ * DM * DIN, DM, DIN, (bf16_t*)(wb + WO_IN), scr_, r, lane, ARGP(8) + wl_ * DM); break; } r -= I_IN; \
            if (r < I_C) { transpose_item<false>(ARGP(14) + (size_t)wl_ * DCONV * DM, DCONV, DM, (bf16_t*)(wb + WO_C), scr_, r, lane, nullptr, DM, 0); break; } r -= I_C; \
            if (r < I_A) { transpose_item<false>(ARGP(15) + (size_t)wl_ * DATT * DM, DATT, DM, (bf16_t*)(wb + WO_C), scr_, r, lane, nullptr, DM, DCONV); break; } r -= I_A; \
            if (r < I_O) { transpose_item<false>(ARGP(19) + (size_t)wl_ * DM * DM, DM, DM, (bf16_t*)(wb + WO_O), scr_, r, lane); break; } r -= I_O; \
            if (r < I_1) { transpose_item<false>(ARGP(21) + (size_t)wl_ * DM * DFF, DM, DFF, (bf16_t*)(wb + WO_1), scr_, r, lane, ARGP(20) + wl_ * DM); break; } r -= I_1; \
            transpose_item<false>(ARGP(22) + (size_t)wl_ * DFF * DM, DFF, DM, (bf16_t*)(wb + WO_2), scr_, r, lane); } while (0)
        for (int it = gw; it < I_L; it += NGW) WCONV_ITEM(0, it, scr);
        for (int it = gw; it < DEPTH * 184; it += NGW) { const int l = it / 184, r = 7 * 256 + 72 + it % 184; bf16_t* p = (bf16_t*)(ws + WS_W + (size_t)l * W_LSTRIDE + WO_IN) + (size_t)r * DM;
            *((v4u*)p + lane) = (v4u){0u, 0u, 0u, 0u}; *((v4u*)p + 64 + lane) = (v4u){0u, 0u, 0u, 0u}; }
        for (int it = gw; it < DEPTH * DM; it += NGW) { const int l = it / DM, j = it % DM; const int c0 = 4 * lane, g = c0 >> 6, cl = c0 & 63;
            const float* pw = ARGP(16) + (((size_t)l * 4 + g) * 64 + cl) * 64; const float* ps = ARGP(17) + l * DPOOL + 64 * g; const float* wo = ARGP(18) + ((size_t)l * DPOOL + 64 * g) * DM + j;
            float a0 = 0.f, a1 = 0.f, a2 = 0.f, a3 = 0.f;
#pragma unroll 16
            for (int d = 0; d < 64; ++d) { const float f = ps[d] * wo[(size_t)d * DM]; a0 += pw[d] * f; a1 += pw[64 + d] * f; a2 += pw[128 + d] * f; a3 += pw[192 + d] * f; }
            v2u w; w.x = pk_bf16(a0, a1); w.y = pk_bf16(a2, a3);
            *(v2u*)((bf16_t*)(ws + WS_W + (size_t)l * W_LSTRIDE + WO_C) + (size_t)j * DM + (DCONV + DATT) + c0) = w; }
        {
            const double invr = exp(-(double)(tid_ & 31) / 32.0 * log(10000.0)) * 0.15915494309189535;
            for (int i = (vcu * NTHR + tid_); i < (T + ST) * 32; i += G * NTHR) { const int p = i >> 5; const double pos = p < T ? (double)p : (double)(PAST + p - T);
                const double tr = pos * invr; const float fr = (float)(tr - rint(tr)); ((float*)B.rc)[i] = __builtin_amdgcn_cosf(fr); ((float*)B.rs)[i] = __builtin_amdgcn_sinf(fr); } }
        for (int m = gw; m < M; m += 2 * NGW) { const int m2 = m + NGW; const bool has2 = m2 < M, sa_ = m >= MP, sb_ = m2 >= MP;
            prep_row2(sa_ ? ARGP(1) + (size_t)(m - MP) * DM : ARGP(0) + (size_t)m * DM, B.H + (size_t)m * DM, sa_ ? (float*)(ws + WS_SSQBS) + (size_t)(m - MP) * 64 : (float*)(ws + WS_SSQB) + (size_t)m * 16, sa_ ? 64 : 16,
                      sb_ ? ARGP(1) + (size_t)(m2 - MP) * DM : ARGP(0) + (size_t)m2 * DM, B.H + (size_t)m2 * DM, sb_ ? (float*)(ws + WS_SSQBS) + (size_t)(m2 - MP) * 64 : (float*)(ws + WS_SSQB) + (size_t)m2 * 16, sb_ ? 64 : 16, has2, lane); }
    }
    SEAM(0);

    for (int l = 0; l < DEPTH; ++l) {
        const int pb = 1 + 9 * l;
#define MKW() unsigned char* wb = ws + WS_W + (size_t)l * W_LSTRIDE; \
        const bf16_t* Win_t = (const bf16_t*)(wb + WO_IN); const bf16_t* Wc_t = (const bf16_t*)(wb + WO_C); const bf16_t* Wa_t = (const bf16_t*)(wb + WO_A); const bf16_t* Wp_t = (const bf16_t*)(wb + WO_P); \
        const bf16_t* Wo_t = (const bf16_t*)(wb + WO_O); const bf16_t* W1_t = (const bf16_t*)(wb + WO_1); const bf16_t* W2_t = (const bf16_t*)(wb + WO_2); (void)Win_t; (void)Wc_t; (void)Wa_t; (void)Wp_t; (void)Wo_t; (void)W1_t; (void)W2_t;

        REPS(0) if (PH_ON(0) && IN(pb + 0)) { MKBUFS(); MKW();
            pg8::Gemm g{B.H, Win_t, M, NIN, DM}; pg8::StaticOrder S; S.init(M, NIN, G, bx);
            LAS float* rst = (LAS float*)(lds + RST_OFF);
            { int pms[8];
#pragma unroll
                for (int i = 0; i < 8; ++i) { pg8::Unit uu; pms[i] = S.next(i, uu) ? uu.pm : -1; }
                float rv[8]; const int r_ = tid_ & 255;
#pragma unroll
                for (int i = 0; i < 8; ++i) rv[i] = pms[i] >= 0 ? row_ms_inv(ws, WS_SSQB, WS_SSQBS, (unsigned)(pms[i] * 256 + r_)) : 0.f;
#pragma unroll
                for (int i = 0; i < 8; ++i) if (tid_ < 256) rst[i * 256 + r_] = sqrtf(rv[i]); }
            __syncthreads();
#ifdef INPROJ_NULL_REP
            if (rep_ > 0) { EpiNull EN{(float*)(ws + WS_TMP + 200 * MiB)}; pg8::gemm_phase<EpiNull, pg8::StaticOrder, true, true>(lds, g, S, EN); } else
#endif
            { EpiInproj E{ws, (unsigned char*)outp_, l, rst};
            pg8::gemm_phase<EpiInproj, pg8::StaticOrder, true, true>(lds, g, S, E); }
            if (l == 0 && DEPTH > 1 && rep_ == 0) { pg8::Unit uu; const int nfull = (M / 256) * (NIN / 256) - (G > 0 ? ((M / 256) * (NIN / 256) / G) * G : 0);
                if (!S.next(((M / 256) * (NIN / 256)) / G, uu)) { const int nlight = G - nfull; LAS float* scr2 = (LAS float*)(lds + wave * 16384);
                    for (int it = (bx - nfull) * NWAVES + wave; it < I_L; it += nlight * NWAVES) WCONV_ITEM(1, it, scr2); } }
        }
        SEAM(pb + 0);
#ifdef EXTRA_BARS
        for (int eb = 0; eb < EXTRA_BARS; ++eb) GRIDBAR();
#endif
        REPS(1) if (PH_ON(1) && IN(pb + 1)) { MKBUFS();
            P2Args P{ARGP(5), ARGP(6), ARGP(10), ARGP(11), ARGP(12), ARGP(13), ARGP(4), (const int*)ARGP(7)};
            LAS float* wl = (LAS float*)(lds + 40960);
            for (int i = tid_; i < 48 * DCONV / 4; i += NTHR) { const int j = i / (DCONV / 4) - 8; ((LAS f32x4*)wl)[i] = (j >= 0 && j < CONVW) ? ((const f32x4*)(P.conv_w + (size_t)l * CONVW * DCONV))[i - 8 * (DCONV / 4)] : (f32x4){0.f, 0.f, 0.f, 0.f}; }
            __syncthreads();
#ifndef P2_REP_MODE
#define P2_REP_MODE 0
#endif
#ifndef P2_UNIT_ABL
#define P2_UNIT_ABL 0
#endif
            const int p2m = rep_ > 0 ? P2_REP_MODE : 0;
            {
                volatile LAS unsigned* q2 = MISC + 24 + l + 2 * rep_;
                const int vS = vcu, vC = (vcu + G - G / 3) % G, vT = (vcu + G - 2 * (G / 3)) % G;
                const int nS = (p2m == 0 || p2m == 1) ? (SB * NPAGES + SB - vS + G - 1) / G : 0, nC = (p2m == 0 || p2m == 2) ? (MP / 8 + SB - vC + G - 1) / G : 0, nT = (p2m == 0 || p2m == 2) ? (NB * 45 + SB * 45 - vT + G - 1) / G : 0;
                for (;;) { unsigned it = 0; if (lane == 0) it = __hip_atomic_fetch_add((LAS unsigned*)q2, 1u, __ATOMIC_RELAXED, __HIP_MEMORY_SCOPE_WORKGROUP); it = __builtin_amdgcn_readfirstlane(it);
                    int j = (int)it; if (j >= nS + 2 * nC + nT) break;
                    { const int ng = (nS >> 1) < nC ? (nS >> 1) : nC;
                        if (j < 3 * ng) { const int gq = j / 3, gr = j - 3 * gq;
                            if (gr < 2) scores_sample_task(B, P, l, vS + G * (2 * gq + gr), lane, lds + wave * (32 * KI_LD)); else conv_task(B, P, l, vC + G * gq, lane, wl);
                            continue; }
                        j -= 3 * ng;
                        if (j < nS - 2 * ng) { scores_sample_task(B, P, l, vS + G * (2 * ng + j), lane, lds + wave * (32 * KI_LD)); continue; } j -= nS - 2 * ng;
                        if (j < nC - ng) { conv_task(B, P, l, vC + G * (ng + j), lane, wl); continue; } j -= nC - ng; }
                    if (j < nC) { pool_task(B, P, l, vC + G * j, lane); continue; } j -= nC;
                    states_task(B, P, l, vT + G * j, lane); }
            }
            __syncthreads();
            int tid2 = threadIdx.x; asm volatile("" : "+v"(tid2));
            if (p2m == 0 || p2m == 3) for (int u = bx; u < 2 * (T / 32); u += G) { const int b = u < T / 32 ? 0 : 1, qb = u < T / 32 ? u : 2 * (T / 32) - 1 - u; scores_prompt_unit(B, lds, b, qb, tid2, rep_ > 0 ? P2_UNIT_ABL : 0); }
        }
        SEAM(pb + 1);
        REPS(2) if (PH_ON(2) && IN(pb + 2)) { MKBUFS();
            P3Args P3{ARGP(2), ARGP(3), (const int*)ARGP(7)};
            LAS unsigned char* wl = lds + wave * WL_BYTES;
            volatile LAS unsigned* qhead = MISC + 16 + l + 2 * rep_;
            const int nprompt = (MP - vcu + G - 1) / G; const int nconv = 0;
            for (;;) { unsigned it = 0; if (lane == 0) it = __hip_atomic_fetch_add((LAS unsigned*)qhead, 1u, __ATOMIC_RELAXED, __HIP_MEMORY_SCOPE_WORKGROUP); it = __builtin_amdgcn_readfirstlane(it);
                if ((int)it > nprompt + nconv) break;
                if ((int)it > nprompt) { WCONV_ITEM(1, vcu + G * ((int)it - nprompt - 1), (LAS float*)wl); continue; }
#ifdef P3_REP_SAMPLE_ONLY
                if (rep_ > 0 && it > 0) break;
                if (it == 0) { if (vcu < MS) select_attend_task<true>(B, P3, l, MP + vcu, lane, wl); }
#else
                if (it == 0) { if (vcu < MS && rep_ == 0) select_attend_task<true>(B, P3, l, MP + vcu, lane, wl); }
#endif
                else {
#ifdef P3_REP_MODE
                    if (rep_ > 0) select_attend_task<false, P3_REP_MODE>(B, P3, l, vcu + G * ((int)it - 1), lane, wl); else
#endif
                    select_attend_task<false>(B, P3, l, vcu + G * ((int)it - 1), lane, wl); } }
        }
        SEAM(pb + 2);
        REPS(3) if (PH_ON(3) && IN(pb + 3)) { MKBUFS(); MKW();
            const bf16_t* Wcat = Wc_t;
            for (int tk = wave * G + vcu; tk < 16 * (DM / 16); tk += NGW) { const int mt = tk & 15, nt = tk >> 4;
                const bf16_t* As = B.CA + (size_t)MP * DM;
                const f32x4 ya = sg_tile(As, DM, Wcat, DCONV, mt, nt, lane, DM), yb = sg_tile(As + DCONV, DM, Wcat + DCONV, DATT, mt, nt, lane, DM),
                            yc = sg_tile(As + DCONV + DATT, DM, Wcat + DCONV + DATT, DPOOL, mt, nt, lane, DM);
                const size_t row = (size_t)MP + 16 * mt + (lane & 15); const int col = 16 * nt + 4 * (lane >> 4); const _Float16* gp = B.G + row * 3072 + col;
                const f16x4 ga = *(const f16x4*)gp, gb = *(const f16x4*)(gp + 1024), gc = *(const f16x4*)(gp + 2048); float r[4];
#pragma unroll
                for (int e = 0; e < 4; ++e) r[e] = (float)ga[e] * ya[e] + (float)gb[e] * yb[e] + (float)gc[e] * yc[e];
                v2u w; w.x = pk_bf16(r[0], r[1]); w.y = pk_bf16(r[2], r[3]); *(v2u*)(B.MB + row * DM + col) = w; }
            pg8::Gemm g{B.CA, Wcat, MP, DM, DM}; pg8::StaticOrder S; S.init(MP, DM, G, bx); EpiGate E{B.MB, B.G};
            pg8::gemm_phase<EpiGate, pg8::StaticOrder, false, true>(lds, g, S, E);
        }
        SEAM(pb + 3);
        REPS(4) if (PH_ON(4) && IN(pb + 4)) { MKBUFS(); MKW();
            float* ssq_p = (float*)(ws + WS_SSQA); float* ssq_s = (float*)(ws + WS_SSQAS);
            for (int tk = (wave & 3) * G + vcu; tk < 16 * (DM / 16); tk += 4 * G) { const int mt = tk & 15, nt = tk >> 4;
                f32x4 y = sg_tile(B.MB + (size_t)MP * DM + (wave >> 2) * (DM / 2), DM, Wo_t + (wave >> 2) * (DM / 2), DM / 2, mt, nt, lane, DM);
                LAS f32x4* slot = (LAS f32x4*)(lds + RST_OFF) + (wave & 3) * 64 + lane;
                if (wave >= 4) *slot = y;
                __syncthreads();
                if (wave >= 4) continue;
                { const f32x4 y2 = *slot; y.x += y2.x; y.y += y2.y; y.z += y2.z; y.w += y2.w; }
                const size_t ro = ((size_t)MP + 16 * mt + (lane & 15)) * DM + 16 * nt + 4 * (lane >> 4);
                v2u* p = (v2u*)(B.H + ro); const v2u h = *p; f32x4 o; o.x = __uint_as_float(h.x << 16) + y.x; o.y = __uint_as_float(h.x & 0xffff0000u) + y.y; o.z = __uint_as_float(h.y << 16) + y.z; o.w = __uint_as_float(h.y & 0xffff0000u) + y.w;
                v2u hw; hw.x = pk_bf16(o.x, o.y); hw.y = pk_bf16(o.z, o.w); *p = hw;
                float ss = (o.x * o.x + o.y * o.y) + (o.z * o.z + o.w * o.w); ss += __shfl_xor(ss, 16); ss += __shfl_xor(ss, 32);
                if ((lane >> 4) == 0) ssq_s[(size_t)(16 * mt + (lane & 15)) * 64 + nt] = ss; }
            pg8::Gemm g{B.MB, Wo_t, MP, DM, DM}; pg8::StaticOrder S; S.init(MP, DM, G, bx); EpiResid E{B.H, ssq_p};
            pg8::gemm_phase<EpiResid, pg8::StaticOrder, false, true>(lds, g, S, E);
        }
        if (IN(pb + 4) && IN(pb + 6)) GRIDBAR();
        REPS(6) if (PH_ON(6) && IN(pb + 6)) { MKBUFS(); MKW();
            for (int tk = wave * G + vcu; tk < 16 * (DFF / 16); tk += NGW) { const int mt = tk & 15, nt = tk >> 4;
                const f32x4 y = sg_tile(B.H + (size_t)MP * DM, DM, W1_t, DM, mt, nt, lane); float r[4];
                const float r2 = row_ms_inv(ws, WS_SSQA, WS_SSQAS, (unsigned)(MP + 16 * mt + (lane & 15)));
#pragma unroll
                for (int e = 0; e < 4; ++e) { const float x = fmaxf(y[e], 0.f); r[e] = x * x * r2; }
                v2u w; w.x = pk_bf16(r[0], r[1]); w.y = pk_bf16(r[2], r[3]); *(v2u*)(B.R + ((size_t)MP + 16 * mt + (lane & 15)) * DFF + 16 * nt + 4 * (lane >> 4)) = w; }
            pg8::Gemm g{B.H, W1_t, MP, DFF, DM}; pg8::StaticOrder S; S.init(MP, DFF, G, bx);
            LAS float* rst = (LAS float*)(lds + RST_OFF);
            { int pms[4];
#pragma unroll
                for (int i = 0; i < 4; ++i) { pg8::Unit uu; pms[i] = S.next(i, uu) ? uu.pm : -1; }
                float rv[4]; const int r_ = tid_ & 255;
#pragma unroll
                for (int i = 0; i < 4; ++i) rv[i] = pms[i] >= 0 ? row_ms_inv(ws, WS_SSQA, WS_SSQAS, (unsigned)(pms[i] * 256 + r_)) : 0.f;
#pragma unroll
                for (int i = 0; i < 4; ++i) if (tid_ < 256) rst[i * 256 + r_] = rv[i]; }
            __syncthreads();
            EpiRelu2 E{B.R, DFF, rst};
            pg8::gemm_phase<EpiRelu2, pg8::StaticOrder, true, true>(lds, g, S, E);
        }
        SEAM(pb + 6);
        REPS(7) if (PH_ON(7) && IN(pb + 7)) { MKBUFS(); MKW();
            float* ssq_p = (float*)(ws + WS_SSQB); float* ssq_s = (float*)(ws + WS_SSQBS);
            for (int tk = (wave & 3) * G + vcu; tk < 16 * (DM / 16); tk += 4 * G) { const int mt = tk & 15, nt = tk >> 4;
                f32x4 y = sg_tile(B.R + (size_t)MP * DFF + (wave >> 2) * (DFF / 2), DFF, W2_t + (wave >> 2) * (DFF / 2), DFF / 2, mt, nt, lane, DFF);
                LAS f32x4* slot = (LAS f32x4*)(lds + RST_OFF) + (wave & 3) * 64 + lane;
                if (wave >= 4) *slot = y;
                __syncthreads();
                if (wave >= 4) continue;
                { const f32x4 y2 = *slot; y.x += y2.x; y.y += y2.y; y.z += y2.z; y.w += y2.w; }
                const size_t ro = ((size_t)MP + 16 * mt + (lane & 15)) * DM + 16 * nt + 4 * (lane >> 4);
                v2u* p = (v2u*)(B.H + ro); const v2u h = *p; f32x4 o; o.x = __uint_as_float(h.x << 16) + y.x; o.y = __uint_as_float(h.x & 0xffff0000u) + y.y; o.z = __uint_as_float(h.y << 16) + y.z; o.w = __uint_as_float(h.y & 0xffff0000u) + y.w;
                v2u hw; hw.x = pk_bf16(o.x, o.y); hw.y = pk_bf16(o.z, o.w); *p = hw;
                float ss = (o.x * o.x + o.y * o.y) + (o.z * o.z + o.w * o.w); ss += __shfl_xor(ss, 16); ss += __shfl_xor(ss, 32);
                if ((lane >> 4) == 0) ssq_s[(size_t)(16 * mt + (lane & 15)) * 64 + nt] = ss; }
            pg8::Gemm g{B.R, W2_t, MP, DM, DFF}; pg8::StaticOrder S; S.init(MP, DM, G, bx); EpiResid E{B.H, ssq_p};
            pg8::gemm_phase<EpiResid, pg8::StaticOrder, false, true>(lds, g, S, E);
        }
        if (l + 1 == DEPTH) { SEAM(pb + 7);
            REPS(8) if (PH_ON(8) && IN(pb + 8)) { MKBUFS(); MKW();
                for (int m = gw; m < M; m += 2 * NGW) { const int m2 = m + NGW; const bool has2 = m2 < M;
                    rms_row_bf2(B.H + (size_t)m * DM, B.out + (m < MP ? O_YP + (size_t)m * DM : O_YS + (size_t)(m - MP) * DM),
                                B.H + (size_t)m2 * DM, B.out + (m2 < MP ? O_YP + (size_t)m2 * DM : O_YS + (size_t)(m2 - MP) * DM), has2, ARGP(23), lane); } }
        } else { if (IN(pb + 7) && IN(pb + 9)) GRIDBAR(); }
    }
#undef IN
#undef SEAM
}
extern "C" void kernel_launch(void* const* d_in, const int* in_sizes, int n_in, void* d_out, int out_size, void* d_ws, size_t ws_size, hipStream_t stream) {
    if (n_in != 24 || (size_t)out_size != O_END || ws_size < WS_END) { fprintf(stderr, "kernel_launch: unexpected sizes n_in %d out %d ws %zu\n", n_in, out_size, ws_size); return; }
    static int grid = 0;
    if (grid == 0) {
        int dev = 0, cus = 0, per_cu = 0;
        if (hipGetDevice(&dev) != hipSuccess || hipDeviceGetAttribute(&cus, hipDeviceAttributeMultiprocessorCount, dev) != hipSuccess) { fprintf(stderr, "kernel_launch: device query failed\n"); grid = -1; return; }
        if (hipFuncSetAttribute((const void*)fwd, hipFuncAttributeMaxDynamicSharedMemorySize, LDS_BYTES) != hipSuccess) { fprintf(stderr, "kernel_launch: hipFuncSetAttribute failed\n"); grid = -1; return; }
        if (hipOccupancyMaxActiveBlocksPerMultiprocessor(&per_cu, (const void*)fwd, NTHR, LDS_BYTES) != hipSuccess || per_cu < 1) { fprintf(stderr, "kernel_launch: occupancy query says %d\n", per_cu); }
        (void)hipGetLastError();
        grid = cus;
    }
    if (grid < 0) return;
    unsigned char* ws = (unsigned char*)d_ws;
    Args a{}; for (int i = 0; i < 24; ++i) a.in[i] = (const float*)d_in[i]; a.out = (float*)d_out; a.ws = ws; a.ph_lo = 0; a.ph_hi = NPHASE;
    (void)hipMemsetAsync(ws + WS_CTL, 0, CTL_ZERO_BYTES, stream);
    hipLaunchKernelGGL(fwd, dim3(grid), dim3(NTHR), LDS_BYTES, stream, a);
}
```

```cpp
#include <hip/hip_runtime.h>
#include <cstdio>
#include <cstdint>

constexpr int DM = 1024, NB = 2, T = 8192, DEPTH = 2, SB = 32, ST = 8, PAST = 16384, PAGE = 128, NPAGES = PAST / PAGE;
constexpr int NPOOL = 5120;
constexpr int DCONV = 256, CONVW = 31, CHIST = 30, HD = 64, DATT = 512, NH = 8, NKV = 2, KVD = 128, IH = 8, ID = 64, TOPK = 256;
constexpr int DPOOL = 256, PHIST = 15, DFF = 4096, DIN = 5192;
constexpr int MP = NB * T, MS = SB * ST, M = MP + MS;
constexpr int C_AIN = 0, C_AGATE = 256, C_Q = 512, C_K = 1024, C_V = 1152, C_QI = 1280, C_KI = 1792, C_WI = 1856, C_XC = 1864, C_G = 2120;
constexpr int SCS_LD = 16896;
constexpr float RMS_EPS = 1e-6f, LN_EPS = 1e-5f;
constexpr float WI_SCALE = 0.04419417382415922f;

constexpr size_t O_YP = 0, O_YS = O_YP + (size_t)MP * DM, O_KP = O_YS + (size_t)MS * DM, O_VP = O_KP + (size_t)DEPTH * MP * KVD,
                 O_KIP = O_VP + (size_t)DEPTH * MP * KVD, O_CP = O_KIP + (size_t)DEPTH * MP * ID, O_PP = O_CP + (size_t)DEPTH * NB * CHIST * DCONV,
                 O_KS = O_PP + (size_t)DEPTH * NB * PHIST * DPOOL, O_VS = O_KS + (size_t)DEPTH * MS * KVD, O_KIS = O_VS + (size_t)DEPTH * MS * KVD,
                 O_CS = O_KIS + (size_t)DEPTH * MS * ID, O_PS = O_CS + (size_t)DEPTH * SB * CHIST * DCONV, O_END = O_PS + (size_t)DEPTH * SB * PHIST * DPOOL;

constexpr size_t MiB = 1u << 20;
constexpr size_t WS_ROPE = 64 * MiB;
constexpr size_t WS_X = 80 * MiB;
constexpr size_t WS_H = 160 * MiB;
constexpr size_t WS_U = 200 * MiB;
constexpr size_t WS_XC = 220 * MiB;
constexpr size_t WS_QB = 240 * MiB;
constexpr size_t WS_KV = 260 * MiB;
constexpr size_t WS_QI = 272 * MiB;
constexpr size_t WS_KI = 292 * MiB;
constexpr size_t WS_WI = 296 * MiB;
constexpr size_t WS_G = 300 * MiB;
constexpr size_t WS_CA = 404 * MiB;
constexpr size_t WS_PA = 414 * MiB;
constexpr size_t WS_AT = 424 * MiB;
constexpr size_t WS_MB = 444 * MiB;
constexpr size_t WS_R = 480 * MiB;
constexpr size_t WS_SC = 620 * MiB;
constexpr size_t WS_SCS = 880 * MiB;
constexpr size_t WS_TMP = 900 * MiB;
constexpr size_t WS_TMP2 = 1260 * MiB;
constexpr size_t WS_END = 1500 * MiB;

typedef unsigned short bf16_t;
__device__ __forceinline__ float bf2f(bf16_t v) { return __builtin_bit_cast(float, (unsigned)v << 16); }
__device__ __forceinline__ bf16_t f2bf(float f) { unsigned u = __builtin_bit_cast(unsigned, f); return (bf16_t)((u + 0x7fffu + ((u >> 16) & 1u)) >> 16); }
__device__ __forceinline__ float sigmoidf_(float x) { return 1.f / (1.f + __expf(-x)); }

__device__ __forceinline__ int rope_row(int m) { return m < MP ? (m & (T - 1)) : T + ((m - MP) & (ST - 1)); }

struct Bufs { float* X; bf16_t* H; float* U; float* XC; bf16_t* QB; bf16_t* KV; bf16_t* QI; bf16_t* KI; float* WI; _Float16* G; bf16_t* CA; bf16_t* PA; bf16_t* AT; bf16_t* MB; bf16_t* R;
              _Float16* SC; _Float16* SCS; const float* rc; const float* rs; float* out; };

namespace pg8 {
#define PG8_LAS __attribute__((address_space(3)))
typedef unsigned short bf16_t;
typedef short bf16x8 __attribute__((ext_vector_type(8)));
typedef float f32x4 __attribute__((ext_vector_type(4)));
typedef unsigned u32x4 __attribute__((ext_vector_type(4)));
constexpr int BM = 256, BK = 64, HALF = 128, HTB = HALF * BK * 2  , STAGE_BYTES = 8 * HTB, NXCD = 8, WGM = 8;

__host__ __device__ __forceinline__ int lds_byte(int r, int c) { const int st = (r >> 4) * 2 + (c >> 5), rr = r & 15, cc = c & 31, ob = rr * 64 + cc * 2; return st * 1024 + (ob ^ (((ob >> 9) & 1) << 5)); }
__host__ __device__ __forceinline__ void stage_rc(int b, int& R, int& C) { const int st = b / 1024, sb = b % 1024, swz = sb ^ (((sb >> 9) & 1) << 5); R = (st >> 1) * 16 + swz / 64; C = (st & 1) * 32 + (swz % 64) / 2; }
__host__ __device__ __forceinline__ int perm32(int rho) { const int n = rho >> 4, i = rho & 15; return 8 * (i >> 2) + 4 * n + (i & 3); }

struct Unit { int pm, pn, idx; };
struct Gemm { const bf16_t* A; const bf16_t* Bt; int M, N, K; };

struct StaticOrder {
    int nM, nN, nwg, G, c;
    __host__ __device__ __forceinline__ void init(int M, int N, int G_, int c_) { nM = M / BM; nN = N / BM; nwg = nM * nN; G = G_; c = c_; }
    __host__ __device__ __forceinline__ bool next(int i, Unit& u) const {
        const long L = (long)i * G + c; if (L >= nwg) return false;
        int wgid = (int)L; { const int q = nwg / NXCD, r = nwg % NXCD, xcd = wgid % NXCD, off = wgid / NXCD; wgid = (xcd < r ? xcd * (q + 1) : r * (q + 1) + (xcd - r) * q) + off; }
        const int nig = WGM * nN, gid = wgid / nig, fm = gid * WGM, gsz = (nM - fm) < WGM ? (nM - fm) : WGM;
        u.pm = fm + ((wgid % nig) % gsz); u.pn = (wgid % nig) / gsz; u.idx = i; return true;
    }
    __device__ __forceinline__ void a_ready(const Unit&) const {}
    __device__ __forceinline__ void done(const Unit&) const {}
};
typedef float f32x2 __attribute__((ext_vector_type(2)));
__device__ __forceinline__ unsigned cvt_pk_bf16(float lo, float hi) { unsigned r; asm volatile("v_cvt_pk_bf16_f32 %0, %1, %2" : "=v"(r) : "v"(lo), "v"(hi)); return r; }
template <class Epi, class Sched, bool ALIGN_EPI = false, bool SP2 = false>
__device__ __forceinline__ void gemm_phase(PG8_LAS unsigned char* lds, const Gemm g, const Sched& S, const Epi& E) {
    int tid = threadIdx.x; asm volatile("" : "+v"(tid));
    const int wid = __builtin_amdgcn_readfirstlane(tid >> 6), lane = tid & 63, wr = wid >> 2, wc = wid & 3, fr = lane & 15, fq = lane >> 4;
    const int K = g.K, nt = K / BK;
    unsigned voffA[2], voffB[2];
#pragma unroll
    for (int i = 0; i < 2; ++i) { int R, C; stage_rc(tid * 16 + i * 8192, R, C); const int Rb = Epi::COLMAP2 ? (64 * (R >> 5) + perm32(R & 31)) : (Epi::PERM ? ((R & ~31) + perm32(R & 31)) : R);
        voffA[i] = (unsigned)(R * K + C) * 2u; voffB[i] = (unsigned)(Rb * K + C) * 2u; }
    const size_t kstep = (size_t)(BK * 2);
    const size_t hstep = (size_t)HALF * K * 2;
    const size_t hstepB = Epi::COLMAP2 ? (size_t)32 * K * 2 : hstep;
    const size_t tstep = 2 * hstep;
    const unsigned ldsw = (unsigned)wid * 1024u;
    const int aoff = lds_byte(wr * 64 + fr, fq * 8), boff = lds_byte(wc * 32 + fr, fq * 8);
#define PG8_SA(b, h) (((b) * 2 + (h)) * HTB)
#define PG8_SB(b, h) ((4 + (b) * 2 + (h)) * HTB)
#define PG8_STAGE(bufoff, gbase, voff) do { _Pragma("unroll") for (int _i = 0; _i < 2; ++_i) \
        __builtin_amdgcn_global_load_lds((const unsigned*)((const char*)(gbase) + (voff)[_i]), (PG8_LAS unsigned*)(lds + (bufoff) + ldsw + _i * 8192), 16, 0, 0); } while (0)
#define PG8_LDA(dst, b, h) do { _Pragma("unroll") for (int m = 0; m < 4; ++m) _Pragma("unroll") for (int k = 0; k < 2; ++k) dst[m][k] = *(const PG8_LAS bf16x8*)(lds + PG8_SA(b, h) + aoff + m * 2048 + k * 1024); } while (0)
#define PG8_LDB(dst, b, h) do { _Pragma("unroll") for (int n = 0; n < 2; ++n) _Pragma("unroll") for (int k = 0; k < 2; ++k) dst[n][k] = *(const PG8_LAS bf16x8*)(lds + PG8_SB(b, h) + boff + n * 2048 + k * 1024); } while (0)
#define PG8_MMA(ai, bj, At, Bt) do { __builtin_amdgcn_s_setprio(1); _Pragma("unroll") for (int m = 0; m < 4; ++m) _Pragma("unroll") for (int n = 0; n < 2; ++n) _Pragma("unroll") for (int k = 0; k < 2; ++k) \
        acc[ai][bj][m][n] = __builtin_amdgcn_mfma_f32_16x16x32_bf16(Bt[n][k], At[m][k], acc[ai][bj][m][n], 0, 0, 0); __builtin_amdgcn_s_setprio(0); } while (0)
#define PG8_WAIT_V(n) asm volatile("s_waitcnt vmcnt(" #n ")" ::: "memory")
#define PG8_WAIT_L(n) asm volatile("s_waitcnt lgkmcnt(" #n ")" ::: "memory")
#define PG8_BAR __builtin_amdgcn_s_barrier()
#define PG8_SCHED __builtin_amdgcn_sched_barrier(0)
    Unit cur, nxt; int ui = 0;
    if (!S.next(0, cur)) return;
    f32x4 acc[2][2][4][2];
#pragma unroll
    for (int a = 0; a < 2; ++a)
#pragma unroll
        for (int b = 0; b < 2; ++b)
#pragma unroll
            for (int m = 0; m < 4; ++m)
#pragma unroll
                for (int n = 0; n < 2; ++n) acc[a][b][m][n] = (f32x4){0.f, 0.f, 0.f, 0.f};
    bf16x8 At[4][2], B0[2][2], B1[2][2];
    const char* cA = (const char*)g.A + (size_t)cur.pm * tstep; const char* cB = (const char*)g.Bt + (size_t)cur.pn * tstep;
    S.a_ready(cur);
    if constexpr (SP2) {
        PG8_STAGE(PG8_SB(0, 0), cB, voffB); PG8_STAGE(PG8_SB(0, 1), cB + hstepB, voffB); PG8_STAGE(PG8_SA(0, 0), cA, voffA); PG8_STAGE(PG8_SA(0, 1), cA + hstep, voffA);
        if (wr == 1) PG8_BAR;
        PG8_WAIT_V(2); PG8_BAR;
        PG8_STAGE(PG8_SB(1, 0), cB + kstep, voffB); PG8_STAGE(PG8_SA(1, 0), cA + kstep, voffA); PG8_STAGE(PG8_SB(1, 1), cB + hstepB + kstep, voffB);
        PG8_WAIT_V(6); PG8_BAR;
    } else {
        PG8_STAGE(PG8_SB(0, 0), cB, voffB); PG8_STAGE(PG8_SA(0, 0), cA, voffA); PG8_STAGE(PG8_SB(0, 1), cB + hstepB, voffB); PG8_STAGE(PG8_SA(0, 1), cA + hstep, voffA);
        if (wr == 1) PG8_BAR;
        PG8_WAIT_V(4); PG8_BAR;
        PG8_STAGE(PG8_SB(1, 0), cB + kstep, voffB); PG8_STAGE(PG8_SA(1, 0), cA + kstep, voffA); PG8_STAGE(PG8_SB(1, 1), cB + hstepB + kstep, voffB);
        PG8_WAIT_V(6); PG8_BAR;
    }
    for (;;) {
        const bool has_next = S.next(ui + 1, nxt);
        const char* nA = has_next ? (const char*)g.A + (size_t)nxt.pm * tstep : cA; const char* nB = has_next ? (const char*)g.Bt + (size_t)nxt.pn * tstep : cB;
        for (int t = 0; t < nt; t += 2) {
            if constexpr (Epi::HOOK) { if (t == Epi::HOOK_T0 || t == Epi::HOOK_T1) E.hook(acc, cur, t, wr, wc, fr, fq); }
            const bool last = (t == nt - 2);
            const char* a1 = cA + (size_t)(t + 1) * kstep;
            const char* a2 = last ? nA : cA + (size_t)(t + 2) * kstep; const char* b2 = last ? nB : cB + (size_t)(t + 2) * kstep;
            const char* a3 = a2 + kstep; const char* b3 = b2 + kstep;
            if (last && has_next) S.a_ready(nxt);
            if constexpr (SP2) {
            PG8_LDB(B0, 0, 0); PG8_LDB(B1, 0, 1); PG8_SCHED; PG8_LDA(At, 0, 0); PG8_STAGE(PG8_SA(1, 1), a1 + hstep, voffA);
            PG8_WAIT_V(8); PG8_WAIT_L(0); PG8_BAR; PG8_MMA(0, 0, At, B0); PG8_MMA(0, 1, At, B1); PG8_BAR; PG8_SCHED;
            PG8_LDA(At, 0, 1); PG8_STAGE(PG8_SB(0, 0), b2, voffB); PG8_STAGE(PG8_SB(0, 1), b2 + hstepB, voffB); PG8_STAGE(PG8_SA(0, 0), a2, voffA);
            PG8_WAIT_V(8); PG8_WAIT_L(0); PG8_BAR; PG8_MMA(1, 0, At, B0); PG8_MMA(1, 1, At, B1); PG8_BAR; PG8_SCHED;
            PG8_LDB(B0, 1, 0); PG8_LDB(B1, 1, 1); PG8_SCHED; PG8_LDA(At, 1, 0); PG8_STAGE(PG8_SA(0, 1), a2 + hstep, voffA);
            PG8_WAIT_V(8); PG8_WAIT_L(0); PG8_BAR; PG8_MMA(0, 0, At, B0); PG8_MMA(0, 1, At, B1); PG8_BAR; PG8_SCHED;
            PG8_LDA(At, 1, 1); PG8_STAGE(PG8_SB(1, 0), b3, voffB); PG8_STAGE(PG8_SB(1, 1), b3 + hstepB, voffB); PG8_STAGE(PG8_SA(1, 0), a3, voffA);
            PG8_WAIT_V(8); PG8_WAIT_L(0); PG8_BAR; PG8_MMA(1, 0, At, B0); PG8_MMA(1, 1, At, B1); PG8_BAR; PG8_SCHED;
            } else {
            PG8_LDB(B0, 0, 0); PG8_SCHED; PG8_LDA(At, 0, 0); PG8_STAGE(PG8_SA(1, 1), a1 + hstep, voffA);
            PG8_WAIT_L(8); PG8_BAR; PG8_WAIT_L(0); PG8_MMA(0, 0, At, B0); PG8_BAR; PG8_SCHED;
            PG8_LDB(B1, 0, 1); PG8_STAGE(PG8_SB(0, 0), b2, voffB);
            PG8_BAR; PG8_WAIT_L(0); PG8_MMA(0, 1, At, B1); PG8_BAR;
            PG8_LDA(At, 0, 1); PG8_STAGE(PG8_SA(0, 0), a2, voffA);
            PG8_BAR; PG8_WAIT_L(0); PG8_MMA(1, 0, At, B0); PG8_BAR; PG8_SCHED;
            PG8_STAGE(PG8_SB(0, 1), b2 + hstepB, voffB);
            PG8_WAIT_V(6); PG8_BAR; PG8_MMA(1, 1, At, B1); PG8_BAR;
            PG8_LDB(B0, 1, 0); PG8_SCHED; PG8_LDA(At, 1, 0); PG8_STAGE(PG8_SA(0, 1), a2 + hstep, voffA);
            PG8_WAIT_L(8); PG8_BAR; PG8_WAIT_L(0); PG8_MMA(0, 0, At, B0); PG8_BAR; PG8_SCHED;
            PG8_LDB(B1, 1, 1); PG8_STAGE(PG8_SB(1, 0), b3, voffB);
            PG8_BAR; PG8_WAIT_L(0); PG8_MMA(0, 1, At, B1); PG8_BAR;
            PG8_LDA(At, 1, 1); PG8_STAGE(PG8_SA(1, 0), a3, voffA);
            PG8_BAR; PG8_WAIT_L(0); PG8_MMA(1, 0, At, B0); PG8_BAR; PG8_SCHED;
            PG8_STAGE(PG8_SB(1, 1), b3 + hstepB, voffB);
            PG8_WAIT_V(6); PG8_BAR; PG8_MMA(1, 1, At, B1); PG8_BAR;
            }
        }
        if constexpr (ALIGN_EPI) { if (wr == 0) PG8_BAR; }
        if constexpr (!Epi::AFTER_DRAIN) { E(acc, cur, wr, wc, fr, fq); S.done(cur); }
        if (!has_next) break;
#pragma unroll
        for (int a = 0; a < 2; ++a)
#pragma unroll
            for (int b = 0; b < 2; ++b)
#pragma unroll
                for (int m = 0; m < 4; ++m)
#pragma unroll
                    for (int n = 0; n < 2; ++n) acc[a][b][m][n] = (f32x4){0.f, 0.f, 0.f, 0.f};
        cur = nxt; cA = nA; cB = nB; ++ui;
        if constexpr (ALIGN_EPI) { if (wr == 1) PG8_BAR; }
    }
    PG8_WAIT_V(0);
    if constexpr (!ALIGN_EPI) { if (wr == 0) PG8_BAR; }
    PG8_BAR;
    if constexpr (Epi::AFTER_DRAIN) { E.fused(acc, cur, wr, wc, fr, fq, lds, wid, lane); S.done(cur); }
#undef PG8_SA
#undef PG8_SB
#undef PG8_STAGE
#undef PG8_LDA
#undef PG8_LDB
#undef PG8_MMA
#undef PG8_WAIT_V
#undef PG8_WAIT_L
#undef PG8_BAR
#undef PG8_SCHED
}
}
#define LAS __attribute__((address_space(3)))
#define XB_TMO      128
#define XB_XCNT(j)  (256  + 64 * (j))
#define XB_XSUB(j)  (1280 + 64 * (j))
#define XB_XGEN(j)  (2304 + 64 * (j))
#define XB_TOP      3328
#define XB_TOPGEN   3392
#define XCD_BAR_WORDS 3456
#define XB_SPIN_CAP (1u << 23)

__device__ __forceinline__ unsigned xb_ld(unsigned* p)              { return __hip_atomic_load(p, __ATOMIC_RELAXED, __HIP_MEMORY_SCOPE_AGENT); }
__device__ __forceinline__ unsigned xb_add(unsigned* p, unsigned v) { return __hip_atomic_fetch_add(p, v, __ATOMIC_RELAXED, __HIP_MEMORY_SCOPE_AGENT); }
__device__ __forceinline__ unsigned xb_xcc_id() { return (unsigned)__builtin_amdgcn_s_getreg((3 << 11) | 20) & 0xFu; }
#define XB_SPIN(cond, bar) do { unsigned _sp = 0; while (cond) { __builtin_amdgcn_s_sleep(1); \
    if ((++_sp & 255u) == 0u) { if (xb_ld(&(bar)[XB_TMO])) break; if (_sp > XB_SPIN_CAP) { atomicAdd(&(bar)[XB_TMO], 1u); break; } } } } while (0)

struct XcdBarrier {
    unsigned* bar; unsigned x;
    volatile LAS unsigned* st;
};

__device__ __forceinline__ XcdBarrier xcd_barrier_post(unsigned* bar, volatile LAS unsigned* st) {
    XcdBarrier b; b.bar = bar; b.x = xb_xcc_id(); b.st = st;
    if (threadIdx.x == 0) (void)xb_add(&bar[XB_XCNT(b.x)], 1u);
    return b;
}
__device__ __forceinline__ void xcd_barrier_complete(unsigned* bar, unsigned x, unsigned& nloc, unsigned& nx) {
    const unsigned G = gridDim.x * gridDim.y * gridDim.z;
    unsigned sum, cnt, mine, sp = 0u;
    for (;;) {
        sum = 0u; cnt = 0u; mine = 0u;
#pragma unroll
        for (unsigned j = 0; j < 16; ++j) { const unsigned c = xb_ld(&bar[XB_XCNT(j)]); sum += c; cnt += (c > 0u) ? 1u : 0u; mine = (j == x) ? c : mine; }
        if (sum == G) break;
        __builtin_amdgcn_s_sleep(1);
        if ((++sp & 255u) == 0u) { if (xb_ld(&bar[XB_TMO])) break; if (sp > XB_SPIN_CAP) { atomicAdd(&bar[XB_TMO], 1u); break; } }
    }
    nloc = mine > 0u ? mine : 1u; nx = cnt > 0u ? cnt : 1u;
}

__device__ __attribute__((noinline)) void xcd_barrier(const XcdBarrier b) {
    asm volatile("s_waitcnt vmcnt(0)" ::: "memory");
    __syncthreads();
    if (threadIdx.x == 0) {
        unsigned* bar = b.bar;
        __builtin_amdgcn_s_waitcnt(0);
        unsigned nloc = b.st[0], nx = b.st[1];
        if (nloc == 0u) { xcd_barrier_complete(bar, b.x, nloc, nx); b.st[0] = nloc; b.st[1] = nx; }
        const unsigned old = xb_add(&bar[XB_XSUB(b.x)], 1u);
        const unsigned gen = old / nloc;
        if (old + 1u == (gen + 1u) * nloc) {
            __builtin_amdgcn_fence(__ATOMIC_RELEASE, "agent");
            asm volatile("s_waitcnt vmcnt(0)" ::: "memory");
            const unsigned og = xb_add(&bar[XB_TOP], 1u);
            const unsigned tg = og / nx;
            if (og + 1u == (tg + 1u) * nx) xb_add(&bar[XB_TOPGEN], 1u);
            else XB_SPIN(xb_ld(&bar[XB_TOPGEN]) == tg, bar);
            __builtin_amdgcn_fence(__ATOMIC_ACQUIRE, "agent");
            xb_add(&bar[XB_XGEN(b.x)], 1u);
            asm volatile("s_waitcnt vmcnt(0)" ::: "memory");
        } else {
            XB_SPIN(xb_ld(&bar[XB_XGEN(b.x)]) == gen, bar);
            __builtin_amdgcn_fence(__ATOMIC_ACQUIRE, "agent");
            asm volatile("s_waitcnt vmcnt(0)" ::: "memory");
        }
    }
    __syncthreads();
}
#define GAS __attribute__((address_space(1)))
#ifndef LAS
#define LAS __attribute__((address_space(3)))
#endif
typedef unsigned v4u __attribute__((ext_vector_type(4)));
typedef unsigned v2u __attribute__((ext_vector_type(2)));
typedef float f32x4 __attribute__((ext_vector_type(4)));
typedef short bf16x8 __attribute__((ext_vector_type(8)));
typedef _Float16 f16x2 __attribute__((ext_vector_type(2)));
typedef _Float16 f16x4 __attribute__((ext_vector_type(4)));
typedef _Float16 f16x8 __attribute__((ext_vector_type(8)));
#define LDS_WAIT() asm volatile("s_waitcnt lgkmcnt(0)" ::: "memory")
#define VM_WAIT() asm volatile("s_waitcnt vmcnt(0)" ::: "memory")

constexpr int NWAVES = 8, NTHR = 512;
constexpr int NIN = 5376;
constexpr size_t WS_CTL = 0, CTL_ZERO_BYTES = 64 * 1024;
constexpr size_t WS_W = 2 * MiB, W_LSTRIDE = 31 * MiB;
constexpr size_t WO_IN = 0, WO_C = WO_IN + (size_t)NIN * DM * 2, WO_A = WO_C + (size_t)DM * DCONV * 2, WO_P = WO_A + (size_t)DM * DATT * 2,
                 WO_O = WO_P + (size_t)DM * DPOOL * 2, WO_1 = WO_O + (size_t)DM * DM * 2, WO_2 = WO_1 + (size_t)DFF * DM * 2, WO_END = WO_2 + (size_t)DM * DFF * 2;
static_assert(WO_END <= W_LSTRIDE && WS_W + 2 * W_LSTRIDE <= WS_ROPE, "weight map");
constexpr size_t WS_SSQA = 900 * MiB, WS_SSQB = 902 * MiB, WS_SSQAS = 904 * MiB, WS_SSQBS = 905 * MiB;
constexpr int CW_BAR = 4096;
constexpr int RING_BYTES = 131072, LDSCTL_OFF = RING_BYTES, MISC_OFF = LDSCTL_OFF + 320, LDS_BYTES = 147456;
constexpr int RST_OFF = 132096;

__device__ __forceinline__ float fast_sigmoid(float x) { return __builtin_amdgcn_rcpf(1.f + __expf(-x)); }
typedef __bf16 bf16x2_t __attribute__((ext_vector_type(2)));
typedef float f32x2_t __attribute__((ext_vector_type(2)));
__device__ __forceinline__ unsigned pk_bf16(float lo, float hi) { const f32x2_t v = {lo, hi}; const bf16x2_t b = __builtin_convertvector(v, bf16x2_t); return __builtin_bit_cast(unsigned, b); }
__device__ __forceinline__ unsigned pk_f16(float lo, float hi) { f16x2 v = {(_Float16)lo, (_Float16)hi}; return __builtin_bit_cast(unsigned, v); }
__device__ __forceinline__ float wave_sum(float v) {
#pragma unroll
    for (int o = 1; o < 64; o <<= 1) v += __shfl_xor(v, o);
    return v;
}


__device__ __forceinline__ float row_ms_inv(const unsigned char* ws, size_t off_p, size_t off_s, unsigned row) {
    float s = 0.f;
    if (row < (unsigned)MP) { const f32x4* p = (const f32x4*)(ws + off_p) + (size_t)row * 4;
#pragma unroll
        for (int j = 0; j < 4; ++j) { const f32x4 v = p[j]; s += (v.x + v.y) + (v.z + v.w); } }
    else { const f32x4* p = (const f32x4*)(ws + off_s) + (size_t)(row - MP) * 16;
#pragma unroll
        for (int j = 0; j < 16; ++j) { const f32x4 v = p[j]; s += (v.x + v.y) + (v.z + v.w); } }
    return 1.f / (s * (1.f / DM) + RMS_EPS);
}

__host__ __device__ __forceinline__ int rope_perm(int d) { return 8 * ((d & 31) >> 2) + 4 * (d >> 5) + (d & 3); }
__host__ __device__ __forceinline__ int win_row(int n) {
    if (n < C_AGATE) { return 256 * (n >> 7) + 8 * ((n & 127) >> 2) + (n & 3); }
    if (n < C_Q) { int c = n - C_AGATE; return 256 * (c >> 7) + 8 * ((c & 127) >> 2) + 4 + (c & 3); }
    if (n < C_K) { int i = n - C_Q, hh = i >> 6; return 256 * (2 + (hh >> 2)) + 64 * (hh & 3) + rope_perm(i & 63); }
    if (n < C_V) { int i = n - C_K; return 256 * 4 + 64 * (i >> 6) + rope_perm(i & 63); }
    if (n < C_QI) { return 256 * 4 + 128 + (n - C_V); }
    if (n < C_KI) { int i = n - C_QI, hh = i >> 6; return 256 * (5 + (hh >> 2)) + 64 * (hh & 3) + rope_perm(i & 63); }
    if (n < C_WI) { return 256 * 7 + rope_perm(n - C_KI); }
    if (n < C_XC) { return 256 * 7 + 64 + (n - C_WI); }
    if (n < C_G) { return 256 * 8 + (n - C_XC); }
    return 256 * 9 + (n - C_G);
}

struct EpiRelu2 {
    static constexpr bool PERM = true, AFTER_DRAIN = false, HOOK = false, COLMAP2 = true; static constexpr int HOOK_T0 = -1, HOOK_T1 = -1; bf16_t* O; int ldc; const LAS float* rst;
    __device__ __forceinline__ void operator()(const pg8::f32x4 (&acc)[2][2][4][2], const pg8::Unit& u, int wr, int wc, int fr, int fq) const {
        asm volatile("" : "+v"(fr), "+v"(fq), "+s"(wr), "+s"(wc));
#pragma unroll
        for (int ai = 0; ai < 2; ++ai)
#pragma unroll
            for (int m = 0; m < 4; ++m) { const unsigned row = (unsigned)(u.pm * 256 + ai * 128 + wr * 64 + m * 16 + fr); bf16_t* rowp = O + (size_t)row * ldc + u.pn * 256 + wc * 64 + 8 * fq;
                const float r2 = rst[u.idx * 256 + ai * 128 + wr * 64 + m * 16 + fr];
#pragma unroll
                for (int bj = 0; bj < 2; ++bj) { pg8::f32x4 a = acc[ai][bj][m][0], b = acc[ai][bj][m][1]; float r[8];
#pragma unroll
                    for (int e = 0; e < 4; ++e) { float x = fmaxf(a[e], 0.f), y = fmaxf(b[e], 0.f); r[e] = x * x * r2; r[4 + e] = y * y * r2; }
                    v4u w; w.x = pk_bf16(r[0], r[1]); w.y = pk_bf16(r[2], r[3]); w.z = pk_bf16(r[4], r[5]); w.w = pk_bf16(r[6], r[7]);
                    *(v4u*)(rowp + bj * 32) = w; } }
    }
};
struct EpiResid {
    static constexpr bool PERM = true, AFTER_DRAIN = false, HOOK = false, COLMAP2 = true; static constexpr int HOOK_T0 = -1, HOOK_T1 = -1; bf16_t* H; float* SSQ;
    __device__ __forceinline__ void operator()(const pg8::f32x4 (&acc)[2][2][4][2], const pg8::Unit& u, int wr, int wc, int fr, int fq) const {
        asm volatile("" : "+v"(fr), "+v"(fq), "+s"(wr), "+s"(wc));
#pragma unroll
        for (int ai = 0; ai < 2; ++ai)
#pragma unroll
            for (int m = 0; m < 4; ++m) { const size_t row = (size_t)(u.pm * 256 + ai * 128 + wr * 64 + m * 16 + fr); const int col = u.pn * 256 + wc * 64 + 8 * fq; float ss = 0.f;
#pragma unroll
                for (int bj = 0; bj < 2; ++bj) { v4u* p = (v4u*)(H + row * DM + col + bj * 32); const v4u h = *p; const pg8::f32x4 a = acc[ai][bj][m][0], b = acc[ai][bj][m][1];
                    const float o0 = __uint_as_float(h.x << 16) + a[0], o1 = __uint_as_float(h.x & 0xffff0000u) + a[1], o2 = __uint_as_float(h.y << 16) + a[2], o3 = __uint_as_float(h.y & 0xffff0000u) + a[3];
                    const float o4 = __uint_as_float(h.z << 16) + b[0], o5 = __uint_as_float(h.z & 0xffff0000u) + b[1], o6 = __uint_as_float(h.w << 16) + b[2], o7 = __uint_as_float(h.w & 0xffff0000u) + b[3];
                    ss += ((o0 * o0 + o1 * o1) + (o2 * o2 + o3 * o3)) + ((o4 * o4 + o5 * o5) + (o6 * o6 + o7 * o7));
                    v4u w; w.x = pk_bf16(o0, o1); w.y = pk_bf16(o2, o3); w.z = pk_bf16(o4, o5); w.w = pk_bf16(o6, o7);
                    *p = w; }
                ss += __shfl_xor(ss, 16); ss += __shfl_xor(ss, 32);
                if (fq == 0) SSQ[row * 16 + u.pn * 4 + wc] = ss;
                if (m == 3) asm volatile("" ::: "memory"); }
    }
};
struct EpiGate {
    static constexpr bool PERM = true, AFTER_DRAIN = false, HOOK = true, COLMAP2 = true; static constexpr int HOOK_T0 = 4, HOOK_T1 = 12;
    bf16_t* MBp; const _Float16* G;
    __device__ __forceinline__ void hook(pg8::f32x4 (&acc)[2][2][4][2], const pg8::Unit& u, int t, int wr, int wc, int fr, int fq) const {
        asm volatile("" : "+v"(fr), "+v"(fq), "+s"(wr), "+s"(wc));
        const int br = t == HOOK_T0 ? 0 : 1;
#pragma unroll
        for (int ai = 0; ai < 2; ++ai)
#pragma unroll
            for (int m = 0; m < 4; ++m) { const size_t row = (size_t)(u.pm * 256 + ai * 128 + wr * 64 + m * 16 + fr); const int col = u.pn * 256 + wc * 64 + 8 * fq;
#pragma unroll
                for (int bj = 0; bj < 2; ++bj) { const _Float16* gp = G + row * 3072 + 1024 * br + col + bj * 32;
                    const f16x8 gn = *(const f16x8*)gp, gd = *(const f16x8*)(gp + 1024);
#pragma unroll
                    for (int e = 0; e < 4; ++e) { acc[ai][bj][m][0][e] *= (float)gn[e] * __builtin_amdgcn_rcpf(fmaxf((float)gd[e], 1e-7f)); acc[ai][bj][m][1][e] *= (float)gn[4 + e] * __builtin_amdgcn_rcpf(fmaxf((float)gd[4 + e], 1e-7f)); } }
                if (m == 3) asm volatile("" ::: "memory"); }
    }
    __device__ __forceinline__ void operator()(const pg8::f32x4 (&acc)[2][2][4][2], const pg8::Unit& u, int wr, int wc, int fr, int fq) const {
        asm volatile("" : "+v"(fr), "+v"(fq), "+s"(wr), "+s"(wc));
#pragma unroll
        for (int ai = 0; ai < 2; ++ai)
#pragma unroll
            for (int m = 0; m < 4; ++m) { const size_t row = (size_t)(u.pm * 256 + ai * 128 + wr * 64 + m * 16 + fr); const int col = u.pn * 256 + wc * 64 + 8 * fq;
#pragma unroll
                for (int bj = 0; bj < 2; ++bj) { pg8::f32x4 a = acc[ai][bj][m][0], b = acc[ai][bj][m][1];
                    const f16x8 gv = *(const f16x8*)(G + row * 3072 + 2048 + col + bj * 32); float r[8];
#pragma unroll
                    for (int e = 0; e < 4; ++e) { r[e] = (float)gv[e] * a[e]; r[4 + e] = (float)gv[4 + e] * b[e]; }
                    v4u w; w.x = pk_bf16(r[0], r[1]); w.y = pk_bf16(r[2], r[3]); w.z = pk_bf16(r[4], r[5]); w.w = pk_bf16(r[6], r[7]);
                    *(v4u*)(MBp + row * DM + col + bj * 32) = w; }
                if (m == 3) asm volatile("" ::: "memory"); }
    }
};
struct EpiNull {
    static constexpr bool PERM = true, AFTER_DRAIN = false, HOOK = false, COLMAP2 = false; static constexpr int HOOK_T0 = -1, HOOK_T1 = -1; float* sink;
    __device__ __forceinline__ void operator()(const pg8::f32x4 (&acc)[2][2][4][2], const pg8::Unit& u, int wr, int wc, int fr, int fq) const {
        float s = 0.f;
#pragma unroll
        for (int ai = 0; ai < 2; ++ai)
#pragma unroll
            for (int bj = 0; bj < 2; ++bj)
#pragma unroll
                for (int m = 0; m < 4; ++m) s += acc[ai][bj][m][0][0] + acc[ai][bj][m][1][3];
        if (s == 1234.5678f) sink[0] = s;
    }
};
struct EpiInproj {
    static constexpr bool PERM = true, AFTER_DRAIN = false, HOOK = false, COLMAP2 = false; static constexpr int HOOK_T0 = -1, HOOK_T1 = -1; unsigned char* ws; unsigned char* outb; int layer; const LAS float* rst;
    __device__ __forceinline__ void operator()(const pg8::f32x4 (&acc)[2][2][4][2], const pg8::Unit& u, int wr, int wc, int fr, int fq) const {
        const int pn = u.pn; const bool smp = (u.pm == MP / 256);
        asm volatile("" : "+v"(fr), "+v"(fq), "+s"(wr), "+s"(wc));
#pragma unroll
        for (int ai = 0; ai < 2; ++ai)
#pragma unroll
            for (int m = 0; m < 4; ++m) {
                const unsigned row = (unsigned)(u.pm * 256 + ai * 128 + wr * 64 + m * 16 + fr);
                const unsigned orow = smp ? (unsigned)layer * MS + (row - MP) : (unsigned)layer * MP + row;
                const float rsc = rst[u.idx * 256 + ai * 128 + wr * 64 + m * 16 + fr];
#pragma unroll
                for (int bj = 0; bj < 2; ++bj) {
                    const pg8::f32x4 a = acc[ai][bj][m][0] * rsc, b = acc[ai][bj][m][1] * rsc;
                    const unsigned cb = 128 * bj + 32 * wc + 8 * fq;
                    if (pn < 2) {
                        f32x4 o; o.x = a[0] * fast_sigmoid(b[0]); o.y = a[1] * fast_sigmoid(b[1]); o.z = a[2] * fast_sigmoid(b[2]); o.w = a[3] * fast_sigmoid(b[3]);
                        *(f32x4*)(ws + (unsigned)(WS_U + (row * 256u + 128u * pn + (cb >> 1)) * 4u)) = o;
                    } else if (pn == 8) {
                        const unsigned off = (unsigned)(WS_XC + (row * 256u + cb) * 4u);
                        *(f32x4*)(ws + off) = (f32x4){a[0], a[1], a[2], a[3]}; *(f32x4*)(ws + off + 16u) = (f32x4){b[0], b[1], b[2], b[3]};
                    } else if (pn >= 9) {
                        v4u w; w.x = pk_f16(fast_sigmoid(a[0]), fast_sigmoid(a[1])); w.y = pk_f16(fast_sigmoid(a[2]), fast_sigmoid(a[3]));
                        w.z = pk_f16(fast_sigmoid(b[0]), fast_sigmoid(b[1])); w.w = pk_f16(fast_sigmoid(b[2]), fast_sigmoid(b[3]));
                        __builtin_nontemporal_store(w, (v4u*)(ws + (unsigned)(WS_G + (row * 3072u + 256u * (pn - 9) + cb) * 2u)));
                    } else if (pn == 4 && bj == 1) {
                        const unsigned idx = cb - 128u; v4u w; w.x = pk_bf16(a[0], a[1]); w.y = pk_bf16(a[2], a[3]); w.z = pk_bf16(b[0], b[1]); w.w = pk_bf16(b[2], b[3]);
                        *(v4u*)(ws + (unsigned)(WS_KV + (row * 256u + 128u + idx) * 2u)) = w;
                        const unsigned oo = (unsigned)(((smp ? O_VS : O_VP) + (size_t)orow * KVD + idx) * 4u);
                        *(f32x4*)(outb + oo) = (f32x4){a[0], a[1], a[2], a[3]}; *(f32x4*)(outb + oo + 16u) = (f32x4){b[0], b[1], b[2], b[3]};
                    } else if (pn == 7 && (bj == 1 || wc >= 2)) {
                        if (bj == 0 && wc == 2 && fq == 0) { const unsigned off = (unsigned)(WS_WI + row * 32u);
                            *(f32x4*)(ws + off) = (f32x4){a[0] * WI_SCALE, a[1] * WI_SCALE, a[2] * WI_SCALE, a[3] * WI_SCALE};
                            *(f32x4*)(ws + off + 16u) = (f32x4){b[0] * WI_SCALE, b[1] * WI_SCALE, b[2] * WI_SCALE, b[3] * WI_SCALE}; }
                    } else {
                        const unsigned rr = smp ? T + (row & (ST - 1)) : (row & (T - 1)); const unsigned d0 = (cb & 56u) >> 1, hl = cb >> 6;
                        const unsigned roff = (unsigned)(WS_ROPE + (rr * 32u + d0) * 4u);
                        const f32x4 c4 = *(const f32x4*)(ws + roff), s4 = *(const f32x4*)(ws + roff + (unsigned)((T + ST) * 32 * 4));
                        float o1[4], o2[4];
#pragma unroll
                        for (int e = 0; e < 4; ++e) { o1[e] = a[e] * c4[e] - b[e] * s4[e]; o2[e] = b[e] * c4[e] + a[e] * s4[e]; }
                        unsigned dst; float sc = 1.f; unsigned of = 0u;
                        if (pn < 4) { dst = (unsigned)(WS_QB + (row * 512u + 64u * (4u * (pn - 2) + hl) + d0) * 2u); sc = 0.125f; }
                        else if (pn == 4) { dst = (unsigned)(WS_KV + (row * 256u + 64u * hl + d0) * 2u); of = (unsigned)(((smp ? O_KS : O_KP) + (size_t)orow * KVD + 64u * hl + d0) * 4u); }
                        else if (pn < 7) { dst = (unsigned)(WS_QI + (row * 512u + 64u * (4u * (pn - 5) + hl) + d0) * 2u); }
                        else { dst = (unsigned)(WS_KI + (row * 64u + d0) * 2u); of = (unsigned)(((smp ? O_KIS : O_KIP) + (size_t)orow * ID + d0) * 4u); }
                        v2u w1, w2; w1.x = pk_bf16(o1[0] * sc, o1[1] * sc); w1.y = pk_bf16(o1[2] * sc, o1[3] * sc); w2.x = pk_bf16(o2[0] * sc, o2[1] * sc); w2.y = pk_bf16(o2[2] * sc, o2[3] * sc);
                        *(v2u*)(ws + dst) = w1; *(v2u*)(ws + dst + 64u) = w2;
                        if (pn == 4 || pn == 7) { *(f32x4*)(outb + of) = (f32x4){o1[0], o1[1], o1[2], o1[3]}; *(f32x4*)(outb + of + 128u) = (f32x4){o2[0], o2[1], o2[2], o2[3]}; }
                    }
                }
                if (m == 3) asm volatile("" ::: "memory");
            }
    }
};

__device__ __forceinline__ f32x4 sg_tile(const bf16_t* A, int lda, const bf16_t* Bt, int K, int mt, int nt, int lane, int ldb = 0) {
    const bf16_t* ap = A + (size_t)(16 * mt + (lane & 15)) * lda + 8 * (lane >> 4);
    const bf16_t* bp = Bt + (size_t)(16 * nt + (lane & 15)) * (ldb ? ldb : K) + 8 * (lane >> 4);
    f32x4 acc = {0.f, 0.f, 0.f, 0.f};
    if (K >= 512) {
#pragma unroll 1
        for (int k = 0; k < K; k += 512) { bf16x8 a[16], b[16];
#pragma unroll
            for (int i = 0; i < 16; ++i) { a[i] = *(const bf16x8*)(ap + k + 32 * i); b[i] = *(const bf16x8*)(bp + k + 32 * i); }
#pragma unroll
            for (int i = 0; i < 16; ++i) acc = __builtin_amdgcn_mfma_f32_16x16x32_bf16(b[i], a[i], acc, 0, 0, 0); }
    } else {
#pragma unroll 1
        for (int k = 0; k < K; k += 256) { bf16x8 a[8], b[8];
#pragma unroll
            for (int i = 0; i < 8; ++i) { a[i] = *(const bf16x8*)(ap + k + 32 * i); b[i] = *(const bf16x8*)(bp + k + 32 * i); }
#pragma unroll
            for (int i = 0; i < 8; ++i) acc = __builtin_amdgcn_mfma_f32_16x16x32_bf16(b[i], a[i], acc, 0, 0, 0); }
    }
    return acc;
}

template <bool MAPPED>
__device__ __forceinline__ void transpose_item(const float* W, int K, int N, bf16_t* WT, LAS float* scr, int item, int lane, const float* gain = nullptr, int ldt = 0, int koff = 0) {
    const int nblk = (N + 31) / 32, kb = item / nblk, nb = item % nblk, k0 = 64 * kb, n0 = 32 * nb; const int nn = n0 + (lane & 31);
    (void)nn;
    f32x4 wv[8];
    const int np = n0 + 4 * (lane & 7);
#pragma unroll
    for (int i = 0; i < 8; ++i) { const int kk = 8 * i + (lane >> 3); wv[i] = np < N ? *(const f32x4*)(W + (size_t)(k0 + kk) * N + np) : (f32x4){0.f, 0.f, 0.f, 0.f}; }
#pragma unroll
    for (int i = 0; i < 8; ++i) { const int kk = 8 * i + (lane >> 3); f32x4 v = wv[i]; if (gain) { const float gk = gain[k0 + kk]; v.x *= gk; v.y *= gk; v.z *= gk; v.w *= gk; }
        LAS float* d = scr + kk * 33 + 4 * (lane & 7); d[0] = v.x; d[1] = v.y; d[2] = v.z; d[3] = v.w; }
    LDS_WAIT(); asm volatile("" ::: "memory");
    const int c = lane & 7;
#pragma unroll
    for (int j = 0; j < 4; ++j) { const int nl = (lane >> 3) + 8 * j, n = n0 + nl; const LAS float* s = scr + (8 * c) * 33 + nl;
        v4u o; o.x = pk_bf16(s[0 * 33], s[1 * 33]); o.y = pk_bf16(s[2 * 33], s[3 * 33]); o.z = pk_bf16(s[4 * 33], s[5 * 33]); o.w = pk_bf16(s[6 * 33], s[7 * 33]);
        if (n < N) { const int r = MAPPED ? win_row(n) : n; *(v4u*)(WT + (size_t)r * (ldt ? ldt : K) + koff + k0 + 8 * c) = o; } }
    LDS_WAIT(); asm volatile("" ::: "memory");
}
__device__ __forceinline__ void rms_row(const float* xrow, const float* g, float* xcopy, bf16_t* hout, float* yout, int lane) {
    const f32x4* xr = (const f32x4*)xrow + lane; f32x4 v[4]; float s = 0.f;
#pragma unroll
    for (int j = 0; j < 4; ++j) { v[j] = xr[64 * j]; s += (v[j].x * v[j].x + v[j].y * v[j].y) + (v[j].z * v[j].z + v[j].w * v[j].w); }
    const float r = 1.f / sqrtf(wave_sum(s) * (1.f / DM) + RMS_EPS);
#pragma unroll
    for (int j = 0; j < 4; ++j) { const f32x4 gg = *((const f32x4*)g + lane + 64 * j);
        if (xcopy) *((f32x4*)xcopy + lane + 64 * j) = v[j];
        f32x4 y; y.x = v[j].x * r * gg.x; y.y = v[j].y * r * gg.y; y.z = v[j].z * r * gg.z; y.w = v[j].w * r * gg.w;
        if (hout) { v2u w; w.x = pk_bf16(y.x, y.y); w.y = pk_bf16(y.z, y.w); *((v2u*)hout + lane + 64 * j) = w; }
        if (yout) *((f32x4*)yout + lane + 64 * j) = y; }
}

__device__ __forceinline__ void rms_row_bf(const bf16_t* hrow, const float* g, float* yout, int lane) {
    float v[16]; float s = 0.f;
#pragma unroll
    for (int j = 0; j < 2; ++j) { const v4u h = *((const v4u*)hrow + lane + 64 * j);
        v[8 * j + 0] = __uint_as_float(h.x << 16); v[8 * j + 1] = __uint_as_float(h.x & 0xffff0000u); v[8 * j + 2] = __uint_as_float(h.y << 16); v[8 * j + 3] = __uint_as_float(h.y & 0xffff0000u);
        v[8 * j + 4] = __uint_as_float(h.z << 16); v[8 * j + 5] = __uint_as_float(h.z & 0xffff0000u); v[8 * j + 6] = __uint_as_float(h.w << 16); v[8 * j + 7] = __uint_as_float(h.w & 0xffff0000u); }
#pragma unroll
    for (int e = 0; e < 16; ++e) s += v[e] * v[e];
    const float r = 1.f / sqrtf(wave_sum(s) * (1.f / DM) + RMS_EPS);
#pragma unroll
    for (int j = 0; j < 2; ++j) { const f32x4 g0 = *((const f32x4*)g + 2 * lane + 128 * j), g1 = *((const f32x4*)g + 2 * lane + 128 * j + 1);
        f32x4 y0, y1; y0.x = v[8 * j + 0] * r * g0.x; y0.y = v[8 * j + 1] * r * g0.y; y0.z = v[8 * j + 2] * r * g0.z; y0.w = v[8 * j + 3] * r * g0.w;
        y1.x = v[8 * j + 4] * r * g1.x; y1.y = v[8 * j + 5] * r * g1.y; y1.z = v[8 * j + 6] * r * g1.z; y1.w = v[8 * j + 7] * r * g1.w;
        *((f32x4*)yout + 2 * lane + 128 * j) = y0; *((f32x4*)yout + 2 * lane + 128 * j + 1) = y1; }
}
__device__ __forceinline__ void prep_row(const float* xrow, bf16_t* hout, float* ssq, int nslot, int lane) {
    const f32x4* xr = (const f32x4*)xrow + lane; float s = 0.f;
#pragma unroll
    for (int j = 0; j < 4; ++j) { const f32x4 v = xr[64 * j]; s += (v.x * v.x + v.y * v.y) + (v.z * v.z + v.w * v.w);
        v2u w; w.x = pk_bf16(v.x, v.y); w.y = pk_bf16(v.z, v.w); *((v2u*)hout + lane + 64 * j) = w; }
    s = wave_sum(s);
    if (lane < nslot) ssq[lane] = lane == 0 ? s : 0.f;
}

__device__ __forceinline__ void rms_row_bf2(const bf16_t* ha, float* ya, const bf16_t* hb, float* yb, bool has_b, const float* g, int lane) {
    v4u ra[2], rb[2];
#pragma unroll
    for (int j = 0; j < 2; ++j) ra[j] = *((const v4u*)ha + lane + 64 * j);
#pragma unroll
    for (int j = 0; j < 2; ++j) rb[j] = has_b ? *((const v4u*)hb + lane + 64 * j) : (v4u){0u, 0u, 0u, 0u};
    f32x4 gg[4];
#pragma unroll
    for (int j = 0; j < 2; ++j) { gg[2 * j] = *((const f32x4*)g + 2 * lane + 128 * j); gg[2 * j + 1] = *((const f32x4*)g + 2 * lane + 128 * j + 1); }
#pragma unroll
    for (int rw = 0; rw < 2; ++rw) { if (rw == 1 && !has_b) break;
        float v[16]; float s = 0.f;
#pragma unroll
        for (int j = 0; j < 2; ++j) { const v4u h = rw ? rb[j] : ra[j];
            v[8 * j + 0] = __uint_as_float(h.x << 16); v[8 * j + 1] = __uint_as_float(h.x & 0xffff0000u); v[8 * j + 2] = __uint_as_float(h.y << 16); v[8 * j + 3] = __uint_as_float(h.y & 0xffff0000u);
            v[8 * j + 4] = __uint_as_float(h.z << 16); v[8 * j + 5] = __uint_as_float(h.z & 0xffff0000u); v[8 * j + 6] = __uint_as_float(h.w << 16); v[8 * j + 7] = __uint_as_float(h.w & 0xffff0000u); }
#pragma unroll
        for (int e = 0; e < 16; ++e) s += v[e] * v[e];
        const float r = 1.f / sqrtf(wave_sum(s) * (1.f / DM) + RMS_EPS);
        float* yout = rw ? yb : ya;
#pragma unroll
        for (int j = 0; j < 2; ++j) { const f32x4 g0 = gg[2 * j], g1 = gg[2 * j + 1];
            f32x4 y0, y1; y0.x = v[8 * j + 0] * r * g0.x; y0.y = v[8 * j + 1] * r * g0.y; y0.z = v[8 * j + 2] * r * g0.z; y0.w = v[8 * j + 3] * r * g0.w;
            y1.x = v[8 * j + 4] * r * g1.x; y1.y = v[8 * j + 5] * r * g1.y; y1.z = v[8 * j + 6] * r * g1.z; y1.w = v[8 * j + 7] * r * g1.w;
            *((f32x4*)yout + 2 * lane + 128 * j) = y0; *((f32x4*)yout + 2 * lane + 128 * j + 1) = y1; } }
}
__device__ __forceinline__ void prep_row2(const float* xa, bf16_t* ha, float* sa, int na, const float* xb, bf16_t* hb, float* sb, int nb, bool has_b, int lane) {
    f32x4 va[4], vb[4];
#pragma unroll
    for (int j = 0; j < 4; ++j) va[j] = *((const f32x4*)xa + lane + 64 * j);
#pragma unroll
    for (int j = 0; j < 4; ++j) vb[j] = has_b ? *((const f32x4*)xb + lane + 64 * j) : (f32x4){0.f, 0.f, 0.f, 0.f};
    float s = 0.f, t = 0.f;
#pragma unroll
    for (int j = 0; j < 4; ++j) { const f32x4 v = va[j]; s += (v.x * v.x + v.y * v.y) + (v.z * v.z + v.w * v.w);
        v2u w; w.x = pk_bf16(v.x, v.y); w.y = pk_bf16(v.z, v.w); *((v2u*)ha + lane + 64 * j) = w; }
    s = wave_sum(s);
    if (lane < na) sa[lane] = lane == 0 ? s : 0.f;
    if (has_b) {
#pragma unroll
        for (int j = 0; j < 4; ++j) { const f32x4 v = vb[j]; t += (v.x * v.x + v.y * v.y) + (v.z * v.z + v.w * v.w);
            v2u w; w.x = pk_bf16(v.x, v.y); w.y = pk_bf16(v.z, v.w); *((v2u*)hb + lane + 64 * j) = w; }
        t = wave_sum(t);
        if (lane < nb) sb[lane] = lane == 0 ? t : 0.f; }
}

struct Args { const float* in[24]; float* out; unsigned char* ws; int ph_lo, ph_hi; };
typedef float f32x16 __attribute__((ext_vector_type(16)));
struct P2Args { const float* state_conv; const float* state_pool; const float* conv_w; const float* conv_b; const float* ln_g; const float* ln_b; const float* cache_kidx; const int* page_table; };

__device__ __forceinline__ void conv_task(const Bufs& B, const P2Args& P, int layer, int task, int lane, const LAS float* wl  ) {
    const bool smp = task >= MP / 8; const int b = smp ? task - MP / 8 : task / (T / 8); const int t0 = smp ? 0 : (task % (T / 8)) * 8; const int row0 = smp ? MP + b * ST : b * T;
    const f32x4 bias = *((const f32x4*)(P.conv_b + layer * DCONV) + lane);
    f32x4 acc[8];
#pragma unroll
    for (int i = 0; i < 8; ++i) acc[i] = bias;
#define CONV_LOADROW(dst, r_) do { const int r__ = (r_), tau__ = t0 - 30 + r__; (dst) = (f32x4){0.f, 0.f, 0.f, 0.f}; \
        if (r__ < 38) { if (tau__ >= 0) (dst) = *((const f32x4*)(B.U + (size_t)(row0 + tau__) * 256) + lane); \
            else if (smp) (dst) = *((const f32x4*)(P.state_conv + (((size_t)layer * SB + b) * CHIST + (30 + tau__)) * DCONV) + lane); } } while (0)
    f32x4 xa[4], xb[4], xd[4];
#pragma unroll
    for (int rr = 0; rr < 4; ++rr) CONV_LOADROW(xa[rr], rr);
#pragma unroll
    for (int rr = 0; rr < 4; ++rr) CONV_LOADROW(xb[rr], 4 + rr);
#define CONV_GROUP(XC, XL, r0_) do { const int r0 = (r0_); asm volatile("" ::: "memory");       \
        _Pragma("unroll") for (int rr = 0; rr < 4; ++rr) CONV_LOADROW(XL[rr], r0 + 8 + rr); \
        asm volatile("" ::: "memory"); \
        const LAS f32x4* wb = (const LAS f32x4*)(wl + (r0 + 8) * DCONV) + lane;       \
        _Pragma("unroll") for (int rr = 0; rr < 4; ++rr) { \
            _Pragma("unroll") for (int i = 0; i < 8; ++i) { const f32x4 w = wb[(rr - i) * (DCONV / 4)]; \
                acc[i].x += w.x * XC[rr].x; acc[i].y += w.y * XC[rr].y; acc[i].z += w.z * XC[rr].z; acc[i].w += w.w * XC[rr].w; } } } while (0)
#pragma nounroll
    for (int rg = 0; rg < 36; rg += 12) {
        CONV_GROUP(xa, xd, rg);
        CONV_GROUP(xb, xa, rg + 4);
        CONV_GROUP(xd, xb, rg + 8);
    }
    CONV_GROUP(xa, xd, 36);
#undef CONV_GROUP
#undef CONV_LOADROW
    const f32x4 lg = *((const f32x4*)(P.ln_g + layer * DCONV) + lane), lb = *((const f32x4*)(P.ln_b + layer * DCONV) + lane);
#pragma unroll
    for (int i = 0; i < 8; ++i) {
        const float mu = wave_sum((acc[i].x + acc[i].y) + (acc[i].z + acc[i].w)) * (1.f / 256);
        const f32x4 d = {acc[i].x - mu, acc[i].y - mu, acc[i].z - mu, acc[i].w - mu};
        const float var = wave_sum((d.x * d.x + d.y * d.y) + (d.z * d.z + d.w * d.w)) * (1.f / 256);
        const float rs = 1.f / sqrtf(var + LN_EPS);
        float y0 = d.x * rs * lg.x + lb.x, y1 = d.y * rs * lg.y + lb.y, y2 = d.z * rs * lg.z + lb.z, y3 = d.w * rs * lg.w + lb.w;
        y0 *= fast_sigmoid(y0); y1 *= fast_sigmoid(y1); y2 *= fast_sigmoid(y2); y3 *= fast_sigmoid(y3);
        v2u w; w.x = pk_bf16(y0, y1); w.y = pk_bf16(y2, y3);
        *((v2u*)(B.CA + (size_t)(row0 + t0 + i) * DM) + lane) = w; }
}
__device__ __forceinline__ void pool_task(const Bufs& B, const P2Args& P, int layer, int task, int lane) {
    const bool smp = task >= MP / 8; const int b = smp ? task - MP / 8 : task / (T / 8); const int t0 = smp ? 0 : (task % (T / 8)) * 8; const int row0 = smp ? MP + b * ST : b * T;
    f32x4 cs[24];
    f32x4 xr[8];
    cs[0] = (f32x4){0.f, 0.f, 0.f, 0.f};
#pragma unroll
    for (int r = 0; r < 23; ++r) { const int tau = t0 - 15 + r; f32x4 v;
        if (tau >= 0) v = *((const f32x4*)(B.XC + (size_t)(row0 + tau) * 256) + lane);
        else if (smp) v = *((const f32x4*)(P.state_pool + (((size_t)layer * SB + b) * PHIST + (15 + tau)) * DPOOL) + lane);
        else v = (f32x4){0.f, 0.f, 0.f, 0.f};
        cs[r + 1] = (f32x4){cs[r].x + v.x, cs[r].y + v.y, cs[r].z + v.z, cs[r].w + v.w}; if (r >= 15) xr[r - 15] = v; }
    const int g = lane >> 4, w = 2 << g;
#pragma unroll
    for (int i = 0; i < 8; ++i) {
        const f32x4 s2 = cs[14 + i], s4 = cs[12 + i], s8 = cs[8 + i], s16 = cs[i];
        const f32x4 st = g == 0 ? s2 : (g == 1 ? s4 : (g == 2 ? s8 : s16)); const f32x4 e = cs[16 + i];
        const int t = t0 + i; const float cnt = smp ? (float)w : (float)((t + 1) < w ? (t + 1) : w); const float ic = 1.f / cnt;
        v2u o; o.x = pk_bf16((e.x - st.x) * ic - xr[i].x, (e.y - st.y) * ic - xr[i].y); o.y = pk_bf16((e.z - st.z) * ic - xr[i].z, (e.w - st.w) * ic - xr[i].w);
        *((v2u*)(B.CA + (size_t)(row0 + t) * DM + (DCONV + DATT)) + lane) = o; }
}
__device__ __forceinline__ void states_task(const Bufs& B, const P2Args& P, int layer, int i, int lane) {
    const float* src; float* dst;
    if (i < NB * 30) { const int b = i / 30, r = i % 30; dst = B.out + O_CP + (((size_t)layer * NB + b) * CHIST + r) * DCONV; src = B.U + (size_t)(b * T + T - 30 + r) * 256; }
    else if ((i -= NB * 30) < NB * 15) { const int b = i / 15, r = i % 15; dst = B.out + O_PP + (((size_t)layer * NB + b) * PHIST + r) * DPOOL; src = B.XC + (size_t)(b * T + T - 15 + r) * 256; }
    else if ((i -= NB * 15) < SB * 30) { const int b = i / 30, r = i % 30; dst = B.out + O_CS + (((size_t)layer * SB + b) * CHIST + r) * DCONV;
        src = (ST + r < CHIST) ? P.state_conv + (((size_t)layer * SB + b) * CHIST + ST + r) * DCONV : B.U + (size_t)(MP + b * ST + (ST + r - CHIST)) * 256; }
    else { i -= SB * 30; const int b = i / 15, r = i % 15; dst = B.out + O_PS + (((size_t)layer * SB + b) * PHIST + r) * DPOOL;
        src = (ST + r < PHIST) ? P.state_pool + (((size_t)layer * SB + b) * PHIST + ST + r) * DPOOL : B.XC + (size_t)(MP + b * ST + (ST + r - PHIST)) * 256; }
    *((f32x4*)dst + lane) = *((const f32x4*)src + lane);
}

__device__ __forceinline__ void rho_map(int rho, int& qq, int& head) { const int hf = (rho >> 2) & 1, i = (rho & 3) + 4 * (rho >> 3); qq = 2 * hf + (i >> 3); head = i & 7; }
typedef float f32x2 __attribute__((ext_vector_type(2)));
__device__ __forceinline__ void head_reduce(const f32x16& acc, const float (&wv)[16], float& s0, float& s1) {
    f32x2 a = {0.f, 0.f}, c = {0.f, 0.f};
#pragma unroll
    for (int h = 0; h < 8; h += 2) {
        const float f0 = acc[h], f1 = acc[h + 1], f2 = acc[8 + h], f3 = acc[9 + h];
        const int i0 = __float_as_int(f0), i1 = __float_as_int(f1), i2 = __float_as_int(f2), i3 = __float_as_int(f3);
        const f32x2 x01 = {__int_as_float(i0 > 0 ? i0 : 0), __int_as_float(i1 > 0 ? i1 : 0)}, x23 = {__int_as_float(i2 > 0 ? i2 : 0), __int_as_float(i3 > 0 ? i3 : 0)};
        const f32x2 w01 = {wv[h], wv[h + 1]}, w23 = {wv[8 + h], wv[9 + h]};
        a = __builtin_elementwise_fma(w01, x01, a); c = __builtin_elementwise_fma(w23, x23, c); }
    s0 = a.x + a.y; s1 = c.x + c.y;
}
typedef short s16x2 __attribute__((ext_vector_type(2)));
__device__ __forceinline__ void wfrag_build(const float* wrow  , int lane, bf16x8 (&wf)[2]) {
    const int r = lane & 31, hh = lane >> 5, ssel = r - 2 * hh; v4u pk = {0u, 0u, 0u, 0u};
    if (r < 4) { const f32x4 w0 = *(const f32x4*)(wrow + r * 8), w1 = *(const f32x4*)(wrow + r * 8 + 4); pk.x = pk_bf16(w0.x, w0.y); pk.y = pk_bf16(w0.z, w0.w); pk.z = pk_bf16(w1.x, w1.y); pk.w = pk_bf16(w1.z, w1.w); }
    const v4u z = {0u, 0u, 0u, 0u};
    wf[0] = __builtin_bit_cast(bf16x8, (r < 4 && ssel == 0) ? pk : z); wf[1] = __builtin_bit_cast(bf16x8, (r < 4 && ssel == 1) ? pk : z);
}
__device__ __forceinline__ f32x16 head_reduce_mfma(const f32x16& acc, const bf16x8 (&wf)[2]) {
    f32x16 y;
#pragma unroll
    for (int i = 0; i < 16; ++i) y[i] = 0.f;
#pragma unroll
    for (int st = 0; st < 2; ++st) { unsigned d[4];
#pragma unroll
        for (int p = 0; p < 4; ++p) { const float f0 = acc[8 * st + 2 * p], f1 = acc[8 * st + 2 * p + 1]; const unsigned w = pk_bf16(f0, f1);
            const s16x2 v = {(short)(w & 0xFFFFu), (short)(w >> 16)}; const s16x2 m = __builtin_elementwise_max(v, (s16x2){0, 0});
            d[p] = (unsigned)(unsigned short)m.x | ((unsigned)(unsigned short)m.y << 16); }
        const v4u pk = {d[0], d[1], d[2], d[3]};
        y = __builtin_amdgcn_mfma_f32_32x32x16_bf16(wf[st], __builtin_bit_cast(bf16x8, pk), y, 0, 0, 0); }
    return y;
}
constexpr int KI_LD = 144;
constexpr int KI_BUF = 128 * KI_LD;

__device__ __forceinline__ void scores_prompt_unit(const Bufs& B, LAS unsigned char* lds, int b, int qb, int tid, int abl = 0) {
    const int lane = tid & 63, wave = __builtin_amdgcn_readfirstlane(tid >> 6), hf = lane >> 5, qg = wave & 3, kh = wave >> 2;
    const int t0 = qb * 32; const size_t mrow = (size_t)b * T + t0 + 8 * qg;
    int qq, head; rho_map(lane & 31, qq, head);
    bf16x8 af[2][4]; bf16x8 wf[2][2];
#pragma unroll
    for (int a = 0; a < 2; ++a) {
#pragma unroll
        for (int ks = 0; ks < 4; ++ks) af[a][ks] = *(const bf16x8*)(B.QI + (mrow + 4 * a + qq) * 512 + head * 64 + 16 * ks + 8 * hf);
        wfrag_build(B.WI + (mrow + 4 * a) * 8, lane, wf[a]); }
    const int nchunk = (t0 + 32 + 127) >> 7;
    const bf16_t* kbase = B.KI + (size_t)b * T * 64;
    const int p0 = tid, p1 = tid + 512; const unsigned so0 = (unsigned)((p0 >> 3) * KI_LD + (p0 & 7) * 16), so1 = (unsigned)((p1 >> 3) * KI_LD + (p1 & 7) * 16);
    const bf16_t* kp0 = kbase + (size_t)(p0 >> 3) * 64 + (p0 & 7) * 8; const bf16_t* kp1 = kbase + (size_t)(p1 >> 3) * 64 + (p1 & 7) * 8;
    v4u rA0 = *(const v4u*)kp0, rA1 = *(const v4u*)kp1, rB0 = rA0, rB1 = rA1;
    if (nchunk > 1) { rB0 = *(const v4u*)(kp0 + 128 * 64); rB1 = *(const v4u*)(kp1 + 128 * 64); }
    *(LAS v4u*)(lds + so0) = rA0; *(LAS v4u*)(lds + so1) = rA1;
    if (nchunk > 1) { *(LAS v4u*)(lds + KI_BUF + so0) = rB0; *(LAS v4u*)(lds + KI_BUF + so1) = rB1; }
    if (nchunk > 2) { rA0 = *(const v4u*)(kp0 + 2 * 128 * 64); rA1 = *(const v4u*)(kp1 + 2 * 128 * 64); }
    __syncthreads();
    constexpr int ST_OFF = 98304;
    _Float16* const scblk = B.SC + ((size_t)b * T + t0 + (tid >> 4)) * T + 8 * (tid & 15);
    const unsigned fro = (unsigned)((64 * kh + (lane & 31)) * KI_LD + 16 * hf);
    bf16x8 bqA[2][4], bqB[2][4];
#pragma unroll
    for (int kbl = 0; kbl < 2; ++kbl)
#pragma unroll
        for (int ks = 0; ks < 4; ++ks) bqA[kbl][ks] = *(const LAS bf16x8*)(lds + fro + (32 * kbl) * KI_LD + 32 * ks);
#define SCORE_MM(dst, a_, kbl_, BQ) do { _Pragma("unroll") for (int i = 0; i < 16; ++i) (dst)[i] = 0.f; \
            _Pragma("unroll") for (int ks = 0; ks < 4; ++ks) (dst) = __builtin_amdgcn_mfma_f32_32x32x16_bf16(af[a_][ks], BQ[kbl_][ks], (dst), 0, 0, 0); } while (0)
#define SCORE_HR(acc_, a_, j_) do { const f32x16 y = head_reduce_mfma(acc_, wf[a_]); LAS _Float16* sp = stile + (4 * ((j_) & 1)) * 128 + 32 * ((j_) >> 1); \
            sp[0] = (_Float16)y[0]; sp[128] = (_Float16)y[1]; sp[256] = (_Float16)y[2]; sp[384] = (_Float16)y[3]; } while (0)
#define SCORE_BODY(c_, BQC, BQN, RW0, RW1, RL0, RL1) { const int c = (c_); \
        if (c + 3 < nchunk && !(abl & 2)) { RL0 = *(const v4u*)(kp0 + (size_t)(c + 3) * 128 * 64); RL1 = *(const v4u*)(kp1 + (size_t)(c + 3) * 128 * 64); } \
        if (c > 0) { const v4u sv = *(const LAS v4u*)(lds + ST_OFF + ((c - 1) & 1) * 8192 + (tid >> 4) * 256 + (tid & 15) * 16); if (!(abl & 1)) __builtin_nontemporal_store(sv, (v4u*)(scblk + (size_t)(c - 1) * 128)); else if (sv.x == 0x12345u) *(v4u*)(scblk) = sv; } \
        if (c == nchunk) break; \
        LAS unsigned char* nxt = lds + ((c + 1) & 1) * KI_BUF; \
        if (c + 1 < nchunk) { _Pragma("unroll") for (int kbl = 0; kbl < 2; ++kbl) _Pragma("unroll") for (int ks = 0; ks < 4; ++ks) BQN[kbl][ks] = *(const LAS bf16x8*)(nxt + fro + (32 * kbl) * KI_LD + 32 * ks); } \
        f32x16 a0, a1; \
        LAS _Float16* stile = (LAS _Float16*)(lds + ST_OFF + (hf ? 2 : (c & 1)) * 8192) + (8 * qg) * 128 + 64 * kh + (lane & 31);        \
        { \
        SCORE_MM(a0, 0, 0, BQC); \
        SCORE_MM(a1, 1, 0, BQC); SCORE_HR(a0, 0, 0); \
        SCORE_MM(a0, 0, 1, BQC); SCORE_HR(a1, 1, 1); \
        SCORE_MM(a1, 1, 1, BQC); SCORE_HR(a0, 0, 2); \
        SCORE_HR(a1, 1, 3); } \
        if (c + 2 < nchunk) { LAS unsigned char* wb = lds + (c & 1) * KI_BUF; *(LAS v4u*)(wb + so0) = RW0; *(LAS v4u*)(wb + so1) = RW1; }        \
        __syncthreads(); }
    for (int c2 = 0; ; c2 += 2) { SCORE_BODY(c2, bqA, bqB, rA0, rA1, rB0, rB1) SCORE_BODY(c2 + 1, bqB, bqA, rB0, rB1, rA0, rA1) }
#undef SCORE_BODY
#undef SCORE_HR
#undef SCORE_MM
}
__device__ __forceinline__ void scores_sample_task(const Bufs& B, const P2Args& P, int layer, int task, int lane, LAS unsigned char* swl  ) {
    const int hf = lane >> 5; const bool newk = task >= SB * NPAGES; const int b = newk ? task - SB * NPAGES : task / NPAGES, pg = newk ? 0 : task % NPAGES;
    const size_t mrow = (size_t)MP + b * ST;
    int qq, head; rho_map(lane & 31, qq, head);
    bf16x8 af[2][4]; bf16x8 wf[2][2];
#pragma unroll
    for (int a = 0; a < 2; ++a) {
#pragma unroll
        for (int ks = 0; ks < 4; ++ks) af[a][ks] = *(const bf16x8*)(B.QI + (mrow + 4 * a + qq) * 512 + head * 64 + 16 * ks + 8 * hf);
        wfrag_build(B.WI + (mrow + 4 * a) * 8, lane, wf[a]); }
    _Float16* sc0 = B.SCS + (size_t)(b * ST) * SCS_LD + (lane & 31);
    if (!newk) {
        const float* pgp = P.cache_kidx + (((size_t)layer * NPOOL + P.page_table[b * NPAGES + pg]) * PAGE + (lane >> 4)) * ID + 4 * (lane & 15);
        f32x4 u[4][8];
#pragma unroll
        for (int kb = 0; kb < 4; ++kb)
#pragma unroll
            for (int q = 0; q < 8; ++q) u[kb][q] = *(const f32x4*)(pgp + (size_t)(32 * kb + 4 * q) * ID);
#pragma unroll
        for (int kb = 0; kb < 4; ++kb) {
            asm volatile("" ::: "memory");
#pragma unroll
            for (int q = 0; q < 8; ++q) { v2u p; p.x = pk_bf16(u[kb][q].x, u[kb][q].y); p.y = pk_bf16(u[kb][q].z, u[kb][q].w); *(LAS v2u*)(swl + (4 * q + (lane >> 4)) * KI_LD + (lane & 15) * 8) = p; }
            asm volatile("" ::: "memory");
            bf16x8 bfg[4];
#pragma unroll
            for (int ks = 0; ks < 4; ++ks) bfg[ks] = *(const LAS bf16x8*)(swl + (lane & 31) * KI_LD + 32 * ks + 16 * hf);
            asm volatile("" ::: "memory");
#pragma unroll
            for (int a = 0; a < 2; ++a) { f32x16 acc;
#pragma unroll
                for (int i = 0; i < 16; ++i) acc[i] = 0.f;
#pragma unroll
                for (int ks = 0; ks < 4; ++ks) acc = __builtin_amdgcn_mfma_f32_32x32x16_bf16(af[a][ks], bfg[ks], acc, 0, 0, 0);
                const f32x16 y = head_reduce_mfma(acc, wf[a]);
                if (hf == 0) { _Float16* sp = sc0 + (size_t)(4 * a) * SCS_LD + pg * PAGE + 32 * kb; sp[0] = (_Float16)y[0]; sp[SCS_LD] = (_Float16)y[1]; sp[2 * SCS_LD] = (_Float16)y[2]; sp[3 * SCS_LD] = (_Float16)y[3]; } }
        }
    } else {
        const int kr = (lane & 31) < ST ? (lane & 31) : 0;
        bf16x8 bfg[4];
#pragma unroll
        for (int ks = 0; ks < 4; ++ks) bfg[ks] = *(const bf16x8*)(B.KI + (mrow + kr) * 64 + 16 * ks + 8 * hf);
#pragma unroll
        for (int a = 0; a < 2; ++a) { f32x16 acc;
#pragma unroll
            for (int i = 0; i < 16; ++i) acc[i] = 0.f;
#pragma unroll
            for (int ks = 0; ks < 4; ++ks) acc = __builtin_amdgcn_mfma_f32_32x32x16_bf16(af[a][ks], bfg[ks], acc, 0, 0, 0);
            const f32x16 y = head_reduce_mfma(acc, wf[a]);
            if (lane < ST) { _Float16* sp = sc0 + (size_t)(4 * a) * SCS_LD + PAST; sp[0] = (_Float16)y[0]; sp[SCS_LD] = (_Float16)y[1]; sp[2 * SCS_LD] = (_Float16)y[2]; sp[3 * SCS_LD] = (_Float16)y[3]; } }
    }
}

struct P3Args { const float* cache_k; const float* cache_v; const int* page_table; };
typedef short s16x4 __attribute__((ext_vector_type(4)));
constexpr int WL_BYTES = 16384, WL_LIST = 4096, WL_VB = 5120, VB_LD = 160, NHC = 4;
__device__ __forceinline__ unsigned f16_sortkey(unsigned h) { return (h & 0x8000u) ? (~h & 0xFFFFu) : (h | 0x8000u); }
__device__ __forceinline__ void find_bin(const LAS unsigned* hist, int ncopy, int K, int lane, int& bin, int& above) {
    unsigned c0 = 0, c1 = 0, c2 = 0, c3 = 0;
    for (int cp = 0; cp < ncopy; ++cp) { const v4u h = *(const LAS v4u*)(hist + cp * 256 + 4 * lane); c0 += h.x; c1 += h.y; c2 += h.z; c3 += h.w; }
    const int tot = (int)(c0 + c1 + c2 + c3); int v = tot;
#pragma unroll
    for (int o = 1; o < 64; o <<= 1) { const int tmp = __shfl_down(v, o); if (lane + o < 64) v += tmp; }
    const int S = v - tot;
    const bool mine = (S < K) && (v >= K);
    const unsigned long long mk = __ballot(mine); const int L = mk ? (int)__builtin_ctzll(mk) : 0;
    int run = S, lb = 4 * lane, la = S; bool found = false;
    if (run + (int)c3 >= K) { lb = 4 * lane + 3; la = run; found = true; } else run += (int)c3;
    if (!found) { if (run + (int)c2 >= K) { lb = 4 * lane + 2; la = run; found = true; } else run += (int)c2; }
    if (!found) { if (run + (int)c1 >= K) { lb = 4 * lane + 1; la = run; found = true; } else run += (int)c1; }
    if (!found) { lb = 4 * lane; la = run; }
    bin = __shfl(lb, L); above = __shfl(la, L);
}
__device__ __forceinline__ unsigned sortkey2(unsigned x) { const unsigned sgn = (x >> 15) & 0x00010001u; return x ^ ((sgn * 0x7FFFu) | 0x80008000u); }
template <bool SMP, int MODE = 0>
__device__ __forceinline__ void select_attend_task(const Bufs& B, const P3Args& P, int layer, int m_in, int lane_in, LAS unsigned char* wl) {
    int m = m_in, lane = lane_in; asm volatile("" : "+s"(m)); asm volatile("" : "+v"(lane));
    constexpr int CIT = SMP ? 11 : 16, NCH = SMP ? 3 : 1;
    const int b = SMP ? (m - MP) / ST : m / T, t = SMP ? (m - MP) % ST : m % T; const int n = SMP ? PAST + t + 1 : t + 1;
    const unsigned char* scb = (const unsigned char*)(SMP ? B.SCS + (size_t)(m - MP) * SCS_LD : B.SC + (size_t)m * T);
    LAS unsigned* hist = (LAS unsigned*)wl; LAS unsigned* list = (LAS unsigned*)(wl + WL_LIST);
    const int cnt = n < TOPK ? n : TOPK;
    asm volatile("" ::: "memory");
    if (MODE == 2 || MODE == 3) {
#pragma unroll
        for (int q = 0; q < 4; ++q) list[lane + 64 * q] = (unsigned)((lane + 64 * q) * 29 % (n > 1 ? n : 1));
    } else if (n <= TOPK) {
#pragma unroll
        for (int q = 0; q < 4; ++q) { const int i = lane + 64 * q; list[i] = i < n ? (unsigned)i : 0u; }
    } else {
        const int nIt = (n + 511) >> 9;
        v4u kk[CIT];
#define LOADCHUNK(ch_) do { _Pragma("unroll") for (int it = 0; it < CIT; ++it) { kk[it] = (v4u){0u, 0u, 0u, 0u}; if ((ch_) * CIT + it < nIt) kk[it] = __builtin_nontemporal_load((const v4u*)(scb + ((ch_) * CIT + it) * 1024 + (unsigned)(lane * 16))); } \
        _Pragma("unroll") for (int it = 0; it < CIT; ++it) { const int e0 = ((ch_) * CIT + it) * 512 + lane * 8; unsigned w[4] = {kk[it].x, kk[it].y, kk[it].z, kk[it].w}; \
            _Pragma("unroll") for (int d = 0; d < 4; ++d) { unsigned k2 = sortkey2(w[d]); if (e0 + 2 * d >= n) k2 = 0u; else if (e0 + 2 * d + 1 >= n) k2 &= 0xFFFFu; w[d] = k2; } \
            kk[it] = (v4u){w[0], w[1], w[2], w[3]}; } } while (0)
#define FOR_KEYS(ch_) _Pragma("unroll") for (int it = 0; it < CIT; ++it) if ((ch_) * CIT + it < nIt) { const int e0 = ((ch_) * CIT + it) * 512 + lane * 8; (void)e0; unsigned w[4] = {kk[it].x, kk[it].y, kk[it].z, kk[it].w}; \
            asm volatile("" : "+v"(w[0]), "+v"(w[1]), "+v"(w[2]), "+v"(w[3])); _Pragma("unroll") for (int d = 0; d < 4; ++d) { const unsigned k0 = w[d] & 0xFFFFu, k1 = w[d] >> 16; (void)k0; (void)k1;
#define END_KEYS } }
#pragma unroll
        for (int q = 0; q < 4 * NHC; ++q) hist[lane + 64 * q] = 0u;
        if (NCH == 1) LOADCHUNK(0);
        asm volatile("s_waitcnt lgkmcnt(0)" ::: "memory");
        LAS unsigned* hc = hist + (lane & (NHC - 1)) * 256;
#pragma unroll 1
        for (int ch = 0; ch < NCH; ++ch) { if (NCH > 1) LOADCHUNK(ch);
            FOR_KEYS(ch) __hip_atomic_fetch_add(hc + (k0 >> 8), 1u, __ATOMIC_RELAXED, __HIP_MEMORY_SCOPE_WORKGROUP); __hip_atomic_fetch_add(hc + (k1 >> 8), 1u, __ATOMIC_RELAXED, __HIP_MEMORY_SCOPE_WORKGROUP); END_KEYS }
        asm volatile("s_waitcnt lgkmcnt(0)" ::: "memory");
        int B1, above1; find_bin(hist, NHC, TOPK, lane, B1, above1);
        if (MODE == 11) { if (B1 == 12345) list[lane] = (unsigned)above1; return; }
        asm volatile("" ::: "memory");
#pragma unroll
        for (int q = 0; q < 4; ++q) hist[lane + 64 * q] = 0u;
        asm volatile("s_waitcnt lgkmcnt(0)" ::: "memory");
#pragma unroll 1
        for (int ch = 0; ch < NCH; ++ch) { if (NCH > 1) LOADCHUNK(ch);
            FOR_KEYS(ch) if ((int)(k0 >> 8) == B1) __hip_atomic_fetch_add(hist + (k0 & 255u), 1u, __ATOMIC_RELAXED, __HIP_MEMORY_SCOPE_WORKGROUP);
                         if ((int)(k1 >> 8) == B1) __hip_atomic_fetch_add(hist + (k1 & 255u), 1u, __ATOMIC_RELAXED, __HIP_MEMORY_SCOPE_WORKGROUP); END_KEYS }
        asm volatile("s_waitcnt lgkmcnt(0)" ::: "memory");
        int B2, above2; find_bin(hist, 1, TOPK - above1, lane, B2, above2);
        const unsigned tau = ((unsigned)B1 << 8) | (unsigned)B2; const int cnt_gt = above1 + above2;
        if (MODE == 12) { if (tau == 0x12345u) list[lane] = (unsigned)cnt_gt; return; }
        constexpr int NMW = (CIT + 3) / 4;
#define BUILD_MASKS(ch_) do { _Pragma("unroll") for (int wq = 0; wq < NMW; ++wq) { mg[wq] = 0u; me[wq] = 0u; } \
            FOR_KEYS(ch_) const unsigned g2 = ((tau - k0) >> 31) | (((tau - k1) >> 31) << 1), q2 = (((k0 ^ tau) - 1u) >> 31) | ((((k1 ^ tau) - 1u) >> 31) << 1); \
                mg[it >> 2] |= g2 << (8 * (it & 3) + 2 * d); me[it >> 2] |= q2 << (8 * (it & 3) + 2 * d); END_KEYS } while (0)
        unsigned mg[NMW], me[NMW];
        int cg = 0, ce = 0;
#pragma unroll 1
        for (int ch = 0; ch < NCH; ++ch) { if (NCH > 1) LOADCHUNK(ch);
            BUILD_MASKS(ch);
#pragma unroll
            for (int wq = 0; wq < NMW; ++wq) { cg += __popc(mg[wq]); ce += __popc(me[wq]); } }
        if (MODE == 13) { if (cg == 12345) list[lane] = (unsigned)ce; return; }
        int pg = cg, pe = ce;
#pragma unroll
        for (int o = 1; o < 64; o <<= 1) { const int tg = __shfl_up(pg, o), te = __shfl_up(pe, o); if (lane >= o) { pg += tg; pe += te; } }
        pg -= cg; pe = cnt_gt + (pe - ce);
        asm volatile("" ::: "memory");
#pragma unroll 1
        for (int ch = 0; ch < NCH; ++ch) { if (NCH > 1) { LOADCHUNK(ch); BUILD_MASKS(ch); }
#pragma unroll
            for (int wq = 0; wq < NMW; ++wq) { const int ebase = ((ch * CIT + 4 * wq) * 512) + lane * 8;
                unsigned m = mg[wq];
                while (m) { const int bb = __builtin_ctz(m); m &= m - 1u; list[pg] = (unsigned)(ebase + ((bb >> 3) << 9) + (bb & 7)); ++pg; }
                m = me[wq];
                while (m) { const int bb = __builtin_ctz(m); m &= m - 1u; if (pe < TOPK) list[pe] = (unsigned)(ebase + ((bb >> 3) << 9) + (bb & 7)); ++pe; } } }
#undef BUILD_MASKS
#undef LOADCHUNK
#undef FOR_KEYS
#undef END_KEYS
    }
    asm volatile("s_waitcnt lgkmcnt(0)" ::: "memory");
    if (MODE == 1) return;
    const int hcol = lane & 15, g = lane >> 4;
    const float* ckb = nullptr; const float* cvb = nullptr; const int* ptb = nullptr;
    if (SMP) { ckb = P.cache_k + (size_t)layer * NPOOL * PAGE * KVD; cvb = P.cache_v + (size_t)layer * NPOOL * PAGE * KVD; ptb = P.page_table + b * NPAGES; }
    const unsigned char* kvb = (const unsigned char*)(SMP ? B.KV + (size_t)(MP + b * ST) * 256 : B.KV + (size_t)b * T * 256);
    LAS unsigned char* vb = wl + WL_VB;
    constexpr float LOG2E = 1.4426950408889634f;
#pragma unroll 1
    for (int nk = 0; nk < 2; ++nk) {
        bf16x8 qf[2];
#pragma unroll
        for (int ks = 0; ks < 2; ++ks) { qf[ks] = (bf16x8){0, 0, 0, 0, 0, 0, 0, 0}; if (hcol < 4) qf[ks] = *(const bf16x8*)(B.QB + (size_t)m * 512 + (4 * nk + hcol) * 64 + 32 * ks + 8 * g); }
        f32x4 S[16];
        if (SMP) {
#pragma unroll
            for (int tl = 0; tl < 16; ++tl) {
                const unsigned kidx = list[16 * tl + hcol]; bf16x8 a0, a1;
                if (kidx < (unsigned)PAST) { const float* kp = ckb + ((size_t)ptb[kidx >> 7] * PAGE + (kidx & 127u)) * KVD + 64 * nk + 8 * g;
                    const f32x4 u0 = *(const f32x4*)kp, u1 = *(const f32x4*)(kp + 4), u2 = *(const f32x4*)(kp + 32), u3 = *(const f32x4*)(kp + 36);
                    v4u p0, p1; p0.x = pk_bf16(u0.x, u0.y); p0.y = pk_bf16(u0.z, u0.w); p0.z = pk_bf16(u1.x, u1.y); p0.w = pk_bf16(u1.z, u1.w);
                    p1.x = pk_bf16(u2.x, u2.y); p1.y = pk_bf16(u2.z, u2.w); p1.z = pk_bf16(u3.x, u3.y); p1.w = pk_bf16(u3.z, u3.w);
                    a0 = __builtin_bit_cast(bf16x8, p0); a1 = __builtin_bit_cast(bf16x8, p1);
                } else { const unsigned off = (kidx - PAST) * 512u + (unsigned)(128 * nk + 16 * g); a0 = *(const bf16x8*)(kvb + off); a1 = *(const bf16x8*)(kvb + off + 64u); }
                f32x4 s = {0.f, 0.f, 0.f, 0.f};
                s = __builtin_amdgcn_mfma_f32_16x16x32_bf16(a0, qf[0], s, 0, 0, 0);
                S[tl] = __builtin_amdgcn_mfma_f32_16x16x32_bf16(a1, qf[1], s, 0, 0, 0);
            }
        } else {
#define KLOAD(dst, kb_, q_) do { const int kl_ = (lane >> 3) + 8 * (q_), part_ = lane & 7; const unsigned kidx_ = list[32 * (kb_) + kl_]; \
                (dst) = *(const v4u*)(kvb + (kidx_ * 512u + (unsigned)(128 * nk + 16 * part_))); } while (0)
            v4u pk[2][8];
#pragma unroll
            for (int i = 0; i < 8; ++i) KLOAD(pk[0][i], i >> 2, i & 3);
#pragma unroll
            for (int kb = 0; kb < 8; ++kb) {
                asm volatile("" ::: "memory");
                if ((kb & 1) == 0 && kb + 2 < 8) {
#pragma unroll
                    for (int i = 0; i < 8; ++i) KLOAD(pk[((kb >> 1) + 1) & 1][i], kb + 2 + (i >> 2), i & 3);
                }
#pragma unroll
                for (int q = 0; q < 4; ++q) *(LAS v4u*)(vb + ((lane >> 3) + 8 * q) * VB_LD + (lane & 7) * 16) = pk[(kb >> 1) & 1][4 * (kb & 1) + q];
                asm volatile("" ::: "memory");
#pragma unroll
                for (int t2 = 0; t2 < 2; ++t2) { const LAS unsigned char* kr = vb + (16 * t2 + hcol) * VB_LD + 16 * g;
                    const bf16x8 a0 = *(const LAS bf16x8*)kr, a1 = *(const LAS bf16x8*)(kr + 64);
                    f32x4 s = {0.f, 0.f, 0.f, 0.f};
                    s = __builtin_amdgcn_mfma_f32_16x16x32_bf16(a0, qf[0], s, 0, 0, 0);
                    S[2 * kb + t2] = __builtin_amdgcn_mfma_f32_16x16x32_bf16(a1, qf[1], s, 0, 0, 0); }
                asm volatile("" ::: "memory");
            }
#undef KLOAD
        }
        if (cnt < TOPK) {
#pragma unroll
            for (int tl = 0; tl < 16; ++tl) { const int p0i = 16 * tl + 4 * g;
                S[tl].x = p0i + 0 < cnt ? S[tl].x : -INFINITY; S[tl].y = p0i + 1 < cnt ? S[tl].y : -INFINITY; S[tl].z = p0i + 2 < cnt ? S[tl].z : -INFINITY; S[tl].w = p0i + 3 < cnt ? S[tl].w : -INFINITY; } }
        if (MODE == 3) { float sacc = 0.f;
#pragma unroll
            for (int tl = 0; tl < 16; ++tl) sacc += S[tl].x + S[tl].w; if (sacc == 1234.5f) *(float*)(B.X) = sacc; continue; }
#define VLOAD(dst, kb_, q_) do { const int kl_ = (lane >> 3) + 8 * (q_), part_ = lane & 7; const unsigned kidx_ = list[32 * (kb_) + kl_]; \
            if (SMP && kidx_ < (unsigned)PAST) { const float* vp_ = cvb + ((size_t)ptb[kidx_ >> 7] * PAGE + (kidx_ & 127u)) * KVD + 64 * nk + 8 * part_; \
                const f32x4 u0_ = *(const f32x4*)vp_, u1_ = *(const f32x4*)(vp_ + 4); (dst).x = pk_bf16(u0_.x, u0_.y); (dst).y = pk_bf16(u0_.z, u0_.w); (dst).z = pk_bf16(u1_.x, u1_.y); (dst).w = pk_bf16(u1_.z, u1_.w); \
            } else (dst) = *(const v4u*)(kvb + ((SMP ? kidx_ - PAST : kidx_) * 512u + (unsigned)(256 + 128 * nk + 16 * part_))); } while (0)
        v4u pv[2][8];
        if (!SMP) {
#pragma unroll
            for (int i = 0; i < 8; ++i) VLOAD(pv[0][i], i >> 2, i & 3);
        }
        float mx = -INFINITY;
#pragma unroll
        for (int tl = 0; tl < 16; ++tl) mx = fmaxf(fmaxf(mx, fmaxf(S[tl].x, S[tl].y)), fmaxf(S[tl].z, S[tl].w));
        mx = fmaxf(mx, __shfl_xor(mx, 16)); mx = fmaxf(mx, __shfl_xor(mx, 32));
        const float mx2 = mx * LOG2E; float sum = 0.f;
#pragma unroll
        for (int tl = 0; tl < 16; ++tl) { S[tl].x = __builtin_amdgcn_exp2f(S[tl].x * LOG2E - mx2); S[tl].y = __builtin_amdgcn_exp2f(S[tl].y * LOG2E - mx2); S[tl].z = __builtin_amdgcn_exp2f(S[tl].z * LOG2E - mx2); S[tl].w = __builtin_amdgcn_exp2f(S[tl].w * LOG2E - mx2);
            sum += (S[tl].x + S[tl].y) + (S[tl].z + S[tl].w); }
        sum += __shfl_xor(sum, 16); sum += __shfl_xor(sum, 32);
        f32x4 O[4];
#pragma unroll
        for (int dt = 0; dt < 4; ++dt) O[dt] = (f32x4){0.f, 0.f, 0.f, 0.f};
#pragma unroll
        for (int kb = 0; kb < 8; ++kb) {
            asm volatile("" ::: "memory");
            if (SMP) {
#pragma unroll
                for (int q = 0; q < 4; ++q) VLOAD(pv[0][q], kb, q);
            } else if ((kb & 1) == 0 && kb + 2 < 8) {
#pragma unroll
                for (int i = 0; i < 8; ++i) VLOAD(pv[((kb >> 1) + 1) & 1][i], kb + 2 + (i >> 2), i & 3);
            }
#pragma unroll
            for (int q = 0; q < 4; ++q) *(LAS v4u*)(vb + ((lane >> 3) + 8 * q) * VB_LD + (lane & 7) * 16) = SMP ? pv[0][q] : pv[(kb >> 1) & 1][4 * (kb & 1) + q];
            asm volatile("" ::: "memory");
            v4u pw; pw.x = pk_bf16(S[2 * kb].x, S[2 * kb].y); pw.y = pk_bf16(S[2 * kb].z, S[2 * kb].w); pw.z = pk_bf16(S[2 * kb + 1].x, S[2 * kb + 1].y); pw.w = pk_bf16(S[2 * kb + 1].z, S[2 * kb + 1].w);
            const bf16x8 pf = __builtin_bit_cast(bf16x8, pw);
#pragma unroll
            for (int dt = 0; dt < 4; ++dt) {
                const LAS unsigned char* ta = vb + (4 * g + (hcol >> 2)) * VB_LD + (16 * dt + 4 * (hcol & 3)) * 2;
                const s16x4 lo = __builtin_bit_cast(s16x4, __builtin_amdgcn_ds_read_tr16_b64_v4i16((LAS s16x4*)ta));
                const s16x4 hi = __builtin_bit_cast(s16x4, __builtin_amdgcn_ds_read_tr16_b64_v4i16((LAS s16x4*)(ta + 16 * VB_LD)));
                const bf16x8 af = {lo.x, lo.y, lo.z, lo.w, hi.x, hi.y, hi.z, hi.w};
                O[dt] = __builtin_amdgcn_mfma_f32_16x16x32_bf16(af, pf, O[dt], 0, 0, 0); }
            asm volatile("" ::: "memory");
        }
#undef VLOAD
        if (hcol < 4 && (MODE == 0 || sum == 123.456f)) { const float inv = 1.f / sum;
#pragma unroll
            for (int dt = 0; dt < 4; ++dt) { v2u w; w.x = pk_bf16(O[dt].x * inv, O[dt].y * inv); w.y = pk_bf16(O[dt].z * inv, O[dt].w * inv);
                *(v2u*)(B.CA + (size_t)m * DM + DCONV + (4 * nk + hcol) * 64 + 16 * dt + 4 * g) = w; } }
    }
    asm volatile("s_waitcnt lgkmcnt(0)" ::: "memory");
}
constexpr int NPHASE = 1 + 9 * DEPTH;
constexpr int I_IN = (DM / 64) * ((DIN + 31) / 32), I_C = (DCONV / 64) * (DM / 32), I_A = (DATT / 64) * (DM / 32), I_O = (DM / 64) * (DM / 32), I_1 = (DM / 64) * (DFF / 32), I_2 = (DFF / 64) * (DM / 32);
constexpr int I_L = I_IN + I_C + I_A + I_O + I_1 + I_2;
#ifndef PH_MASK
#define PH_MASK 0x3FF
#endif
#define PH_ON(k) (((PH_MASK) >> (k)) & 1)
#ifndef REP_PH
#define REP_PH -1
#endif
#ifndef REP_N
#define REP_N 1
#endif
#define REPS(k) for (int rep_ = 0; rep_ <= ((REP_PH) == (k) ? (REP_N) : 0); ++rep_)
__global__ void __launch_bounds__(NTHR, 2) fwd(Args args) {
    extern __shared__ __attribute__((aligned(16))) unsigned char lds_[];
    LAS unsigned char* lds = (LAS unsigned char*)lds_;
    volatile LAS unsigned* MISC = (volatile LAS unsigned*)(lds + MISC_OFF);
    const int tid = threadIdx.x, lane = tid & 63, wave = __builtin_amdgcn_readfirstlane(tid >> 6);
    const int G = gridDim.x; const int bx = blockIdx.x; const int vcu = (G % 8 == 0) ? (bx % 8) * (G / 8) + bx / 8 : bx;
    const int gw = vcu * NWAVES + wave, NGW = G * NWAVES;
    unsigned* ctl = (unsigned*)(args.ws + WS_CTL);
    for (int u = tid; u < (LDS_BYTES - LDSCTL_OFF) / 4; u += NTHR) ((LAS unsigned*)(lds + LDSCTL_OFF))[u] = 0u;
    __syncthreads();
    (void)xcd_barrier_post(ctl + CW_BAR, MISC + 8);
#define KAS __attribute__((address_space(4)))
#define ARGP(i) (*(const float* KAS const*)(ka_ + 8 * (i)))
#define MKBUFS() int tid_ = threadIdx.x; asm volatile("" : "+v"(tid_)); const int lane = tid_ & 63; (void)lane; const int wave = __builtin_amdgcn_readfirstlane(tid_ >> 6); (void)wave; \
    int G = gridDim.x, bx = blockIdx.x; asm volatile("" : "+s"(G), "+s"(bx)); const int vcu = (G % 8 == 0) ? (bx % 8) * (G / 8) + bx / 8 : bx; const int gw = vcu * NWAVES + wave, NGW = G * NWAVES; (void)gw; (void)NGW; \
    const KAS unsigned char* ka_ = (const KAS unsigned char*)__builtin_amdgcn_kernarg_segment_ptr(); asm volatile("" : "+s"(ka_)); \
    unsigned char* ws = *(unsigned char* KAS const*)(ka_ + 200); float* outp_ = *(float* KAS const*)(ka_ + 192); \
    Bufs B{}; B.X = (float*)(ws + WS_X); B.H = (bf16_t*)(ws + WS_H); B.U = (float*)(ws + WS_U); B.XC = (float*)(ws + WS_XC); B.QB = (bf16_t*)(ws + WS_QB); B.KV = (bf16_t*)(ws + WS_KV); \
    B.QI = (bf16_t*)(ws + WS_QI); B.KI = (bf16_t*)(ws + WS_KI); B.WI = (float*)(ws + WS_WI); B.G = (_Float16*)(ws + WS_G); B.CA = (bf16_t*)(ws + WS_CA); B.PA = (bf16_t*)(ws + WS_PA); \
    B.AT = (bf16_t*)(ws + WS_AT); B.MB = (bf16_t*)(ws + WS_MB); B.R = (bf16_t*)(ws + WS_R); B.SC = (_Float16*)(ws + WS_SC); B.SCS = (_Float16*)(ws + WS_SCS); \
    B.rc = (const float*)(ws + WS_ROPE); B.rs = B.rc + (T + ST) * 32; B.out = outp_;
#define IN(k) (args.ph_lo <= (k) && (k) < args.ph_hi)
#define GRIDBAR() do { XcdBarrier b_; b_.bar = (unsigned*)(args.ws + WS_CTL) + CW_BAR; b_.x = xb_xcc_id(); b_.st = (volatile LAS unsigned*)(lds + MISC_OFF) + 8; xcd_barrier(b_); } while (0)
#define SEAM(k) do { if (IN(k) && IN((k) + 1)) GRIDBAR(); } while (0)

    REPS(9) if (PH_ON(9) && IN(0)) { MKBUFS();
        LAS float* scr = (LAS float*)(lds + wave * 16384);
#define WCONV_ITEM(l_, r_in, scr_) do { const int wl_ = (l_); int r = (r_in); unsigned char* wb = ws + WS_W + (size_t)wl_ * W_LSTRIDE; \
            if (r < I_IN) { transpose_item<true>(ARGP(9) + (size_t)wl_ * DM * DIN, DM, DIN, (bf16_t*)(wb + WO_IN), scr_, r, lane, ARGP(8) + wl_ * DM); break; } r -= I_IN; \
            if (r < I_C) { transpose_item<false>(ARGP(14) + (size_t)wl_ * DCONV * DM, DCONV, DM, (bf16_t*)(wb + WO_C), scr_, r, lane, nullptr, DM, 0); break; } r -= I_C; \
            if (r < I_A) { transpose_item<false>(ARGP(15) + (size_t)wl_ * DATT * DM, DATT, DM, (bf16_t*)(wb + WO_C), scr_, r, lane, nullptr, DM, DCONV); break; } r -= I_A; \
            if (r < I_O) { transpose_item<false>(ARGP(19) + (size_t)wl_ * DM * DM, DM, DM, (bf16_t*)(wb + WO_O), scr_, r, lane); break; } r -= I_O; \
            if (r < I_1) { transpose_item<false>(ARGP(21) + (size_t)wl_ * DM * DFF, DM, DFF, (bf16_t*)(wb + WO_1), scr_, r, lane, ARGP(20) + wl_ * DM); break; } r -= I_1; \
            transpose_item<false>(ARGP(22) + (size_t)wl_ * DFF * DM, DFF, DM, (bf16_t*)(wb + WO_2), scr_, r, lane); } while (0)
        for (int it = gw; it < I_L; it += NGW) WCONV_ITEM(0, it, scr);
        for (int it = gw; it < DEPTH * 184; it += NGW) { const int l = it / 184, r = 7 * 256 + 72 + it % 184; bf16_t* p = (bf16_t*)(ws + WS_W + (size_t)l * W_LSTRIDE + WO_IN) + (size_t)r * DM;
            *((v4u*)p + lane) = (v4u){0u, 0u, 0u, 0u}; *((v4u*)p + 64 + lane) = (v4u){0u, 0u, 0u, 0u}; }
        for (int it = gw; it < DEPTH * DM; it += NGW) { const int l = it / DM, j = it % DM; const int c0 = 4 * lane, g = c0 >> 6, cl = c0 & 63;
            const float* pw = ARGP(16) + (((size_t)l * 4 + g) * 64 + cl) * 64; const float* ps = ARGP(17) + l * DPOOL + 64 * g; const float* wo = ARGP(18) + ((size_t)l * DPOOL + 64 * g) * DM + j;
            float a0 = 0.f, a1 = 0.f, a2 = 0.f, a3 = 0.f;
#pragma unroll 16
            for (int d = 0; d < 64; ++d) { const float f = ps[d] * wo[(size_t)d * DM]; a0 += pw[d] * f; a1 += pw[64 + d] * f; a2 += pw[128 + d] * f; a3 += pw[192 + d] * f; }
            v2u w; w.x = pk_bf16(a0, a1); w.y = pk_bf16(a2, a3);
            *(v2u*)((bf16_t*)(ws + WS_W + (size_t)l * W_LSTRIDE + WO_C) + (size_t)j * DM + (DCONV + DATT) + c0) = w; }
        {
            const double invr = exp(-(double)(tid_ & 31) / 32.0 * log(10000.0)) * 0.15915494309189535;
            for (int i = (vcu * NTHR + tid_); i < (T + ST) * 32; i += G * NTHR) { const int p = i >> 5; const double pos = p < T ? (double)p : (double)(PAST + p - T);
                const double tr = pos * invr; const float fr = (float)(tr - rint(tr)); ((float*)B.rc)[i] = __builtin_amdgcn_cosf(fr); ((float*)B.rs)[i] = __builtin_amdgcn_sinf(fr); } }
        for (int m = gw; m < M; m += 2 * NGW) { const int m2 = m + NGW; const bool has2 = m2 < M, sa_ = m >= MP, sb_ = m2 >= MP;
            prep_row2(sa_ ? ARGP(1) + (size_t)(m - MP) * DM : ARGP(0) + (size_t)m * DM, B.H + (size_t)m * DM, sa_ ? (float*)(ws + WS_SSQBS) + (size_t)(m - MP) * 64 : (float*)(ws + WS_SSQB) + (size_t)m * 16, sa_ ? 64 : 16,
                      sb_ ? ARGP(1) + (size_t)(m2 - MP) * DM : ARGP(0) + (size_t)m2 * DM, B.H + (size_t)m2 * DM, sb_ ? (float*)(ws + WS_SSQBS) + (size_t)(m2 - MP) * 64 : (float*)(ws + WS_SSQB) + (size_t)m2 * 16, sb_ ? 64 : 16, has2, lane); }
    }
    SEAM(0);

    for (int l = 0; l < DEPTH; ++l) {
        const int pb = 1 + 9 * l;
#define MKW() unsigned char* wb = ws + WS_W + (size_t)l * W_LSTRIDE; \
        const bf16_t* Win_t = (const bf16_t*)(wb + WO_IN); const bf16_t* Wc_t = (const bf16_t*)(wb + WO_C); const bf16_t* Wa_t = (const bf16_t*)(wb + WO_A); const bf16_t* Wp_t = (const bf16_t*)(wb + WO_P); \
        const bf16_t* Wo_t = (const bf16_t*)(wb + WO_O); const bf16_t* W1_t = (const bf16_t*)(wb + WO_1); const bf16_t* W2_t = (const bf16_t*)(wb + WO_2); (void)Win_t; (void)Wc_t; (void)Wa_t; (void)Wp_t; (void)Wo_t; (void)W1_t; (void)W2_t;

        REPS(0) if (PH_ON(0) && IN(pb + 0)) { MKBUFS(); MKW();
            pg8::Gemm g{B.H, Win_t, M, NIN, DM}; pg8::StaticOrder S; S.init(M, NIN, G, bx);
            LAS float* rst = (LAS float*)(lds + RST_OFF);
            { int pms[8];
#pragma unroll
                for (int i = 0; i < 8; ++i) { pg8::Unit uu; pms[i] = S.next(i, uu) ? uu.pm : -1; }
                float rv[8]; const int r_ = tid_ & 255;
#pragma unroll
                for (int i = 0; i < 8; ++i) rv[i] = pms[i] >= 0 ? row_ms_inv(ws, WS_SSQB, WS_SSQBS, (unsigned)(pms[i] * 256 + r_)) : 0.f;
#pragma unroll
                for (int i = 0; i < 8; ++i) if (tid_ < 256) rst[i * 256 + r_] = sqrtf(rv[i]); }
            __syncthreads();
#ifdef INPROJ_NULL_REP
            if (rep_ > 0) { EpiNull EN{(float*)(ws + WS_TMP + 200 * MiB)}; pg8::gemm_phase<EpiNull, pg8::StaticOrder, true, true>(lds, g, S, EN); } else
#endif
            { EpiInproj E{ws, (unsigned char*)outp_, l, rst};
            pg8::gemm_phase<EpiInproj, pg8::StaticOrder, true, true>(lds, g, S, E); }
            if (l == 0 && DEPTH > 1 && rep_ == 0) { pg8::Unit uu; const int nfull = (M / 256) * (NIN / 256) - (G > 0 ? ((M / 256) * (NIN / 256) / G) * G : 0);
                if (!S.next(((M / 256) * (NIN / 256)) / G, uu)) { const int nlight = G - nfull; LAS float* scr2 = (LAS float*)(lds + wave * 16384);
                    for (int it = (bx - nfull) * NWAVES + wave; it < I_L; it += nlight * NWAVES) WCONV_ITEM(1, it, scr2); } }
        }
        SEAM(pb + 0);
#ifdef EXTRA_BARS
        for (int eb = 0; eb < EXTRA_BARS; ++eb) GRIDBAR();
#endif
        REPS(1) if (PH_ON(1) && IN(pb + 1)) { MKBUFS();
            P2Args P{ARGP(5), ARGP(6), ARGP(10), ARGP(11), ARGP(12), ARGP(13), ARGP(4), (const int*)ARGP(7)};
            LAS float* wl = (LAS float*)(lds + 40960);
            for (int i = tid_; i < 48 * DCONV / 4; i += NTHR) { const int j = i / (DCONV / 4) - 8; ((LAS f32x4*)wl)[i] = (j >= 0 && j < CONVW) ? ((const f32x4*)(P.conv_w + (size_t)l * CONVW * DCONV))[i - 8 * (DCONV / 4)] : (f32x4){0.f, 0.f, 0.f, 0.f}; }
            __syncthreads();
#ifndef P2_REP_MODE
#define P2_REP_MODE 0
#endif
#ifndef P2_UNIT_ABL
#define P2_UNIT_ABL 0
#endif
            const int p2m = rep_ > 0 ? P2_REP_MODE : 0;
            {
                volatile LAS unsigned* q2 = MISC + 24 + l + 2 * rep_;
                const int vS = vcu, vC = (vcu + G - G / 3) % G, vT = (vcu + G - 2 * (G / 3)) % G;
                const int nS = (p2m == 0 || p2m == 1) ? (SB * NPAGES + SB - vS + G - 1) / G : 0, nC = (p2m == 0 || p2m == 2) ? (MP / 8 + SB - vC + G - 1) / G : 0, nT = (p2m == 0 || p2m == 2) ? (NB * 45 + SB * 45 - vT + G - 1) / G : 0;
                for (;;) { unsigned it = 0; if (lane == 0) it = __hip_atomic_fetch_add((LAS unsigned*)q2, 1u, __ATOMIC_RELAXED, __HIP_MEMORY_SCOPE_WORKGROUP); it = __builtin_amdgcn_readfirstlane(it);
                    int j = (int)it; if (j >= nS + 2 * nC + nT) break;
                    { const int ng = (nS >> 1) < nC ? (nS >> 1) : nC;
                        if (j < 3 * ng) { const int gq = j / 3, gr = j - 3 * gq;
                            if (gr < 2) scores_sample_task(B, P, l, vS + G * (2 * gq + gr), lane, lds + wave * (32 * KI_LD)); else conv_task(B, P, l, vC + G * gq, lane, wl);
                            continue; }
                        j -= 3 * ng;
                        if (j < nS - 2 * ng) { scores_sample_task(B, P, l, vS + G * (2 * ng + j), lane, lds + wave * (32 * KI_LD)); continue; } j -= nS - 2 * ng;
                        if (j < nC - ng) { conv_task(B, P, l, vC + G * (ng + j), lane, wl); continue; } j -= nC - ng; }
                    if (j < nC) { pool_task(B, P, l, vC + G * j, lane); continue; } j -= nC;
                    states_task(B, P, l, vT + G * j, lane); }
            }
            __syncthreads();
            int tid2 = threadIdx.x; asm volatile("" : "+v"(tid2));
            if (p2m == 0 || p2m == 3) for (int u = bx; u < 2 * (T / 32); u += G) { const int b = u < T / 32 ? 0 : 1, qb = u < T / 32 ? u : 2 * (T / 32) - 1 - u; scores_prompt_unit(B, lds, b, qb, tid2, rep_ > 0 ? P2_UNIT_ABL : 0); }
        }
        SEAM(pb + 1);
        REPS(2) if (PH_ON(2) && IN(pb + 2)) { MKBUFS();
            P3Args P3{ARGP(2), ARGP(3), (const int*)ARGP(7)};
            LAS unsigned char* wl = lds + wave * WL_BYTES;
            volatile LAS unsigned* qhead = MISC + 16 + l + 2 * rep_;
            const int nprompt = (MP - vcu + G - 1) / G; const int nconv = 0;
            for (;;) { unsigned it = 0; if (lane == 0) it = __hip_atomic_fetch_add((LAS unsigned*)qhead, 1u, __ATOMIC_RELAXED, __HIP_MEMORY_SCOPE_WORKGROUP); it = __builtin_amdgcn_readfirstlane(it);
                if ((int)it > nprompt + nconv) break;
                if ((int)it > nprompt) { WCONV_ITEM(1, vcu + G * ((int)it - nprompt - 1), (LAS float*)wl); continue; }
#ifdef P3_REP_SAMPLE_ONLY
                if (rep_ > 0 && it > 0) break;
                if (it == 0) { if (vcu < MS) select_attend_task<true>(B, P3, l, MP + vcu, lane, wl); }
#else
                if (it == 0) { if (vcu < MS && rep_ == 0) select_attend_task<true>(B, P3, l, MP + vcu, lane, wl); }
#endif
                else {
#ifdef P3_REP_MODE
                    if (rep_ > 0) select_attend_task<false, P3_REP_MODE>(B, P3, l, vcu + G * ((int)it - 1), lane, wl); else
#endif
                    select_attend_task<false>(B, P3, l, vcu + G * ((int)it - 1), lane, wl); } }
        }
        SEAM(pb + 2);
        REPS(3) if (PH_ON(3) && IN(pb + 3)) { MKBUFS(); MKW();
            const bf16_t* Wcat = Wc_t;
            for (int tk = wave * G + vcu; tk < 16 * (DM / 16); tk += NGW) { const int mt = tk & 15, nt = tk >> 4;
                const bf16_t* As = B.CA + (size_t)MP * DM;
                const f32x4 ya = sg_tile(As, DM, Wcat, DCONV, mt, nt, lane, DM), yb = sg_tile(As + DCONV, DM, Wcat + DCONV, DATT, mt, nt, lane, DM),
                            yc = sg_tile(As + DCONV + DATT, DM, Wcat + DCONV + DATT, DPOOL, mt, nt, lane, DM);
                const size_t row = (size_t)MP + 16 * mt + (lane & 15); const int col = 16 * nt + 4 * (lane >> 4); const _Float16* gp = B.G + row * 3072 + col;
                const f16x4 ga = *(const f16x4*)gp, gb = *(const f16x4*)(gp + 1024), gc = *(const f16x4*)(gp + 2048); float r[4];
#pragma unroll
                for (int e = 0; e < 4; ++e) r[e] = (float)ga[e] * ya[e] + (float)gb[e] * yb[e] + (float)gc[e] * yc[e];
                v2u w; w.x = pk_bf16(r[0], r[1]); w.y = pk_bf16(r[2], r[3]); *(v2u*)(B.MB + row * DM + col) = w; }
            pg8::Gemm g{B.CA, Wcat, MP, DM, DM}; pg8::StaticOrder S; S.init(MP, DM, G, bx); EpiGate E{B.MB, B.G};
            pg8::gemm_phase<EpiGate, pg8::StaticOrder, true, true>(lds, g, S, E);
        }
        SEAM(pb + 3);
        REPS(4) if (PH_ON(4) && IN(pb + 4)) { MKBUFS(); MKW();
            float* ssq_p = (float*)(ws + WS_SSQA); float* ssq_s = (float*)(ws + WS_SSQAS);
            for (int tk = (wave & 3) * G + vcu; tk < 16 * (DM / 16); tk += 4 * G) { const int mt = tk & 15, nt = tk >> 4;
                f32x4 y = sg_tile(B.MB + (size_t)MP * DM + (wave >> 2) * (DM / 2), DM, Wo_t + (wave >> 2) * (DM / 2), DM / 2, mt, nt, lane, DM);
                LAS f32x4* slot = (LAS f32x4*)(lds + RST_OFF) + (wave & 3) * 64 + lane;
                if (wave >= 4) *slot = y;
                __syncthreads();
                if (wave >= 4) continue;
                { const f32x4 y2 = *slot; y.x += y2.x; y.y += y2.y; y.z += y2.z; y.w += y2.w; }
                const size_t ro = ((size_t)MP + 16 * mt + (lane & 15)) * DM + 16 * nt + 4 * (lane >> 4);
                v2u* p = (v2u*)(B.H + ro); const v2u h = *p; f32x4 o; o.x = __uint_as_float(h.x << 16) + y.x; o.y = __uint_as_float(h.x & 0xffff0000u) + y.y; o.z = __uint_as_float(h.y << 16) + y.z; o.w = __uint_as_float(h.y & 0xffff0000u) + y.w;
                v2u hw; hw.x = pk_bf16(o.x, o.y); hw.y = pk_bf16(o.z, o.w); *p = hw;
                float ss = (o.x * o.x + o.y * o.y) + (o.z * o.z + o.w * o.w); ss += __shfl_xor(ss, 16); ss += __shfl_xor(ss, 32);
                if ((lane >> 4) == 0) ssq_s[(size_t)(16 * mt + (lane & 15)) * 64 + nt] = ss; }
            pg8::Gemm g{B.MB, Wo_t, MP, DM, DM}; pg8::StaticOrder S; S.init(MP, DM, G, bx); EpiResid E{B.H, ssq_p};
            pg8::gemm_phase<EpiResid, pg8::StaticOrder, true, true>(lds, g, S, E);
        }
        if (IN(pb + 4) && IN(pb + 6)) GRIDBAR();
        REPS(6) if (PH_ON(6) && IN(pb + 6)) { MKBUFS(); MKW();
            for (int tk = wave * G + vcu; tk < 16 * (DFF / 16); tk += NGW) { const int mt = tk & 15, nt = tk >> 4;
                const f32x4 y = sg_tile(B.H + (size_t)MP * DM, DM, W1_t, DM, mt, nt, lane); float r[4];
                const float r2 = row_ms_inv(ws, WS_SSQA, WS_SSQAS, (unsigned)(MP + 16 * mt + (lane & 15)));
#pragma unroll
                for (int e = 0; e < 4; ++e) { const float x = fmaxf(y[e], 0.f); r[e] = x * x * r2; }
                v2u w; w.x = pk_bf16(r[0], r[1]); w.y = pk_bf16(r[2], r[3]); *(v2u*)(B.R + ((size_t)MP + 16 * mt + (lane & 15)) * DFF + 16 * nt + 4 * (lane >> 4)) = w; }
            pg8::Gemm g{B.H, W1_t, MP, DFF, DM}; pg8::StaticOrder S; S.init(MP, DFF, G, bx);
            LAS float* rst = (LAS float*)(lds + RST_OFF);
            { int pms[4];
#pragma unroll
                for (int i = 0; i < 4; ++i) { pg8::Unit uu; pms[i] = S.next(i, uu) ? uu.pm : -1; }
                float rv[4]; const int r_ = tid_ & 255;
#pragma unroll
                for (int i = 0; i < 4; ++i) rv[i] = pms[i] >= 0 ? row_ms_inv(ws, WS_SSQA, WS_SSQAS, (unsigned)(pms[i] * 256 + r_)) : 0.f;
#pragma unroll
                for (int i = 0; i < 4; ++i) if (tid_ < 256) rst[i * 256 + r_] = rv[i]; }
            __syncthreads();
            EpiRelu2 E{B.R, DFF, rst};
            pg8::gemm_phase<EpiRelu2, pg8::StaticOrder, true, true>(lds, g, S, E);
        }
        SEAM(pb + 6);
        REPS(7) if (PH_ON(7) && IN(pb + 7)) { MKBUFS(); MKW();
            float* ssq_p = (float*)(ws + WS_SSQB); float* ssq_s = (float*)(ws + WS_SSQBS);
            for (int tk = (wave & 3) * G + vcu; tk < 16 * (DM / 16); tk += 4 * G) { const int mt = tk & 15, nt = tk >> 4;
                f32x4 y = sg_tile(B.R + (size_t)MP * DFF + (wave >> 2) * (DFF / 2), DFF, W2_t + (wave >> 2) * (DFF / 2), DFF / 2, mt, nt, lane, DFF);
                LAS f32x4* slot = (LAS f32x4*)(lds + RST_OFF) + (wave & 3) * 64 + lane;
                if (wave >= 4) *slot = y;
                __syncthreads();
                if (wave >= 4) continue;
                { const f32x4 y2 = *slot; y.x += y2.x; y.y += y2.y; y.z += y2.z; y.w += y2.w; }
                const size_t ro = ((size_t)MP + 16 * mt + (lane & 15)) * DM + 16 * nt + 4 * (lane >> 4);
                v2u* p = (v2u*)(B.H + ro); const v2u h = *p; f32x4 o; o.x = __uint_as_float(h.x << 16) + y.x; o.y = __uint_as_float(h.x & 0xffff0000u) + y.y; o.z = __uint_as_float(h.y << 16) + y.z; o.w = __uint_as_float(h.y & 0xffff0000u) + y.w;
                v2u hw; hw.x = pk_bf16(o.x, o.y); hw.y = pk_bf16(o.z, o.w); *p = hw;
                float ss = (o.x * o.x + o.y * o.y) + (o.z * o.z + o.w * o.w); ss += __shfl_xor(ss, 16); ss += __shfl_xor(ss, 32);
                if ((lane >> 4) == 0) ssq_s[(size_t)(16 * mt + (lane & 15)) * 64 + nt] = ss; }
            pg8::Gemm g{B.R, W2_t, MP, DM, DFF}; pg8::StaticOrder S; S.init(MP, DM, G, bx); EpiResid E{B.H, ssq_p};
            pg8::gemm_phase<EpiResid, pg8::StaticOrder, true, true>(lds, g, S, E);
        }
        if (l + 1 == DEPTH) { SEAM(pb + 7);
            REPS(8) if (PH_ON(8) && IN(pb + 8)) { MKBUFS(); MKW();
                for (int m = gw; m < M; m += 2 * NGW) { const int m2 = m + NGW; const bool has2 = m2 < M;
                    rms_row_bf2(B.H + (size_t)m * DM, B.out + (m < MP ? O_YP + (size_t)m * DM : O_YS + (size_t)(m - MP) * DM),
                                B.H + (size_t)m2 * DM, B.out + (m2 < MP ? O_YP + (size_t)m2 * DM : O_YS + (size_t)(m2 - MP) * DM), has2, ARGP(23), lane); } }
        } else { if (IN(pb + 7) && IN(pb + 9)) GRIDBAR(); }
    }
#undef IN
#undef SEAM
}
extern "C" void kernel_launch(void* const* d_in, const int* in_sizes, int n_in, void* d_out, int out_size, void* d_ws, size_t ws_size, hipStream_t stream) {
    if (n_in != 24 || (size_t)out_size != O_END || ws_size < WS_END) { fprintf(stderr, "kernel_launch: unexpected sizes n_in %d out %d ws %zu\n", n_in, out_size, ws_size); return; }
    static int grid = 0;
    if (grid == 0) {
        int dev = 0, cus = 0, per_cu = 0;
        if (hipGetDevice(&dev) != hipSuccess || hipDeviceGetAttribute(&cus, hipDeviceAttributeMultiprocessorCount, dev) != hipSuccess) { fprintf(stderr, "kernel_launch: device query failed\n"); grid = -1; return; }
        if (hipFuncSetAttribute((const void*)fwd, hipFuncAttributeMaxDynamicSharedMemorySize, LDS_BYTES) != hipSuccess) { fprintf(stderr, "kernel_launch: hipFuncSetAttribute failed\n"); grid = -1; return; }
        if (hipOccupancyMaxActiveBlocksPerMultiprocessor(&per_cu, (const void*)fwd, NTHR, LDS_BYTES) != hipSuccess || per_cu < 1) { fprintf(stderr, "kernel_launch: occupancy query says %d\n", per_cu); }
        (void)hipGetLastError();
        grid = cus;
    }
    if (grid < 0) return;
    unsigned char* ws = (unsigned char*)d_ws;
    Args a{}; for (int i = 0; i < 24; ++i) a.in[i] = (const float*)d_in[i]; a.out = (float*)d_out; a.ws = ws; a.ph_lo = 0; a.ph_hi = NPHASE;
    (void)hipMemsetAsync(ws + WS_CTL, 0, CTL_ZERO_BYTES, stream);
    hipLaunchKernelGGL(fwd, dim3(grid), dim3(NTHR), LDS_BYTES, stream, a);
}
```

```cpp
#include <hip/hip_runtime.h>
#include <cstdio>
#include <cstdint>

constexpr int DM = 1024, NB = 2, T = 8192, DEPTH = 2, SB = 32, ST = 8, PAST = 16384, PAGE = 128, NPAGES = PAST / PAGE;
constexpr int NPOOL = 5120;
constexpr int DCONV = 256, CONVW = 31, CHIST = 30, HD = 64, DATT = 512, NH = 8, NKV = 2, KVD = 128, IH = 8, ID = 64, TOPK = 256;
constexpr int DPOOL = 256, PHIST = 15, DFF = 4096, DIN = 5192;
constexpr int MP = NB * T, MS = SB * ST, M = MP + MS;
constexpr int C_AIN = 0, C_AGATE = 256, C_Q = 512, C_K = 1024, C_V = 1152, C_QI = 1280, C_KI = 1792, C_WI = 1856, C_XC = 1864, C_G = 2120;
constexpr int SCS_LD = 16896;
constexpr float RMS_EPS = 1e-6f, LN_EPS = 1e-5f;
constexpr float WI_SCALE = 0.04419417382415922f;

constexpr size_t O_YP = 0, O_YS = O_YP + (size_t)MP * DM, O_KP = O_YS + (size_t)MS * DM, O_VP = O_KP + (size_t)DEPTH * MP * KVD,
                 O_KIP = O_VP + (size_t)DEPTH * MP * KVD, O_CP = O_KIP + (size_t)DEPTH * MP * ID, O_PP = O_CP + (size_t)DEPTH * NB * CHIST * DCONV,
                 O_KS = O_PP + (size_t)DEPTH * NB * PHIST * DPOOL, O_VS = O_KS + (size_t)DEPTH * MS * KVD, O_KIS = O_VS + (size_t)DEPTH * MS * KVD,
                 O_CS = O_KIS + (size_t)DEPTH * MS * ID, O_PS = O_CS + (size_t)DEPTH * SB * CHIST * DCONV, O_END = O_PS + (size_t)DEPTH * SB * PHIST * DPOOL;

constexpr size_t MiB = 1u << 20;
constexpr size_t WS_ROPE = 64 * MiB;
constexpr size_t WS_X = 80 * MiB;
constexpr size_t WS_H = 160 * MiB;
constexpr size_t WS_U = 200 * MiB;
constexpr size_t WS_XC = 220 * MiB;
constexpr size_t WS_QB = 240 * MiB;
constexpr size_t WS_KV = 260 * MiB;
constexpr size_t WS_QI = 272 * MiB;
constexpr size_t WS_KI = 292 * MiB;
constexpr size_t WS_WI = 296 * MiB;
constexpr size_t WS_G = 300 * MiB;
constexpr size_t WS_CA = 404 * MiB;
constexpr size_t WS_PA = 414 * MiB;
constexpr size_t WS_AT = 424 * MiB;
constexpr size_t WS_MB = 444 * MiB;
constexpr size_t WS_R = 480 * MiB;
constexpr size_t WS_SC = 620 * MiB;
constexpr size_t WS_SCS = 880 * MiB;
constexpr size_t WS_TMP = 900 * MiB;
constexpr size_t WS_TMP2 = 1260 * MiB;
constexpr size_t WS_END = 1500 * MiB;

typedef unsigned short bf16_t;
__device__ __forceinline__ float bf2f(bf16_t v) { return __builtin_bit_cast(float, (unsigned)v << 16); }
__device__ __forceinline__ bf16_t f2bf(float f) { unsigned u = __builtin_bit_cast(unsigned, f); return (bf16_t)((u + 0x7fffu + ((u >> 16) & 1u)) >> 16); }
__device__ __forceinline__ float sigmoidf_(float x) { return 1.f / (1.f + __expf(-x)); }

__device__ __forceinline__ int rope_row(int m) { return m < MP ? (m & (T - 1)) : T + ((m - MP) & (ST - 1)); }

struct Bufs { float* X; bf16_t* H; float* U; float* XC; bf16_t* QB; bf16_t* KV; bf16_t* QI; bf16_t* KI; float* WI; _Float16* G; bf16_t* CA; bf16_t* PA; bf16_t* AT; bf16_t* MB; bf16_t* R;
              _Float16* SC; _Float16* SCS; const float* rc; const float* rs; float* out; };

namespace pg8 {
#define PG8_LAS __attribute__((address_space(3)))
typedef unsigned short bf16_t;
typedef short bf16x8 __attribute__((ext_vector_type(8)));
typedef float f32x4 __attribute__((ext_vector_type(4)));
typedef unsigned u32x4 __attribute__((ext_vector_type(4)));
constexpr int BM = 256, BK = 64, HALF = 128, HTB = HALF * BK * 2  , STAGE_BYTES = 8 * HTB, NXCD = 8, WGM = 8;

__host__ __device__ __forceinline__ int lds_byte(int r, int c) { const int st = (r >> 4) * 2 + (c >> 5), rr = r & 15, cc = c & 31, ob = rr * 64 + cc * 2; return st * 1024 + (ob ^ (((ob >> 9) & 1) << 5)); }
__host__ __device__ __forceinline__ void stage_rc(int b, int& R, int& C) { const int st = b / 1024, sb = b % 1024, swz = sb ^ (((sb >> 9) & 1) << 5); R = (st >> 1) * 16 + swz / 64; C = (st & 1) * 32 + (swz % 64) / 2; }
__host__ __device__ __forceinline__ int perm32(int rho) { const int n = rho >> 4, i = rho & 15; return 8 * (i >> 2) + 4 * n + (i & 3); }

struct Unit { int pm, pn, idx; };
struct Gemm { const bf16_t* A; const bf16_t* Bt; int M, N, K; };

struct StaticOrder {
    int nM, nN, nwg, G, c;
    __host__ __device__ __forceinline__ void init(int M, int N, int G_, int c_) { nM = M / BM; nN = N / BM; nwg = nM * nN; G = G_; c = c_; }
    __host__ __device__ __forceinline__ bool next(int i, Unit& u) const {
        const long L = (long)i * G + c; if (L >= nwg) return false;
        int wgid = (int)L; { const int q = nwg / NXCD, r = nwg % NXCD, xcd = wgid % NXCD, off = wgid / NXCD; wgid = (xcd < r ? xcd * (q + 1) : r * (q + 1) + (xcd - r) * q) + off; }
        const int nig = WGM * nN, gid = wgid / nig, fm = gid * WGM, gsz = (nM - fm) < WGM ? (nM - fm) : WGM;
        u.pm = fm + ((wgid % nig) % gsz); u.pn = (wgid % nig) / gsz; u.idx = i; return true;
    }
    __device__ __forceinline__ void a_ready(const Unit&) const {}
    __device__ __forceinline__ void done(const Unit&) const {}
};
typedef float f32x2 __attribute__((ext_vector_type(2)));
__device__ __forceinline__ unsigned cvt_pk_bf16(float lo, float hi) { unsigned r; asm volatile("v_cvt_pk_bf16_f32 %0, %1, %2" : "=v"(r) : "v"(lo), "v"(hi)); return r; }
template <class Epi, class Sched, bool ALIGN_EPI = false, bool SP2 = false>
__device__ __forceinline__ void gemm_phase(PG8_LAS unsigned char* lds, const Gemm g, const Sched& S, const Epi& E) {
    int tid = threadIdx.x; asm volatile("" : "+v"(tid));
    const int wid = __builtin_amdgcn_readfirstlane(tid >> 6), lane = tid & 63, wr = wid >> 2, wc = wid & 3, fr = lane & 15, fq = lane >> 4;
    const int K = g.K, nt = K / BK;
    unsigned voffA[2], voffB[2];
#pragma unroll
    for (int i = 0; i < 2; ++i) { int R, C; stage_rc(tid * 16 + i * 8192, R, C); const int Rb = Epi::COLMAP2 ? (64 * (R >> 5) + perm32(R & 31)) : (Epi::PERM ? ((R & ~31) + perm32(R & 31)) : R);
        voffA[i] = (unsigned)(R * K + C) * 2u; voffB[i] = (unsigned)(Rb * K + C) * 2u; }
    const size_t kstep = (size_t)(BK * 2);
    const size_t hstep = (size_t)HALF * K * 2;
    const size_t hstepB = Epi::COLMAP2 ? (size_t)32 * K * 2 : hstep;
    const size_t tstep = 2 * hstep;
    const unsigned ldsw = (unsigned)wid * 1024u;
    const int aoff = lds_byte(wr * 64 + fr, fq * 8), boff = lds_byte(wc * 32 + fr, fq * 8);
#define PG8_SA(b, h) (((b) * 2 + (h)) * HTB)
#define PG8_SB(b, h) ((4 + (b) * 2 + (h)) * HTB)
#define PG8_STAGE(bufoff, gbase, voff) do { _Pragma("unroll") for (int _i = 0; _i < 2; ++_i) \
        __builtin_amdgcn_global_load_lds((const unsigned*)((const char*)(gbase) + (voff)[_i]), (PG8_LAS unsigned*)(lds + (bufoff) + ldsw + _i * 8192), 16, 0, 0); } while (0)
#define PG8_LDA(dst, b, h) do { _Pragma("unroll") for (int m = 0; m < 4; ++m) _Pragma("unroll") for (int k = 0; k < 2; ++k) dst[m][k] = *(const PG8_LAS bf16x8*)(lds + PG8_SA(b, h) + aoff + m * 2048 + k * 1024); } while (0)
#define PG8_LDB(dst, b, h) do { _Pragma("unroll") for (int n = 0; n < 2; ++n) _Pragma("unroll") for (int k = 0; k < 2; ++k) dst[n][k] = *(const PG8_LAS bf16x8*)(lds + PG8_SB(b, h) + boff + n * 2048 + k * 1024); } while (0)
#define PG8_MMA(ai, bj, At, Bt) do { __builtin_amdgcn_s_setprio(1); _Pragma("unroll") for (int m = 0; m < 4; ++m) _Pragma("unroll") for (int n = 0; n < 2; ++n) _Pragma("unroll") for (int k = 0; k < 2; ++k) \
        acc[ai][bj][m][n] = __builtin_amdgcn_mfma_f32_16x16x32_bf16(Bt[n][k], At[m][k], acc[ai][bj][m][n], 0, 0, 0); __builtin_amdgcn_s_setprio(0); } while (0)
#define PG8_WAIT_V(n) asm volatile("s_waitcnt vmcnt(" #n ")" ::: "memory")
#define PG8_WAIT_L(n) asm volatile("s_waitcnt lgkmcnt(" #n ")" ::: "memory")
#define PG8_BAR __builtin_amdgcn_s_barrier()
#define PG8_SCHED __builtin_amdgcn_sched_barrier(0)
    Unit cur, nxt; int ui = 0;
    if (!S.next(0, cur)) return;
    f32x4 acc[2][2][4][2];
#pragma unroll
    for (int a = 0; a < 2; ++a)
#pragma unroll
        for (int b = 0; b < 2; ++b)
#pragma unroll
            for (int m = 0; m < 4; ++m)
#pragma unroll
                for (int n = 0; n < 2; ++n) acc[a][b][m][n] = (f32x4){0.f, 0.f, 0.f, 0.f};
    bf16x8 At[4][2], B0[2][2], B1[2][2];
    const char* cA = (const char*)g.A + (size_t)cur.pm * tstep; const char* cB = (const char*)g.Bt + (size_t)cur.pn * tstep;
    S.a_ready(cur);
    if constexpr (SP2) {
        PG8_STAGE(PG8_SB(0, 0), cB, voffB); PG8_STAGE(PG8_SB(0, 1), cB + hstepB, voffB); PG8_STAGE(PG8_SA(0, 0), cA, voffA); PG8_STAGE(PG8_SA(0, 1), cA + hstep, voffA);
        if (wr == 1) PG8_BAR;
        PG8_WAIT_V(2); PG8_BAR;
        PG8_STAGE(PG8_SB(1, 0), cB + kstep, voffB); PG8_STAGE(PG8_SA(1, 0), cA + kstep, voffA); PG8_STAGE(PG8_SB(1, 1), cB + hstepB + kstep, voffB);
        PG8_WAIT_V(6); PG8_BAR;
    } else {
        PG8_STAGE(PG8_SB(0, 0), cB, voffB); PG8_STAGE(PG8_SA(0, 0), cA, voffA); PG8_STAGE(PG8_SB(0, 1), cB + hstepB, voffB); PG8_STAGE(PG8_SA(0, 1), cA + hstep, voffA);
        if (wr == 1) PG8_BAR;
        PG8_WAIT_V(4); PG8_BAR;
        PG8_STAGE(PG8_SB(1, 0), cB + kstep, voffB); PG8_STAGE(PG8_SA(1, 0), cA + kstep, voffA); PG8_STAGE(PG8_SB(1, 1), cB + hstepB + kstep, voffB);
        PG8_WAIT_V(6); PG8_BAR;
    }
    for (;;) {
        const bool has_next = S.next(ui + 1, nxt);
        const char* nA = has_next ? (const char*)g.A + (size_t)nxt.pm * tstep : cA; const char* nB = has_next ? (const char*)g.Bt + (size_t)nxt.pn * tstep : cB;
        for (int t = 0; t < nt; t += 2) {
            if constexpr (Epi::HOOK) { if (t == Epi::HOOK_T0 || t == Epi::HOOK_T1) E.hook(acc, cur, t, wr, wc, fr, fq); }
            const bool last = (t == nt - 2);
            const char* a1 = cA + (size_t)(t + 1) * kstep;
            const char* a2 = last ? nA : cA + (size_t)(t + 2) * kstep; const char* b2 = last ? nB : cB + (size_t)(t + 2) * kstep;
            const char* a3 = a2 + kstep; const char* b3 = b2 + kstep;
            if (last && has_next) S.a_ready(nxt);
            if constexpr (SP2) {
            PG8_LDB(B0, 0, 0); PG8_LDB(B1, 0, 1); PG8_SCHED; PG8_LDA(At, 0, 0); PG8_STAGE(PG8_SA(1, 1), a1 + hstep, voffA);
            PG8_WAIT_V(8); PG8_WAIT_L(0); PG8_BAR; PG8_MMA(0, 0, At, B0); PG8_MMA(0, 1, At, B1); PG8_BAR; PG8_SCHED;
            PG8_LDA(At, 0, 1); PG8_STAGE(PG8_SB(0, 0), b2, voffB); PG8_STAGE(PG8_SB(0, 1), b2 + hstepB, voffB); PG8_STAGE(PG8_SA(0, 0), a2, voffA);
            PG8_WAIT_V(8); PG8_WAIT_L(0); PG8_BAR; PG8_MMA(1, 0, At, B0); PG8_MMA(1, 1, At, B1); PG8_BAR; PG8_SCHED;
            PG8_LDB(B0, 1, 0); PG8_LDB(B1, 1, 1); PG8_SCHED; PG8_LDA(At, 1, 0); PG8_STAGE(PG8_SA(0, 1), a2 + hstep, voffA);
            PG8_WAIT_V(8); PG8_WAIT_L(0); PG8_BAR; PG8_MMA(0, 0, At, B0); PG8_MMA(0, 1, At, B1); PG8_BAR; PG8_SCHED;
            PG8_LDA(At, 1, 1); PG8_STAGE(PG8_SB(1, 0), b3, voffB); PG8_STAGE(PG8_SB(1, 1), b3 + hstepB, voffB); PG8_STAGE(PG8_SA(1, 0), a3, voffA);
            PG8_WAIT_V(8); PG8_WAIT_L(0); PG8_BAR; PG8_MMA(1, 0, At, B0); PG8_MMA(1, 1, At, B1); PG8_BAR; PG8_SCHED;
            } else {
            PG8_LDB(B0, 0, 0); PG8_SCHED; PG8_LDA(At, 0, 0); PG8_STAGE(PG8_SA(1, 1), a1 + hstep, voffA);
            PG8_WAIT_L(8); PG8_BAR; PG8_WAIT_L(0); PG8_MMA(0, 0, At, B0); PG8_BAR; PG8_SCHED;
            PG8_LDB(B1, 0, 1); PG8_STAGE(PG8_SB(0, 0), b2, voffB);
            PG8_BAR; PG8_WAIT_L(0); PG8_MMA(0, 1, At, B1); PG8_BAR;
            PG8_LDA(At, 0, 1); PG8_STAGE(PG8_SA(0, 0), a2, voffA);
            PG8_BAR; PG8_WAIT_L(0); PG8_MMA(1, 0, At, B0); PG8_BAR; PG8_SCHED;
            PG8_STAGE(PG8_SB(0, 1), b2 + hstepB, voffB);
            PG8_WAIT_V(6); PG8_BAR; PG8_MMA(1, 1, At, B1); PG8_BAR;
            PG8_LDB(B0, 1, 0); PG8_SCHED; PG8_LDA(At, 1, 0); PG8_STAGE(PG8_SA(0, 1), a2 + hstep, voffA);
            PG8_WAIT_L(8); PG8_BAR; PG8_WAIT_L(0); PG8_MMA(0, 0, At, B0); PG8_BAR; PG8_SCHED;
            PG8_LDB(B1, 1, 1); PG8_STAGE(PG8_SB(1, 0), b3, voffB);
            PG8_BAR; PG8_WAIT_L(0); PG8_MMA(0, 1, At, B1); PG8_BAR;
            PG8_LDA(At, 1, 1); PG8_STAGE(PG8_SA(1, 0), a3, voffA);
            PG8_BAR; PG8_WAIT_L(0); PG8_MMA(1, 0, At, B0); PG8_BAR; PG8_SCHED;
            PG8_STAGE(PG8_SB(1, 1), b3 + hstepB, voffB);
            PG8_WAIT_V(6); PG8_BAR; PG8_MMA(1, 1, At, B1); PG8_BAR;
            }
        }
        if constexpr (ALIGN_EPI) { if (wr == 0) PG8_BAR; }
        if constexpr (!Epi::AFTER_DRAIN) { E(acc, cur, wr, wc, fr, fq); S.done(cur); }
        if (!has_next) break;
#pragma unroll
        for (int a = 0; a < 2; ++a)
#pragma unroll
            for (int b = 0; b < 2; ++b)
#pragma unroll
                for (int m = 0; m < 4; ++m)
#pragma unroll
                    for (int n = 0; n < 2; ++n) acc[a][b][m][n] = (f32x4){0.f, 0.f, 0.f, 0.f};
        cur = nxt; cA = nA; cB = nB; ++ui;
        if constexpr (ALIGN_EPI) { if (wr == 1) PG8_BAR; }
    }
    PG8_WAIT_V(0);
    if constexpr (!ALIGN_EPI) { if (wr == 0) PG8_BAR; }
    PG8_BAR;
    if constexpr (Epi::AFTER_DRAIN) { E.fused(acc, cur, wr, wc, fr, fq, lds, wid, lane); S.done(cur); }
#undef PG8_SA
#undef PG8_SB
#undef PG8_STAGE
#undef PG8_LDA
#undef PG8_LDB
#undef PG8_MMA
#undef PG8_WAIT_V
#undef PG8_WAIT_L
#undef PG8_BAR
#undef PG8_SCHED
}
}
#define LAS __attribute__((address_space(3)))
#define XB_TMO      128
#define XB_XCNT(j)  (256  + 64 * (j))
#define XB_XSUB(j)  (1280 + 64 * (j))
#define XB_XGEN(j)  (2304 + 64 * (j))
#define XB_TOP      3328
#define XB_TOPGEN   3392
#define XCD_BAR_WORDS 3456
#define XB_SPIN_CAP (1u << 23)

__device__ __forceinline__ unsigned xb_ld(unsigned* p)              { return __hip_atomic_load(p, __ATOMIC_RELAXED, __HIP_MEMORY_SCOPE_AGENT); }
__device__ __forceinline__ unsigned xb_add(unsigned* p, unsigned v) { return __hip_atomic_fetch_add(p, v, __ATOMIC_RELAXED, __HIP_MEMORY_SCOPE_AGENT); }
__device__ __forceinline__ unsigned xb_xcc_id() { return (unsigned)__builtin_amdgcn_s_getreg((3 << 11) | 20) & 0xFu; }
#define XB_SPIN(cond, bar) do { unsigned _sp = 0; while (cond) { __builtin_amdgcn_s_sleep(1); \
    if ((++_sp & 255u) == 0u) { if (xb_ld(&(bar)[XB_TMO])) break; if (_sp > XB_SPIN_CAP) { atomicAdd(&(bar)[XB_TMO], 1u); break; } } } } while (0)

struct XcdBarrier {
    unsigned* bar; unsigned x;
    volatile LAS unsigned* st;
};

__device__ __forceinline__ XcdBarrier xcd_barrier_post(unsigned* bar, volatile LAS unsigned* st) {
    XcdBarrier b; b.bar = bar; b.x = xb_xcc_id(); b.st = st;
    if (threadIdx.x == 0) (void)xb_add(&bar[XB_XCNT(b.x)], 1u);
    return b;
}
__device__ __forceinline__ void xcd_barrier_complete(unsigned* bar, unsigned x, unsigned& nloc, unsigned& nx) {
    const unsigned G = gridDim.x * gridDim.y * gridDim.z;
    unsigned sum, cnt, mine, sp = 0u;
    for (;;) {
        sum = 0u; cnt = 0u; mine = 0u;
#pragma unroll
        for (unsigned j = 0; j < 16; ++j) { const unsigned c = xb_ld(&bar[XB_XCNT(j)]); sum += c; cnt += (c > 0u) ? 1u : 0u; mine = (j == x) ? c : mine; }
        if (sum == G) break;
        __builtin_amdgcn_s_sleep(1);
        if ((++sp & 255u) == 0u) { if (xb_ld(&bar[XB_TMO])) break; if (sp > XB_SPIN_CAP) { atomicAdd(&bar[XB_TMO], 1u); break; } }
    }
    nloc = mine > 0u ? mine : 1u; nx = cnt > 0u ? cnt : 1u;
}

__device__ __attribute__((noinline)) void xcd_barrier(const XcdBarrier b) {
    asm volatile("s_waitcnt vmcnt(0)" ::: "memory");
    __syncthreads();
    if (threadIdx.x == 0) {
        unsigned* bar = b.bar;
        __builtin_amdgcn_s_waitcnt(0);
        unsigned nloc = b.st[0], nx = b.st[1];
        if (nloc == 0u) { xcd_barrier_complete(bar, b.x, nloc, nx); b.st[0] = nloc; b.st[1] = nx; }
        const unsigned old = xb_add(&bar[XB_XSUB(b.x)], 1u);
        const unsigned gen = old / nloc;
        if (old + 1u == (gen + 1u) * nloc) {
            __builtin_amdgcn_fence(__ATOMIC_RELEASE, "agent");
            asm volatile("s_waitcnt vmcnt(0)" ::: "memory");
            const unsigned og = xb_add(&bar[XB_TOP], 1u);
            const unsigned tg = og / nx;
            if (og + 1u == (tg + 1u) * nx) xb_add(&bar[XB_TOPGEN], 1u);
            else XB_SPIN(xb_ld(&bar[XB_TOPGEN]) == tg, bar);
            __builtin_amdgcn_fence(__ATOMIC_ACQUIRE, "agent");
            xb_add(&bar[XB_XGEN(b.x)], 1u);
            asm volatile("s_waitcnt vmcnt(0)" ::: "memory");
        } else {
            XB_SPIN(xb_ld(&bar[XB_XGEN(b.x)]) == gen, bar);
            __builtin_amdgcn_fence(__ATOMIC_ACQUIRE, "agent");
            asm volatile("s_waitcnt vmcnt(0)" ::: "memory");
        }
    }
    __syncthreads();
}
#define GAS __attribute__((address_space(1)))
#ifndef LAS
#define LAS __attribute__((address_space(3)))
#endif
typedef unsigned v4u __attribute__((ext_vector_type(4)));
typedef unsigned v2u __attribute__((ext_vector_type(2)));
typedef float f32x4 __attribute__((ext_vector_type(4)));
typedef short bf16x8 __attribute__((ext_vector_type(8)));
typedef _Float16 f16x2 __attribute__((ext_vector_type(2)));
typedef _Float16 f16x4 __attribute__((ext_vector_type(4)));
typedef _Float16 f16x8 __attribute__((ext_vector_type(8)));
#define LDS_WAIT() asm volatile("s_waitcnt lgkmcnt(0)" ::: "memory")
#define VM_WAIT() asm volatile("s_waitcnt vmcnt(0)" ::: "memory")

constexpr int NWAVES = 8, NTHR = 512;
constexpr int NIN = 5376;
constexpr size_t WS_CTL = 0, CTL_ZERO_BYTES = 64 * 1024;
constexpr size_t WS_W = 2 * MiB, W_LSTRIDE = 31 * MiB;
constexpr size_t WO_IN = 0, WO_C = WO_IN + (size_t)NIN * DM * 2, WO_A = WO_C + (size_t)DM * DCONV * 2, WO_P = WO_A + (size_t)DM * DATT * 2,
                 WO_O = WO_P + (size_t)DM * DPOOL * 2, WO_1 = WO_O + (size_t)DM * DM * 2, WO_2 = WO_1 + (size_t)DFF * DM * 2, WO_END = WO_2 + (size_t)DM * DFF * 2;
static_assert(WO_END <= W_LSTRIDE && WS_W + 2 * W_LSTRIDE <= WS_ROPE, "weight map");
constexpr size_t WS_SSQA = 900 * MiB, WS_SSQB = 902 * MiB, WS_SSQAS = 904 * MiB, WS_SSQBS = 905 * MiB;
constexpr int CW_BAR = 4096;
constexpr int RING_BYTES = 131072, LDSCTL_OFF = RING_BYTES, MISC_OFF = LDSCTL_OFF + 320, LDS_BYTES = 147456;
constexpr int RST_OFF = 132096;

__device__ __forceinline__ float fast_sigmoid(float x) { return __builtin_amdgcn_rcpf(1.f + __expf(-x)); }
typedef __bf16 bf16x2_t __attribute__((ext_vector_type(2)));
typedef float f32x2_t __attribute__((ext_vector_type(2)));
__device__ __forceinline__ unsigned pk_bf16(float lo, float hi) { const f32x2_t v = {lo, hi}; const bf16x2_t b = __builtin_convertvector(v, bf16x2_t); return __builtin_bit_cast(unsigned, b); }
__device__ __forceinline__ unsigned pk_f16(float lo, float hi) { f16x2 v = {(_Float16)lo, (_Float16)hi}; return __builtin_bit_cast(unsigned, v); }
__device__ __forceinline__ float wave_sum(float v) {
#pragma unroll
    for (int o = 1; o < 64; o <<= 1) v += __shfl_xor(v, o);
    return v;
}


__device__ __forceinline__ float row_ms_inv(const unsigned char* ws, size_t off_p, size_t off_s, unsigned row) {
    float s = 0.f;
    if (row < (unsigned)MP) { const f32x4* p = (const f32x4*)(ws + off_p) + (size_t)row * 4;
#pragma unroll
        for (int j = 0; j < 4; ++j) { const f32x4 v = p[j]; s += (v.x + v.y) + (v.z + v.w); } }
    else { const f32x4* p = (const f32x4*)(ws + off_s) + (size_t)(row - MP) * 16;
#pragma unroll
        for (int j = 0; j < 16; ++j) { const f32x4 v = p[j]; s += (v.x + v.y) + (v.z + v.w); } }
    return 1.f / (s * (1.f / DM) + RMS_EPS);
}

__host__ __device__ __forceinline__ int rope_perm(int d) { return 8 * ((d & 31) >> 2) + 4 * (d >> 5) + (d & 3); }
__host__ __device__ __forceinline__ int win_row(int n) {
    if (n < C_AGATE) { return 256 * (n >> 7) + 8 * ((n & 127) >> 2) + (n & 3); }
    if (n < C_Q) { int c = n - C_AGATE; return 256 * (c >> 7) + 8 * ((c & 127) >> 2) + 4 + (c & 3); }
    if (n < C_K) { int i = n - C_Q, hh = i >> 6; return 256 * (2 + (hh >> 2)) + 64 * (hh & 3) + rope_perm(i & 63); }
    if (n < C_V) { int i = n - C_K; return 256 * 4 + 64 * (i >> 6) + rope_perm(i & 63); }
    if (n < C_QI) { return 256 * 4 + 128 + (n - C_V); }
    if (n < C_KI) { int i = n - C_QI, hh = i >> 6; return 256 * (5 + (hh >> 2)) + 64 * (hh & 3) + rope_perm(i & 63); }
    if (n < C_WI) { return 256 * 7 + rope_perm(n - C_KI); }
    if (n < C_XC) { return 256 * 7 + 64 + (n - C_WI); }
    if (n < C_G) { return 256 * 8 + (n - C_XC); }
    return 256 * 9 + (n - C_G);
}

struct EpiRelu2 {
    static constexpr bool PERM = true, AFTER_DRAIN = false, HOOK = false, COLMAP2 = true; static constexpr int HOOK_T0 = -1, HOOK_T1 = -1; bf16_t* O; int ldc; const LAS float* rst;
    __device__ __forceinline__ void operator()(const pg8::f32x4 (&acc)[2][2][4][2], const pg8::Unit& u, int wr, int wc, int fr, int fq) const {
        asm volatile("" : "+v"(fr), "+v"(fq), "+s"(wr), "+s"(wc));
#pragma unroll
        for (int ai = 0; ai < 2; ++ai)
#pragma unroll
            for (int m = 0; m < 4; ++m) { const unsigned row = (unsigned)(u.pm * 256 + ai * 128 + wr * 64 + m * 16 + fr); bf16_t* rowp = O + (size_t)row * ldc + u.pn * 256 + wc * 64 + 8 * fq;
                const float r2 = rst[u.idx * 256 + ai * 128 + wr * 64 + m * 16 + fr];
#pragma unroll
                for (int bj = 0; bj < 2; ++bj) { pg8::f32x4 a = acc[ai][bj][m][0], b = acc[ai][bj][m][1]; float r[8];
#pragma unroll
                    for (int e = 0; e < 4; ++e) { float x = fmaxf(a[e], 0.f), y = fmaxf(b[e], 0.f); r[e] = x * x * r2; r[4 + e] = y * y * r2; }
                    v4u w; w.x = pk_bf16(r[0], r[1]); w.y = pk_bf16(r[2], r[3]); w.z = pk_bf16(r[4], r[5]); w.w = pk_bf16(r[6], r[7]);
                    *(v4u*)(rowp + bj * 32) = w; } }
    }
};
struct EpiResid {
    static constexpr bool PERM = true, AFTER_DRAIN = false, HOOK = false, COLMAP2 = true; static constexpr int HOOK_T0 = -1, HOOK_T1 = -1; bf16_t* H; float* SSQ;
    __device__ __forceinline__ void operator()(const pg8::f32x4 (&acc)[2][2][4][2], const pg8::Unit& u, int wr, int wc, int fr, int fq) const {
        asm volatile("" : "+v"(fr), "+v"(fq), "+s"(wr), "+s"(wc));
#pragma unroll
        for (int ai = 0; ai < 2; ++ai)
#pragma unroll
            for (int m = 0; m < 4; ++m) { const size_t row = (size_t)(u.pm * 256 + ai * 128 + wr * 64 + m * 16 + fr); const int col = u.pn * 256 + wc * 64 + 8 * fq; float ss = 0.f;
#pragma unroll
                for (int bj = 0; bj < 2; ++bj) { v4u* p = (v4u*)(H + row * DM + col + bj * 32); const v4u h = *p; const pg8::f32x4 a = acc[ai][bj][m][0], b = acc[ai][bj][m][1];
                    const float o0 = __uint_as_float(h.x << 16) + a[0], o1 = __uint_as_float(h.x & 0xffff0000u) + a[1], o2 = __uint_as_float(h.y << 16) + a[2], o3 = __uint_as_float(h.y & 0xffff0000u) + a[3];
                    const float o4 = __uint_as_float(h.z << 16) + b[0], o5 = __uint_as_float(h.z & 0xffff0000u) + b[1], o6 = __uint_as_float(h.w << 16) + b[2], o7 = __uint_as_float(h.w & 0xffff0000u) + b[3];
                    ss += ((o0 * o0 + o1 * o1) + (o2 * o2 + o3 * o3)) + ((o4 * o4 + o5 * o5) + (o6 * o6 + o7 * o7));
                    v4u w; w.x = pk_bf16(o0, o1); w.y = pk_bf16(o2, o3); w.z = pk_bf16(o4, o5); w.w = pk_bf16(o6, o7);
                    *p = w; }
                ss += __shfl_xor(ss, 16); ss += __shfl_xor(ss, 32);
                if (fq == 0) SSQ[row * 16 + u.pn * 4 + wc] = ss;
                if (m == 3) asm volatile("" ::: "memory"); }
    }
};
struct EpiGate {
    static constexpr bool PERM = true, AFTER_DRAIN = false, HOOK = true, COLMAP2 = true; static constexpr int HOOK_T0 = 4, HOOK_T1 = 12;
    bf16_t* MBp; const _Float16* G;
    __device__ __forceinline__ void hook(pg8::f32x4 (&acc)[2][2][4][2], const pg8::Unit& u, int t, int wr, int wc, int fr, int fq) const {
        asm volatile("" : "+v"(fr), "+v"(fq), "+s"(wr), "+s"(wc));
        const int br = t == HOOK_T0 ? 0 : 1;
#pragma unroll
        for (int ai = 0; ai < 2; ++ai)
#pragma unroll
            for (int m = 0; m < 4; ++m) { const size_t row = (size_t)(u.pm * 256 + ai * 128 + wr * 64 + m * 16 + fr); const int col = u.pn * 256 + wc * 64 + 8 * fq;
#pragma unroll
                for (int bj = 0; bj < 2; ++bj) { const _Float16* gp = G + row * 3072 + 1024 * br + col + bj * 32;
                    const f16x8 gn = *(const f16x8*)gp, gd = *(const f16x8*)(gp + 1024);
#pragma unroll
                    for (int e = 0; e < 4; ++e) { acc[ai][bj][m][0][e] *= (float)gn[e] * __builtin_amdgcn_rcpf(fmaxf((float)gd[e], 1e-7f)); acc[ai][bj][m][1][e] *= (float)gn[4 + e] * __builtin_amdgcn_rcpf(fmaxf((float)gd[4 + e], 1e-7f)); } }
                if (m == 3) asm volatile("" ::: "memory"); }
    }
    __device__ __forceinline__ void operator()(const pg8::f32x4 (&acc)[2][2][4][2], const pg8::Unit& u, int wr, int wc, int fr, int fq) const {
        asm volatile("" : "+v"(fr), "+v"(fq), "+s"(wr), "+s"(wc));
#pragma unroll
        for (int ai = 0; ai < 2; ++ai)
#pragma unroll
            for (int m = 0; m < 4; ++m) { const size_t row = (size_t)(u.pm * 256 + ai * 128 + wr * 64 + m * 16 + fr); const int col = u.pn * 256 + wc * 64 + 8 * fq;
#pragma unroll
                for (int bj = 0; bj < 2; ++bj) { pg8::f32x4 a = acc[ai][bj][m][0], b = acc[ai][bj][m][1];
                    const f16x8 gv = *(const f16x8*)(G + row * 3072 + 2048 + col + bj * 32); float r[8];
#pragma unroll
                    for (int e = 0; e < 4; ++e) { r[e] = (float)gv[e] * a[e]; r[4 + e] = (float)gv[4 + e] * b[e]; }
                    v4u w; w.x = pk_bf16(r[0], r[1]); w.y = pk_bf16(r[2], r[3]); w.z = pk_bf16(r[4], r[5]); w.w = pk_bf16(r[6], r[7]);
                    *(v4u*)(MBp + row * DM + col + bj * 32) = w; }
                if (m == 3) asm volatile("" ::: "memory"); }
    }
};
struct EpiNull {
    static constexpr bool PERM = true, AFTER_DRAIN = false, HOOK = false, COLMAP2 = false; static constexpr int HOOK_T0 = -1, HOOK_T1 = -1; float* sink;
    __device__ __forceinline__ void operator()(const pg8::f32x4 (&acc)[2][2][4][2], const pg8::Unit& u, int wr, int wc, int fr, int fq) const {
        float s = 0.f;
#pragma unroll
        for (int ai = 0; ai < 2; ++ai)
#pragma unroll
            for (int bj = 0; bj < 2; ++bj)
#pragma unroll
                for (int m = 0; m < 4; ++m) s += acc[ai][bj][m][0][0] + acc[ai][bj][m][1][3];
        if (s == 1234.5678f) sink[0] = s;
    }
};
struct EpiInproj {
    static constexpr bool PERM = true, AFTER_DRAIN = false, HOOK = false, COLMAP2 = false; static constexpr int HOOK_T0 = -1, HOOK_T1 = -1; unsigned char* ws; unsigned char* outb; int layer; const LAS float* rst;
    __device__ __forceinline__ void operator()(const pg8::f32x4 (&acc)[2][2][4][2], const pg8::Unit& u, int wr, int wc, int fr, int fq) const {
        const int pn = u.pn; const bool smp = (u.pm == MP / 256);
        asm volatile("" : "+v"(fr), "+v"(fq), "+s"(wr), "+s"(wc));
#pragma unroll
        for (int ai = 0; ai < 2; ++ai)
#pragma unroll
            for (int m = 0; m < 4; ++m) {
                const unsigned row = (unsigned)(u.pm * 256 + ai * 128 + wr * 64 + m * 16 + fr);
                const unsigned orow = smp ? (unsigned)layer * MS + (row - MP) : (unsigned)layer * MP + row;
                const float rsc = rst[u.idx * 256 + ai * 128 + wr * 64 + m * 16 + fr];
#pragma unroll
                for (int bj = 0; bj < 2; ++bj) {
                    const pg8::f32x4 a = acc[ai][bj][m][0] * rsc, b = acc[ai][bj][m][1] * rsc;
                    const unsigned cb = 128 * bj + 32 * wc + 8 * fq;
                    if (pn < 2) {
                        f32x4 o; o.x = a[0] * fast_sigmoid(b[0]); o.y = a[1] * fast_sigmoid(b[1]); o.z = a[2] * fast_sigmoid(b[2]); o.w = a[3] * fast_sigmoid(b[3]);
                        *(f32x4*)(ws + (unsigned)(WS_U + (row * 256u + 128u * pn + (cb >> 1)) * 4u)) = o;
                    } else if (pn == 8) {
                        const unsigned off = (unsigned)(WS_XC + (row * 256u + cb) * 4u);
                        *(f32x4*)(ws + off) = (f32x4){a[0], a[1], a[2], a[3]}; *(f32x4*)(ws + off + 16u) = (f32x4){b[0], b[1], b[2], b[3]};
                    } else if (pn >= 9) {
                        v4u w; w.x = pk_f16(fast_sigmoid(a[0]), fast_sigmoid(a[1])); w.y = pk_f16(fast_sigmoid(a[2]), fast_sigmoid(a[3]));
                        w.z = pk_f16(fast_sigmoid(b[0]), fast_sigmoid(b[1])); w.w = pk_f16(fast_sigmoid(b[2]), fast_sigmoid(b[3]));
                        __builtin_nontemporal_store(w, (v4u*)(ws + (unsigned)(WS_G + (row * 3072u + 256u * (pn - 9) + cb) * 2u)));
                    } else if (pn == 4 && bj == 1) {
                        const unsigned idx = cb - 128u; v4u w; w.x = pk_bf16(a[0], a[1]); w.y = pk_bf16(a[2], a[3]); w.z = pk_bf16(b[0], b[1]); w.w = pk_bf16(b[2], b[3]);
                        *(v4u*)(ws + (unsigned)(WS_KV + (row * 256u + 128u + idx) * 2u)) = w;
                        const unsigned oo = (unsigned)(((smp ? O_VS : O_VP) + (size_t)orow * KVD + idx) * 4u);
                        *(f32x4*)(outb + oo) = (f32x4){a[0], a[1], a[2], a[3]}; *(f32x4*)(outb + oo + 16u) = (f32x4){b[0], b[1], b[2], b[3]};
                    } else if (pn == 7 && (bj == 1 || wc >= 2)) {
                        if (bj == 0 && wc == 2 && fq == 0) { const unsigned off = (unsigned)(WS_WI + row * 32u);
                            *(f32x4*)(ws + off) = (f32x4){a[0] * WI_SCALE, a[1] * WI_SCALE, a[2] * WI_SCALE, a[3] * WI_SCALE};
                            *(f32x4*)(ws + off + 16u) = (f32x4){b[0] * WI_SCALE, b[1] * WI_SCALE, b[2] * WI_SCALE, b[3] * WI_SCALE}; }
                    } else {
                        const unsigned rr = smp ? T + (row & (ST - 1)) : (row & (T - 1)); const unsigned d0 = (cb & 56u) >> 1, hl = cb >> 6;
                        const unsigned roff = (unsigned)(WS_ROPE + (rr * 32u + d0) * 4u);
                        const f32x4 c4 = *(const f32x4*)(ws + roff), s4 = *(const f32x4*)(ws + roff + (unsigned)((T + ST) * 32 * 4));
                        float o1[4], o2[4];
#pragma unroll
                        for (int e = 0; e < 4; ++e) { o1[e] = a[e] * c4[e] - b[e] * s4[e]; o2[e] = b[e] * c4[e] + a[e] * s4[e]; }
                        unsigned dst; float sc = 1.f; unsigned of = 0u;
                        if (pn < 4) { dst = (unsigned)(WS_QB + (row * 512u + 64u * (4u * (pn - 2) + hl) + d0) * 2u); sc = 0.125f; }
                        else if (pn == 4) { dst = (unsigned)(WS_KV + (row * 256u + 64u * hl + d0) * 2u); of = (unsigned)(((smp ? O_KS : O_KP) + (size_t)orow * KVD + 64u * hl + d0) * 4u); }
                        else if (pn < 7) { dst = (unsigned)(WS_QI + (row * 512u + 64u * (4u * (pn - 5) + hl) + d0) * 2u); }
                        else { dst = (unsigned)(WS_KI + (row * 64u + d0) * 2u); of = (unsigned)(((smp ? O_KIS : O_KIP) + (size_t)orow * ID + d0) * 4u); }
                        v2u w1, w2; w1.x = pk_bf16(o1[0] * sc, o1[1] * sc); w1.y = pk_bf16(o1[2] * sc, o1[3] * sc); w2.x = pk_bf16(o2[0] * sc, o2[1] * sc); w2.y = pk_bf16(o2[2] * sc, o2[3] * sc);
                        *(v2u*)(ws + dst) = w1; *(v2u*)(ws + dst + 64u) = w2;
                        if (pn == 4 || pn == 7) { *(f32x4*)(outb + of) = (f32x4){o1[0], o1[1], o1[2], o1[3]}; *(f32x4*)(outb + of + 128u) = (f32x4){o2[0], o2[1], o2[2], o2[3]}; }
                    }
                }
                if (m == 3) asm volatile("" ::: "memory");
            }
    }
};

__device__ __forceinline__ f32x4 sg_tile(const bf16_t* A, int lda, const bf16_t* Bt, int K, int mt, int nt, int lane, int ldb = 0) {
    const bf16_t* ap = A + (size_t)(16 * mt + (lane & 15)) * lda + 8 * (lane >> 4);
    const bf16_t* bp = Bt + (size_t)(16 * nt + (lane & 15)) * (ldb ? ldb : K) + 8 * (lane >> 4);
    f32x4 acc = {0.f, 0.f, 0.f, 0.f};
    if (K >= 512) {
#pragma unroll 1
        for (int k = 0; k < K; k += 512) { bf16x8 a[16], b[16];
#pragma unroll
            for (int i = 0; i < 16; ++i) { a[i] = *(const bf16x8*)(ap + k + 32 * i); b[i] = *(const bf16x8*)(bp + k + 32 * i); }
#pragma unroll
            for (int i = 0; i < 16; ++i) acc = __builtin_amdgcn_mfma_f32_16x16x32_bf16(b[i], a[i], acc, 0, 0, 0); }
    } else {
#pragma unroll 1
        for (int k = 0; k < K; k += 256) { bf16x8 a[8], b[8];
#pragma unroll
            for (int i = 0; i < 8; ++i) { a[i] = *(const bf16x8*)(ap + k + 32 * i); b[i] = *(const bf16x8*)(bp + k + 32 * i); }
#pragma unroll
            for (int i = 0; i < 8; ++i) acc = __builtin_amdgcn_mfma_f32_16x16x32_bf16(b[i], a[i], acc, 0, 0, 0); }
    }
    return acc;
}

template <bool MAPPED>
__device__ __forceinline__ void transpose_item(const float* W, int K, int N, bf16_t* WT, LAS float* scr, int item, int lane, const float* gain = nullptr, int ldt = 0, int koff = 0) {
    const int nblk = (N + 31) / 32, kb = item / nblk, nb = item % nblk, k0 = 64 * kb, n0 = 32 * nb; const int nn = n0 + (lane & 31);
    (void)nn;
    f32x4 wv[8];
    const int np = n0 + 4 * (lane & 7);
#pragma unroll
    for (int i = 0; i < 8; ++i) { const int kk = 8 * i + (lane >> 3); wv[i] = np < N ? *(const f32x4*)(W + (size_t)(k0 + kk) * N + np) : (f32x4){0.f, 0.f, 0.f, 0.f}; }
#pragma unroll
    for (int i = 0; i < 8; ++i) { const int kk = 8 * i + (lane >> 3); f32x4 v = wv[i]; if (gain) { const float gk = gain[k0 + kk]; v.x *= gk; v.y *= gk; v.z *= gk; v.w *= gk; }
        LAS float* d = scr + kk * 33 + 4 * (lane & 7); d[0] = v.x; d[1] = v.y; d[2] = v.z; d[3] = v.w; }
    LDS_WAIT(); asm volatile("" ::: "memory");
    const int c = lane & 7;
#pragma unroll
    for (int j = 0; j < 4; ++j) { const int nl = (lane >> 3) + 8 * j, n = n0 + nl; const LAS float* s = scr + (8 * c) * 33 + nl;
        v4u o; o.x = pk_bf16(s[0 * 33], s[1 * 33]); o.y = pk_bf16(s[2 * 33], s[3 * 33]); o.z = pk_bf16(s[4 * 33], s[5 * 33]); o.w = pk_bf16(s[6 * 33], s[7 * 33]);
        if (n < N) { const int r = MAPPED ? win_row(n) : n; *(v4u*)(WT + (size_t)r * (ldt ? ldt : K) + koff + k0 + 8 * c) = o; } }
    LDS_WAIT(); asm volatile("" ::: "memory");
}
__device__ __forceinline__ void rms_row(const float* xrow, const float* g, float* xcopy, bf16_t* hout, float* yout, int lane) {
    const f32x4* xr = (const f32x4*)xrow + lane; f32x4 v[4]; float s = 0.f;
#pragma unroll
    for (int j = 0; j < 4; ++j) { v[j] = xr[64 * j]; s += (v[j].x * v[j].x + v[j].y * v[j].y) + (v[j].z * v[j].z + v[j].w * v[j].w); }
    const float r = 1.f / sqrtf(wave_sum(s) * (1.f / DM) + RMS_EPS);
#pragma unroll
    for (int j = 0; j < 4; ++j) { const f32x4 gg = *((const f32x4*)g + lane + 64 * j);
        if (xcopy) *((f32x4*)xcopy + lane + 64 * j) = v[j];
        f32x4 y; y.x = v[j].x * r * gg.x; y.y = v[j].y * r * gg.y; y.z = v[j].z * r * gg.z; y.w = v[j].w * r * gg.w;
        if (hout) { v2u w; w.x = pk_bf16(y.x, y.y); w.y = pk_bf16(y.z, y.w); *((v2u*)hout + lane + 64 * j) = w; }
        if (yout) *((f32x4*)yout + lane + 64 * j) = y; }
}

__device__ __forceinline__ void rms_row_bf(const bf16_t* hrow, const float* g, float* yout, int lane) {
    float v[16]; float s = 0.f;
#pragma unroll
    for (int j = 0; j < 2; ++j) { const v4u h = *((const v4u*)hrow + lane + 64 * j);
        v[8 * j + 0] = __uint_as_float(h.x << 16); v[8 * j + 1] = __uint_as_float(h.x & 0xffff0000u); v[8 * j + 2] = __uint_as_float(h.y << 16); v[8 * j + 3] = __uint_as_float(h.y & 0xffff0000u);
        v[8 * j + 4] = __uint_as_float(h.z << 16); v[8 * j + 5] = __uint_as_float(h.z & 0xffff0000u); v[8 * j + 6] = __uint_as_float(h.w << 16); v[8 * j + 7] = __uint_as_float(h.w & 0xffff0000u); }
#pragma unroll
    for (int e = 0; e < 16; ++e) s += v[e] * v[e];
    const float r = 1.f / sqrtf(wave_sum(s) * (1.f / DM) + RMS_EPS);
#pragma unroll
    for (int j = 0; j < 2; ++j) { const f32x4 g0 = *((const f32x4*)g + 2 * lane + 128 * j), g1 = *((const f32x4*)g + 2 * lane + 128 * j + 1);
        f32x4 y0, y1; y0.x = v[8 * j + 0] * r * g0.x; y0.y = v[8 * j + 1] * r * g0.y; y0.z = v[8 * j + 2] * r * g0.z; y0.w = v[8 * j + 3] * r * g0.w;
        y1.x = v[8 * j + 4] * r * g1.x; y1.y = v[8 * j + 5] * r * g1.y; y1.z = v[8 * j + 6] * r * g1.z; y1.w = v[8 * j + 7] * r * g1.w;
        *((f32x4*)yout + 2 * lane + 128 * j) = y0; *((f32x4*)yout + 2 * lane + 128 * j + 1) = y1; }
}
__device__ __forceinline__ void prep_row(const float* xrow, bf16_t* hout, float* ssq, int nslot, int lane) {
    const f32x4* xr = (const f32x4*)xrow + lane; float s = 0.f;
#pragma unroll
    for (int j = 0; j < 4; ++j) { const f32x4 v = xr[64 * j]; s += (v.x * v.x + v.y * v.y) + (v.z * v.z + v.w * v.w);
        v2u w; w.x = pk_bf16(v.x, v.y); w.y = pk_bf16(v.z, v.w); *((v2u*)hout + lane + 64 * j) = w; }
    s = wave_sum(s);
    if (lane < nslot) ssq[lane] = lane == 0 ? s : 0.f;
}

__device__ __forceinline__ void rms_row_bf2(const bf16_t* ha, float* ya, const bf16_t* hb, float* yb, bool has_b, const float* g, int lane) {
    v4u ra[2], rb[2];
#pragma unroll
    for (int j = 0; j < 2; ++j) ra[j] = *((const v4u*)ha + lane + 64 * j);
#pragma unroll
    for (int j = 0; j < 2; ++j) rb[j] = has_b ? *((const v4u*)hb + lane + 64 * j) : (v4u){0u, 0u, 0u, 0u};
    f32x4 gg[4];
#pragma unroll
    for (int j = 0; j < 2; ++j) { gg[2 * j] = *((const f32x4*)g + 2 * lane + 128 * j); gg[2 * j + 1] = *((const f32x4*)g + 2 * lane + 128 * j + 1); }
#pragma unroll
    for (int rw = 0; rw < 2; ++rw) { if (rw == 1 && !has_b) break;
        float v[16]; float s = 0.f;
#pragma unroll
        for (int j = 0; j < 2; ++j) { const v4u h = rw ? rb[j] : ra[j];
            v[8 * j + 0] = __uint_as_float(h.x << 16); v[8 * j + 1] = __uint_as_float(h.x & 0xffff0000u); v[8 * j + 2] = __uint_as_float(h.y << 16); v[8 * j + 3] = __uint_as_float(h.y & 0xffff0000u);
            v[8 * j + 4] = __uint_as_float(h.z << 16); v[8 * j + 5] = __uint_as_float(h.z & 0xffff0000u); v[8 * j + 6] = __uint_as_float(h.w << 16); v[8 * j + 7] = __uint_as_float(h.w & 0xffff0000u); }
#pragma unroll
        for (int e = 0; e < 16; ++e) s += v[e] * v[e];
        const float r = 1.f / sqrtf(wave_sum(s) * (1.f / DM) + RMS_EPS);
        float* yout = rw ? yb : ya;
#pragma unroll
        for (int j = 0; j < 2; ++j) { const f32x4 g0 = gg[2 * j], g1 = gg[2 * j + 1];
            f32x4 y0, y1; y0.x = v[8 * j + 0] * r * g0.x; y0.y = v[8 * j + 1] * r * g0.y; y0.z = v[8 * j + 2] * r * g0.z; y0.w = v[8 * j + 3] * r * g0.w;
            y1.x = v[8 * j + 4] * r * g1.x; y1.y = v[8 * j + 5] * r * g1.y; y1.z = v[8 * j + 6] * r * g1.z; y1.w = v[8 * j + 7] * r * g1.w;
            *((f32x4*)yout + 2 * lane + 128 * j) = y0; *((f32x4*)yout + 2 * lane + 128 * j + 1) = y1; } }
}
__device__ __forceinline__ void prep_row2(const float* xa, bf16_t* ha, float* sa, int na, const float* xb, bf16_t* hb, float* sb, int nb, bool has_b, int lane) {
    f32x4 va[4], vb[4];
#pragma unroll
    for (int j = 0; j < 4; ++j) va[j] = *((const f32x4*)xa + lane + 64 * j);
#pragma unroll
    for (int j = 0; j < 4; ++j) vb[j] = has_b ? *((const f32x4*)xb + lane + 64 * j) : (f32x4){0.f, 0.f, 0.f, 0.f};
    float s = 0.f, t = 0.f;
#pragma unroll
    for (int j = 0; j < 4; ++j) { const f32x4 v = va[j]; s += (v.x * v.x + v.y * v.y) + (v.z * v.z + v.w * v.w);
        v2u w; w.x = pk_bf16(v.x, v.y); w.y = pk_bf16(v.z, v.w); *((v2u*)ha + lane + 64 * j) = w; }
    s = wave_sum(s);
    if (lane < na) sa[lane] = lane == 0 ? s : 0.f;
    if (has_b) {
#pragma unroll
        for (int j = 0; j < 4; ++j) { const f32x4 v = vb[j]; t += (v.x * v.x + v.y * v.y) + (v.z * v.z + v.w * v.w);
            v2u w; w.x = pk_bf16(v.x, v.y); w.y = pk_bf16(v.z, v.w); *((v2u*)hb + lane + 64 * j) = w; }
        t = wave_sum(t);
        if (lane < nb) sb[lane] = lane == 0 ? t : 0.f; }
}

struct Args { const float* in[24]; float* out; unsigned char* ws; int ph_lo, ph_hi; };
typedef float f32x16 __attribute__((ext_vector_type(16)));
struct P2Args { const float* state_conv; const float* state_pool; const float* conv_w; const float* conv_b; const float* ln_g; const float* ln_b; const float* cache_kidx; const int* page_table; };

__device__ __forceinline__ void conv_task(const Bufs& B, const P2Args& P, int layer, int task, int lane, const LAS float* wl  ) {
    const bool smp = task >= MP / 8; const int b = smp ? task - MP / 8 : task / (T / 8); const int t0 = smp ? 0 : (task % (T / 8)) * 8; const int row0 = smp ? MP + b * ST : b * T;
    const f32x4 bias = *((const f32x4*)(P.conv_b + layer * DCONV) + lane);
    f32x4 acc[8];
#pragma unroll
    for (int i = 0; i < 8; ++i) acc[i] = bias;
#define CONV_LOADROW(dst, r_) do { const int r__ = (r_), tau__ = t0 - 30 + r__; (dst) = (f32x4){0.f, 0.f, 0.f, 0.f}; \
        if (r__ < 38) { if (tau__ >= 0) (dst) = *((const f32x4*)(B.U + (size_t)(row0 + tau__) * 256) + lane); \
            else if (smp) (dst) = *((const f32x4*)(P.state_conv + (((size_t)layer * SB + b) * CHIST + (30 + tau__)) * DCONV) + lane); } } while (0)
    f32x4 xa[4], xb[4], xd[4];
#pragma unroll
    for (int rr = 0; rr < 4; ++rr) CONV_LOADROW(xa[rr], rr);
#pragma unroll
    for (int rr = 0; rr < 4; ++rr) CONV_LOADROW(xb[rr], 4 + rr);
#define CONV_GROUP(XC, XL, r0_) do { const int r0 = (r0_); asm volatile("" ::: "memory");       \
        _Pragma("unroll") for (int rr = 0; rr < 4; ++rr) CONV_LOADROW(XL[rr], r0 + 8 + rr); \
        asm volatile("" ::: "memory"); \
        const LAS f32x4* wb = (const LAS f32x4*)(wl + (r0 + 8) * DCONV) + lane;       \
        _Pragma("unroll") for (int rr = 0; rr < 4; ++rr) { \
            _Pragma("unroll") for (int i = 0; i < 8; ++i) { const f32x4 w = wb[(rr - i) * (DCONV / 4)]; \
                acc[i].x += w.x * XC[rr].x; acc[i].y += w.y * XC[rr].y; acc[i].z += w.z * XC[rr].z; acc[i].w += w.w * XC[rr].w; } } } while (0)
#pragma nounroll
    for (int rg = 0; rg < 36; rg += 12) {
        CONV_GROUP(xa, xd, rg);
        CONV_GROUP(xb, xa, rg + 4);
        CONV_GROUP(xd, xb, rg + 8);
    }
    CONV_GROUP(xa, xd, 36);
#undef CONV_GROUP
#undef CONV_LOADROW
    const f32x4 lg = *((const f32x4*)(P.ln_g + layer * DCONV) + lane), lb = *((const f32x4*)(P.ln_b + layer * DCONV) + lane);
#pragma unroll
    for (int i = 0; i < 8; ++i) {
        const float mu = wave_sum((acc[i].x + acc[i].y) + (acc[i].z + acc[i].w)) * (1.f / 256);
        const f32x4 d = {acc[i].x - mu, acc[i].y - mu, acc[i].z - mu, acc[i].w - mu};
        const float var = wave_sum((d.x * d.x + d.y * d.y) + (d.z * d.z + d.w * d.w)) * (1.f / 256);
        const float rs = 1.f / sqrtf(var + LN_EPS);
        float y0 = d.x * rs * lg.x + lb.x, y1 = d.y * rs * lg.y + lb.y, y2 = d.z * rs * lg.z + lb.z, y3 = d.w * rs * lg.w + lb.w;
        y0 *= fast_sigmoid(y0); y1 *= fast_sigmoid(y1); y2 *= fast_sigmoid(y2); y3 *= fast_sigmoid(y3);
        v2u w; w.x = pk_bf16(y0, y1); w.y = pk_bf16(y2, y3);
        *((v2u*)(B.CA + (size_t)(row0 + t0 + i) * DM) + lane) = w; }
}
__device__ __forceinline__ void pool_task(const Bufs& B, const P2Args& P, int layer, int task, int lane) {
    const bool smp = task >= MP / 8; const int b = smp ? task - MP / 8 : task / (T / 8); const int t0 = smp ? 0 : (task % (T / 8)) * 8; const int row0 = smp ? MP + b * ST : b * T;
    f32x4 cs[24];
    f32x4 xr[8];
    cs[0] = (f32x4){0.f, 0.f, 0.f, 0.f};
#pragma unroll
    for (int r = 0; r < 23; ++r) { const int tau = t0 - 15 + r; f32x4 v;
        if (tau >= 0) v = *((const f32x4*)(B.XC + (size_t)(row0 + tau) * 256) + lane);
        else if (smp) v = *((const f32x4*)(P.state_pool + (((size_t)layer * SB + b) * PHIST + (15 + tau)) * DPOOL) + lane);
        else v = (f32x4){0.f, 0.f, 0.f, 0.f};
        cs[r + 1] = (f32x4){cs[r].x + v.x, cs[r].y + v.y, cs[r].z + v.z, cs[r].w + v.w}; if (r >= 15) xr[r - 15] = v; }
    const int g = lane >> 4, w = 2 << g;
#pragma unroll
    for (int i = 0; i < 8; ++i) {
        const f32x4 s2 = cs[14 + i], s4 = cs[12 + i], s8 = cs[8 + i], s16 = cs[i];
        const f32x4 st = g == 0 ? s2 : (g == 1 ? s4 : (g == 2 ? s8 : s16)); const f32x4 e = cs[16 + i];
        const int t = t0 + i; const float cnt = smp ? (float)w : (float)((t + 1) < w ? (t + 1) : w); const float ic = 1.f / cnt;
        v2u o; o.x = pk_bf16((e.x - st.x) * ic - xr[i].x, (e.y - st.y) * ic - xr[i].y); o.y = pk_bf16((e.z - st.z) * ic - xr[i].z, (e.w - st.w) * ic - xr[i].w);
        *((v2u*)(B.CA + (size_t)(row0 + t) * DM + (DCONV + DATT)) + lane) = o; }
}
__device__ __forceinline__ void states_task(const Bufs& B, const P2Args& P, int layer, int i, int lane) {
    const float* src; float* dst;
    if (i < NB * 30) { const int b = i / 30, r = i % 30; dst = B.out + O_CP + (((size_t)layer * NB + b) * CHIST + r) * DCONV; src = B.U + (size_t)(b * T + T - 30 + r) * 256; }
    else if ((i -= NB * 30) < NB * 15) { const int b = i / 15, r = i % 15; dst = B.out + O_PP + (((size_t)layer * NB + b) * PHIST + r) * DPOOL; src = B.XC + (size_t)(b * T + T - 15 + r) * 256; }
    else if ((i -= NB * 15) < SB * 30) { const int b = i / 30, r = i % 30; dst = B.out + O_CS + (((size_t)layer * SB + b) * CHIST + r) * DCONV;
        src = (ST + r < CHIST) ? P.state_conv + (((size_t)layer * SB + b) * CHIST + ST + r) * DCONV : B.U + (size_t)(MP + b * ST + (ST + r - CHIST)) * 256; }
    else { i -= SB * 30; const int b = i / 15, r = i % 15; dst = B.out + O_PS + (((size_t)layer * SB + b) * PHIST + r) * DPOOL;
        src = (ST + r < PHIST) ? P.state_pool + (((size_t)layer * SB + b) * PHIST + ST + r) * DPOOL : B.XC + (size_t)(MP + b * ST + (ST + r - PHIST)) * 256; }
    *((f32x4*)dst + lane) = *((const f32x4*)src + lane);
}

__device__ __forceinline__ void rho_map(int rho, int& qq, int& head) { const int hf = (rho >> 2) & 1, i = (rho & 3) + 4 * (rho >> 3); qq = 2 * hf + (i >> 3); head = i & 7; }
typedef float f32x2 __attribute__((ext_vector_type(2)));
__device__ __forceinline__ void head_reduce(const f32x16& acc, const float (&wv)[16], float& s0, float& s1) {
    f32x2 a = {0.f, 0.f}, c = {0.f, 0.f};
#pragma unroll
    for (int h = 0; h < 8; h += 2) {
        const float f0 = acc[h], f1 = acc[h + 1], f2 = acc[8 + h], f3 = acc[9 + h];
        const int i0 = __float_as_int(f0), i1 = __float_as_int(f1), i2 = __float_as_int(f2), i3 = __float_as_int(f3);
        const f32x2 x01 = {__int_as_float(i0 > 0 ? i0 : 0), __int_as_float(i1 > 0 ? i1 : 0)}, x23 = {__int_as_float(i2 > 0 ? i2 : 0), __int_as_float(i3 > 0 ? i3 : 0)};
        const f32x2 w01 = {wv[h], wv[h + 1]}, w23 = {wv[8 + h], wv[9 + h]};
        a = __builtin_elementwise_fma(w01, x01, a); c = __builtin_elementwise_fma(w23, x23, c); }
    s0 = a.x + a.y; s1 = c.x + c.y;
}
typedef short s16x2 __attribute__((ext_vector_type(2)));
__device__ __forceinline__ void wfrag_build(const float* wrow  , int lane, bf16x8 (&wf)[2]) {
    const int r = lane & 31, hh = lane >> 5, ssel = r - 2 * hh; v4u pk = {0u, 0u, 0u, 0u};
    if (r < 4) { const f32x4 w0 = *(const f32x4*)(wrow + r * 8), w1 = *(const f32x4*)(wrow + r * 8 + 4); pk.x = pk_bf16(w0.x, w0.y); pk.y = pk_bf16(w0.z, w0.w); pk.z = pk_bf16(w1.x, w1.y); pk.w = pk_bf16(w1.z, w1.w); }
    const v4u z = {0u, 0u, 0u, 0u};
    wf[0] = __builtin_bit_cast(bf16x8, (r < 4 && ssel == 0) ? pk : z); wf[1] = __builtin_bit_cast(bf16x8, (r < 4 && ssel == 1) ? pk : z);
}
__device__ __forceinline__ f32x16 head_reduce_mfma(const f32x16& acc, const bf16x8 (&wf)[2]) {
    f32x16 y;
#pragma unroll
    for (int i = 0; i < 16; ++i) y[i] = 0.f;
#pragma unroll
    for (int st = 0; st < 2; ++st) { unsigned d[4];
#pragma unroll
        for (int p = 0; p < 4; ++p) { const float f0 = acc[8 * st + 2 * p], f1 = acc[8 * st + 2 * p + 1]; const unsigned w = pk_bf16(f0, f1);
            const s16x2 v = {(short)(w & 0xFFFFu), (short)(w >> 16)}; const s16x2 m = __builtin_elementwise_max(v, (s16x2){0, 0});
            d[p] = (unsigned)(unsigned short)m.x | ((unsigned)(unsigned short)m.y << 16); }
        const v4u pk = {d[0], d[1], d[2], d[3]};
        y = __builtin_amdgcn_mfma_f32_32x32x16_bf16(wf[st], __builtin_bit_cast(bf16x8, pk), y, 0, 0, 0); }
    return y;
}
constexpr int KI_LD = 144;
constexpr int KI_BUF = 128 * KI_LD;

__device__ __forceinline__ void scores_prompt_unit(const Bufs& B, LAS unsigned char* lds, int b, int qb, int tid, int abl = 0) {
    const int lane = tid & 63, wave = __builtin_amdgcn_readfirstlane(tid >> 6), hf = lane >> 5, qg = wave & 3, kh = wave >> 2;
    const int t0 = qb * 32; const size_t mrow = (size_t)b * T + t0 + 8 * qg;
    int qq, head; rho_map(lane & 31, qq, head);
    bf16x8 af[2][4]; bf16x8 wf[2][2];
#pragma unroll
    for (int a = 0; a < 2; ++a) {
#pragma unroll
        for (int ks = 0; ks < 4; ++ks) af[a][ks] = *(const bf16x8*)(B.QI + (mrow + 4 * a + qq) * 512 + head * 64 + 16 * ks + 8 * hf);
        wfrag_build(B.WI + (mrow + 4 * a) * 8, lane, wf[a]); }
    const int nchunk = (t0 + 32 + 127) >> 7;
    const bf16_t* kbase = B.KI + (size_t)b * T * 64;
    const int p0 = tid, p1 = tid + 512; const unsigned so0 = (unsigned)((p0 >> 3) * KI_LD + (p0 & 7) * 16), so1 = (unsigned)((p1 >> 3) * KI_LD + (p1 & 7) * 16);
    const bf16_t* kp0 = kbase + (size_t)(p0 >> 3) * 64 + (p0 & 7) * 8; const bf16_t* kp1 = kbase + (size_t)(p1 >> 3) * 64 + (p1 & 7) * 8;
    v4u rA0 = *(const v4u*)kp0, rA1 = *(const v4u*)kp1, rB0 = rA0, rB1 = rA1;
    if (nchunk > 1) { rB0 = *(const v4u*)(kp0 + 128 * 64); rB1 = *(const v4u*)(kp1 + 128 * 64); }
    *(LAS v4u*)(lds + so0) = rA0; *(LAS v4u*)(lds + so1) = rA1;
    if (nchunk > 1) { *(LAS v4u*)(lds + KI_BUF + so0) = rB0; *(LAS v4u*)(lds + KI_BUF + so1) = rB1; }
    if (nchunk > 2) { rA0 = *(const v4u*)(kp0 + 2 * 128 * 64); rA1 = *(const v4u*)(kp1 + 2 * 128 * 64); }
    __syncthreads();
    constexpr int ST_OFF = 98304;
    _Float16* const scblk = B.SC + ((size_t)b * T + t0 + (tid >> 4)) * T + 8 * (tid & 15);
    const unsigned fro = (unsigned)((64 * kh + (lane & 31)) * KI_LD + 16 * hf);
    bf16x8 bqA[2][4], bqB[2][4];
#pragma unroll
    for (int kbl = 0; kbl < 2; ++kbl)
#pragma unroll
        for (int ks = 0; ks < 4; ++ks) bqA[kbl][ks] = *(const LAS bf16x8*)(lds + fro + (32 * kbl) * KI_LD + 32 * ks);
#define SCORE_MM(dst, a_, kbl_, BQ) do { _Pragma("unroll") for (int i = 0; i < 16; ++i) (dst)[i] = 0.f; \
            _Pragma("unroll") for (int ks = 0; ks < 4; ++ks) (dst) = __builtin_amdgcn_mfma_f32_32x32x16_bf16(af[a_][ks], BQ[kbl_][ks], (dst), 0, 0, 0); } while (0)
#define SCORE_HR(acc_, a_, j_) do { const f32x16 y = head_reduce_mfma(acc_, wf[a_]); LAS _Float16* sp = stile + (4 * ((j_) & 1)) * 128 + 32 * ((j_) >> 1); \
            sp[0] = (_Float16)y[0]; sp[128] = (_Float16)y[1]; sp[256] = (_Float16)y[2]; sp[384] = (_Float16)y[3]; } while (0)
#define SCORE_BODY(c_, BQC, BQN, RW0, RW1, RL0, RL1) { const int c = (c_); \
        if (c + 3 < nchunk && !(abl & 2)) { RL0 = *(const v4u*)(kp0 + (size_t)(c + 3) * 128 * 64); RL1 = *(const v4u*)(kp1 + (size_t)(c + 3) * 128 * 64); } \
        if (c > 0) { const v4u sv = *(const LAS v4u*)(lds + ST_OFF + ((c - 1) & 1) * 8192 + (tid >> 4) * 256 + (tid & 15) * 16); if (!(abl & 1)) __builtin_nontemporal_store(sv, (v4u*)(scblk + (size_t)(c - 1) * 128)); else if (sv.x == 0x12345u) *(v4u*)(scblk) = sv; } \
        if (c == nchunk) break; \
        LAS unsigned char* nxt = lds + ((c + 1) & 1) * KI_BUF; \
        if (c + 1 < nchunk) { _Pragma("unroll") for (int kbl = 0; kbl < 2; ++kbl) _Pragma("unroll") for (int ks = 0; ks < 4; ++ks) BQN[kbl][ks] = *(const LAS bf16x8*)(nxt + fro + (32 * kbl) * KI_LD + 32 * ks); } \
        f32x16 a0, a1; \
        LAS _Float16* stile = (LAS _Float16*)(lds + ST_OFF + (hf ? 2 : (c & 1)) * 8192) + (8 * qg) * 128 + 64 * kh + (lane & 31);        \
        { \
        SCORE_MM(a0, 0, 0, BQC); \
        SCORE_MM(a1, 1, 0, BQC); SCORE_HR(a0, 0, 0); \
        SCORE_MM(a0, 0, 1, BQC); SCORE_HR(a1, 1, 1); \
        SCORE_MM(a1, 1, 1, BQC); SCORE_HR(a0, 0, 2); \
        SCORE_HR(a1, 1, 3); } \
        if (c + 2 < nchunk) { LAS unsigned char* wb = lds + (c & 1) * KI_BUF; *(LAS v4u*)(wb + so0) = RW0; *(LAS v4u*)(wb + so1) = RW1; }        \
        __syncthreads(); }
    for (int c2 = 0; ; c2 += 2) { SCORE_BODY(c2, bqA, bqB, rA0, rA1, rB0, rB1) SCORE_BODY(c2 + 1, bqB, bqA, rB0, rB1, rA0, rA1) }
#undef SCORE_BODY
#undef SCORE_HR
#undef SCORE_MM
}
__device__ __forceinline__ void scores_sample_task(const Bufs& B, const P2Args& P, int layer, int task, int lane, LAS unsigned char* swl  ) {
    const int hf = lane >> 5; const bool newk = task >= SB * NPAGES; const int b = newk ? task - SB * NPAGES : task / NPAGES, pg = newk ? 0 : task % NPAGES;
    const size_t mrow = (size_t)MP + b * ST;
    int qq, head; rho_map(lane & 31, qq, head);
    bf16x8 af[2][4]; bf16x8 wf[2][2];
#pragma unroll
    for (int a = 0; a < 2; ++a) {
#pragma unroll
        for (int ks = 0; ks < 4; ++ks) af[a][ks] = *(const bf16x8*)(B.QI + (mrow + 4 * a + qq) * 512 + head * 64 + 16 * ks + 8 * hf);
        wfrag_build(B.WI + (mrow + 4 * a) * 8, lane, wf[a]); }
    _Float16* sc0 = B.SCS + (size_t)(b * ST) * SCS_LD + (lane & 31);
    if (!newk) {
        const float* pgp = P.cache_kidx + (((size_t)layer * NPOOL + P.page_table[b * NPAGES + pg]) * PAGE + (lane >> 4)) * ID + 4 * (lane & 15);
        f32x4 u[4][8];
#pragma unroll
        for (int kb = 0; kb < 4; ++kb)
#pragma unroll
            for (int q = 0; q < 8; ++q) u[kb][q] = *(const f32x4*)(pgp + (size_t)(32 * kb + 4 * q) * ID);
#pragma unroll
        for (int kb = 0; kb < 4; ++kb) {
            asm volatile("" ::: "memory");
#pragma unroll
            for (int q = 0; q < 8; ++q) { v2u p; p.x = pk_bf16(u[kb][q].x, u[kb][q].y); p.y = pk_bf16(u[kb][q].z, u[kb][q].w); *(LAS v2u*)(swl + (4 * q + (lane >> 4)) * KI_LD + (lane & 15) * 8) = p; }
            asm volatile("" ::: "memory");
            bf16x8 bfg[4];
#pragma unroll
            for (int ks = 0; ks < 4; ++ks) bfg[ks] = *(const LAS bf16x8*)(swl + (lane & 31) * KI_LD + 32 * ks + 16 * hf);
            asm volatile("" ::: "memory");
#pragma unroll
            for (int a = 0; a < 2; ++a) { f32x16 acc;
#pragma unroll
                for (int i = 0; i < 16; ++i) acc[i] = 0.f;
#pragma unroll
                for (int ks = 0; ks < 4; ++ks) acc = __builtin_amdgcn_mfma_f32_32x32x16_bf16(af[a][ks], bfg[ks], acc, 0, 0, 0);
                const f32x16 y = head_reduce_mfma(acc, wf[a]);
                if (hf == 0) { _Float16* sp = sc0 + (size_t)(4 * a) * SCS_LD + pg * PAGE + 32 * kb; sp[0] = (_Float16)y[0]; sp[SCS_LD] = (_Float16)y[1]; sp[2 * SCS_LD] = (_Float16)y[2]; sp[3 * SCS_LD] = (_Float16)y[3]; } }
        }
    } else {
        const int kr = (lane & 31) < ST ? (lane & 31) : 0;
        bf16x8 bfg[4];
#pragma unroll
        for (int ks = 0; ks < 4; ++ks) bfg[ks] = *(const bf16x8*)(B.KI + (mrow + kr) * 64 + 16 * ks + 8 * hf);
#pragma unroll
        for (int a = 0; a < 2; ++a) { f32x16 acc;
#pragma unroll
            for (int i = 0; i < 16; ++i) acc[i] = 0.f;
#pragma unroll
            for (int ks = 0; ks < 4; ++ks) acc = __builtin_amdgcn_mfma_f32_32x32x16_bf16(af[a][ks], bfg[ks], acc, 0, 0, 0);
            const f32x16 y = head_reduce_mfma(acc, wf[a]);
            if (lane < ST) { _Float16* sp = sc0 + (size_t)(4 * a) * SCS_LD + PAST; sp[0] = (_Float16)y[0]; sp[SCS_LD] = (_Float16)y[1]; sp[2 * SCS_LD] = (_Float16)y[2]; sp[3 * SCS_LD] = (_Float16)y[3]; } }
    }
}

struct P3Args { const float* cache_k; const float* cache_v; const int* page_table; };
typedef short s16x4 __attribute__((ext_vector_type(4)));
constexpr int WL_BYTES = 16384, WL_LIST = 4096, WL_VB = 5120, VB_LD = 160, NHC = 4;
__device__ __forceinline__ unsigned f16_sortkey(unsigned h) { return (h & 0x8000u) ? (~h & 0xFFFFu) : (h | 0x8000u); }
__device__ __forceinline__ void find_bin(const LAS unsigned* hist, int ncopy, int K, int lane, int& bin, int& above) {
    unsigned c0 = 0, c1 = 0, c2 = 0, c3 = 0;
    for (int cp = 0; cp < ncopy; ++cp) { const v4u h = *(const LAS v4u*)(hist + cp * 256 + 4 * lane); c0 += h.x; c1 += h.y; c2 += h.z; c3 += h.w; }
    const int tot = (int)(c0 + c1 + c2 + c3); int v = tot;
#pragma unroll
    for (int o = 1; o < 64; o <<= 1) { const int tmp = __shfl_down(v, o); if (lane + o < 64) v += tmp; }
    const int S = v - tot;
    const bool mine = (S < K) && (v >= K);
    const unsigned long long mk = __ballot(mine); const int L = mk ? (int)__builtin_ctzll(mk) : 0;
    int run = S, lb = 4 * lane, la = S; bool found = false;
    if (run + (int)c3 >= K) { lb = 4 * lane + 3; la = run; found = true; } else run += (int)c3;
    if (!found) { if (run + (int)c2 >= K) { lb = 4 * lane + 2; la = run; found = true; } else run += (int)c2; }
    if (!found) { if (run + (int)c1 >= K) { lb = 4 * lane + 1; la = run; found = true; } else run += (int)c1; }
    if (!found) { lb = 4 * lane; la = run; }
    bin = __shfl(lb, L); above = __shfl(la, L);
}
__device__ __forceinline__ unsigned sortkey2(unsigned x) { const unsigned sgn = (x >> 15) & 0x00010001u; return x ^ ((sgn * 0x7FFFu) | 0x80008000u); }
template <bool SMP, int MODE = 0>
__device__ __forceinline__ void select_attend_task(const Bufs& B, const P3Args& P, int layer, int m_in, int lane_in, LAS unsigned char* wl) {
    int m = m_in, lane = lane_in; asm volatile("" : "+s"(m)); asm volatile("" : "+v"(lane));
    constexpr int CIT = SMP ? 11 : 16, NCH = SMP ? 3 : 1;
    const int b = SMP ? (m - MP) / ST : m / T, t = SMP ? (m - MP) % ST : m % T; const int n = SMP ? PAST + t + 1 : t + 1;
    const unsigned char* scb = (const unsigned char*)(SMP ? B.SCS + (size_t)(m - MP) * SCS_LD : B.SC + (size_t)m * T);
    LAS unsigned* hist = (LAS unsigned*)wl; LAS unsigned* list = (LAS unsigned*)(wl + WL_LIST);
    const int cnt = n < TOPK ? n : TOPK;
    asm volatile("" ::: "memory");
    if (MODE == 2 || MODE == 3) {
#pragma unroll
        for (int q = 0; q < 4; ++q) list[lane + 64 * q] = (unsigned)((lane + 64 * q) * 29 % (n > 1 ? n : 1));
    } else if (n <= TOPK) {
#pragma unroll
        for (int q = 0; q < 4; ++q) { const int i = lane + 64 * q; list[i] = i < n ? (unsigned)i : 0u; }
    } else {
        const int nIt = (n + 511) >> 9;
        v4u kk[CIT];
#define LOADCHUNK(ch_) do { _Pragma("unroll") for (int it = 0; it < CIT; ++it) { kk[it] = (v4u){0u, 0u, 0u, 0u}; if ((ch_) * CIT + it < nIt) kk[it] = __builtin_nontemporal_load((const v4u*)(scb + ((ch_) * CIT + it) * 1024 + (unsigned)(lane * 16))); } \
        _Pragma("unroll") for (int it = 0; it < CIT; ++it) { const int e0 = ((ch_) * CIT + it) * 512 + lane * 8; unsigned w[4] = {kk[it].x, kk[it].y, kk[it].z, kk[it].w}; \
            _Pragma("unroll") for (int d = 0; d < 4; ++d) { unsigned k2 = sortkey2(w[d]); if (e0 + 2 * d >= n) k2 = 0u; else if (e0 + 2 * d + 1 >= n) k2 &= 0xFFFFu; w[d] = k2; } \
            kk[it] = (v4u){w[0], w[1], w[2], w[3]}; } } while (0)
#define FOR_KEYS(ch_) _Pragma("unroll") for (int it = 0; it < CIT; ++it) if ((ch_) * CIT + it < nIt) { const int e0 = ((ch_) * CIT + it) * 512 + lane * 8; (void)e0; unsigned w[4] = {kk[it].x, kk[it].y, kk[it].z, kk[it].w}; \
            asm volatile("" : "+v"(w[0]), "+v"(w[1]), "+v"(w[2]), "+v"(w[3])); _Pragma("unroll") for (int d = 0; d < 4; ++d) { const unsigned k0 = w[d] & 0xFFFFu, k1 = w[d] >> 16; (void)k0; (void)k1;
#define END_KEYS } }
#pragma unroll
        for (int q = 0; q < 4 * NHC; ++q) hist[lane + 64 * q] = 0u;
        if (NCH == 1) LOADCHUNK(0);
        asm volatile("s_waitcnt lgkmcnt(0)" ::: "memory");
        LAS unsigned* hc = hist + (lane & (NHC - 1)) * 256;
#pragma unroll 1
        for (int ch = 0; ch < NCH; ++ch) { if (NCH > 1) LOADCHUNK(ch);
            FOR_KEYS(ch) __hip_atomic_fetch_add(hc + (k0 >> 8), 1u, __ATOMIC_RELAXED, __HIP_MEMORY_SCOPE_WORKGROUP); __hip_atomic_fetch_add(hc + (k1 >> 8), 1u, __ATOMIC_RELAXED, __HIP_MEMORY_SCOPE_WORKGROUP); END_KEYS }
        asm volatile("s_waitcnt lgkmcnt(0)" ::: "memory");
        int B1, above1; find_bin(hist, NHC, TOPK, lane, B1, above1);
        if (MODE == 11) { if (B1 == 12345) list[lane] = (unsigned)above1; return; }
        asm volatile("" ::: "memory");
#pragma unroll
        for (int q = 0; q < 4; ++q) hist[lane + 64 * q] = 0u;
        asm volatile("s_waitcnt lgkmcnt(0)" ::: "memory");
#pragma unroll 1
        for (int ch = 0; ch < NCH; ++ch) { if (NCH > 1) LOADCHUNK(ch);
            FOR_KEYS(ch) if ((int)(k0 >> 8) == B1) __hip_atomic_fetch_add(hist + (k0 & 255u), 1u, __ATOMIC_RELAXED, __HIP_MEMORY_SCOPE_WORKGROUP);
                         if ((int)(k1 >> 8) == B1) __hip_atomic_fetch_add(hist + (k1 & 255u), 1u, __ATOMIC_RELAXED, __HIP_MEMORY_SCOPE_WORKGROUP); END_KEYS }
        asm volatile("s_waitcnt lgkmcnt(0)" ::: "memory");
        int B2, above2; find_bin(hist, 1, TOPK - above1, lane, B2, above2);
        const unsigned tau = ((unsigned)B1 << 8) | (unsigned)B2; const int cnt_gt = above1 + above2;
        if (MODE == 12) { if (tau == 0x12345u) list[lane] = (unsigned)cnt_gt; return; }
        constexpr int NMW = (CIT + 3) / 4;
#define BUILD_MASKS(ch_) do { _Pragma("unroll") for (int wq = 0; wq < NMW; ++wq) { mg[wq] = 0u; me[wq] = 0u; } \
            FOR_KEYS(ch_) const unsigned g2 = ((tau - k0) >> 31) | (((tau - k1) >> 31) << 1), q2 = (((k0 ^ tau) - 1u) >> 31) | ((((k1 ^ tau) - 1u) >> 31) << 1); \
                mg[it >> 2] |= g2 << (8 * (it & 3) + 2 * d); me[it >> 2] |= q2 << (8 * (it & 3) + 2 * d); END_KEYS } while (0)
        unsigned mg[NMW], me[NMW];
        int cg = 0, ce = 0;
#pragma unroll 1
        for (int ch = 0; ch < NCH; ++ch) { if (NCH > 1) LOADCHUNK(ch);
            BUILD_MASKS(ch);
#pragma unroll
            for (int wq = 0; wq < NMW; ++wq) { cg += __popc(mg[wq]); ce += __popc(me[wq]); } }
        if (MODE == 13) { if (cg == 12345) list[lane] = (unsigned)ce; return; }
        int pg = cg, pe = ce;
#pragma unroll
        for (int o = 1; o < 64; o <<= 1) { const int tg = __shfl_up(pg, o), te = __shfl_up(pe, o); if (lane >= o) { pg += tg; pe += te; } }
        pg -= cg; pe = cnt_gt + (pe - ce);
        asm volatile("" ::: "memory");
#pragma unroll 1
        for (int ch = 0; ch < NCH; ++ch) { if (NCH > 1) { LOADCHUNK(ch); BUILD_MASKS(ch); }
#pragma unroll
            for (int wq = 0; wq < NMW; ++wq) { const int ebase = ((ch * CIT + 4 * wq) * 512) + lane * 8;
                unsigned m = mg[wq];
                while (m) { const int bb = __builtin_ctz(m); m &= m - 1u; list[pg] = (unsigned)(ebase + ((bb >> 3) << 9) + (bb & 7)); ++pg; }
                m = me[wq];
                while (m) { const int bb = __builtin_ctz(m); m &= m - 1u; if (pe < TOPK) list[pe] = (unsigned)(ebase + ((bb >> 3) << 9) + (bb & 7)); ++pe; } } }
#undef BUILD_MASKS
#undef LOADCHUNK
#undef FOR_KEYS
#undef END_KEYS
    }
    asm volatile("s_waitcnt lgkmcnt(0)" ::: "memory");
    if (MODE == 1) return;
    const int hcol = lane & 15, g = lane >> 4;
    const float* ckb = nullptr; const float* cvb = nullptr; const int* ptb = nullptr;
    if (SMP) { ckb = P.cache_k + (size_t)layer * NPOOL * PAGE * KVD; cvb = P.cache_v + (size_t)layer * NPOOL * PAGE * KVD; ptb = P.page_table + b * NPAGES; }
    const unsigned char* kvb = (const unsigned char*)(SMP ? B.KV + (size_t)(MP + b * ST) * 256 : B.KV + (size_t)b * T * 256);
    LAS unsigned char* vb = wl + WL_VB;
    constexpr float LOG2E = 1.4426950408889634f;
#pragma unroll 1
    for (int nk = 0; nk < 2; ++nk) {
        bf16x8 qf[2];
#pragma unroll
        for (int ks = 0; ks < 2; ++ks) { qf[ks] = (bf16x8){0, 0, 0, 0, 0, 0, 0, 0}; if (hcol < 4) qf[ks] = *(const bf16x8*)(B.QB + (size_t)m * 512 + (4 * nk + hcol) * 64 + 32 * ks + 8 * g); }
        f32x4 S[16];
        if (SMP) {
#pragma unroll
            for (int tl = 0; tl < 16; ++tl) {
                const unsigned kidx = list[16 * tl + hcol]; bf16x8 a0, a1;
                if (kidx < (unsigned)PAST) { const float* kp = ckb + ((size_t)ptb[kidx >> 7] * PAGE + (kidx & 127u)) * KVD + 64 * nk + 8 * g;
                    const f32x4 u0 = *(const f32x4*)kp, u1 = *(const f32x4*)(kp + 4), u2 = *(const f32x4*)(kp + 32), u3 = *(const f32x4*)(kp + 36);
                    v4u p0, p1; p0.x = pk_bf16(u0.x, u0.y); p0.y = pk_bf16(u0.z, u0.w); p0.z = pk_bf16(u1.x, u1.y); p0.w = pk_bf16(u1.z, u1.w);
                    p1.x = pk_bf16(u2.x, u2.y); p1.y = pk_bf16(u2.z, u2.w); p1.z = pk_bf16(u3.x, u3.y); p1.w = pk_bf16(u3.z, u3.w);
                    a0 = __builtin_bit_cast(bf16x8, p0); a1 = __builtin_bit_cast(bf16x8, p1);
                } else { const unsigned off = (kidx - PAST) * 512u + (unsigned)(128 * nk + 16 * g); a0 = *(const bf16x8*)(kvb + off); a1 = *(const bf16x8*)(kvb + off + 64u); }
                f32x4 s = {0.f, 0.f, 0.f, 0.f};
                s = __builtin_amdgcn_mfma_f32_16x16x32_bf16(a0, qf[0], s, 0, 0, 0);
                S[tl] = __builtin_amdgcn_mfma_f32_16x16x32_bf16(a1, qf[1], s, 0, 0, 0);
            }
        } else {
#define KLOAD(dst, kb_, q_) do { const int kl_ = (lane >> 3) + 8 * (q_), part_ = lane & 7; const unsigned kidx_ = list[32 * (kb_) + kl_]; \
                (dst) = *(const v4u*)(kvb + (kidx_ * 512u + (unsigned)(128 * nk + 16 * part_))); } while (0)
            v4u pk[2][8];
#pragma unroll
            for (int i = 0; i < 8; ++i) KLOAD(pk[0][i], i >> 2, i & 3);
#pragma unroll
            for (int kb = 0; kb < 8; ++kb) {
                asm volatile("" ::: "memory");
                if ((kb & 1) == 0 && kb + 2 < 8) {
#pragma unroll
                    for (int i = 0; i < 8; ++i) KLOAD(pk[((kb >> 1) + 1) & 1][i], kb + 2 + (i >> 2), i & 3);
                }
#pragma unroll
                for (int q = 0; q < 4; ++q) *(LAS v4u*)(vb + ((lane >> 3) + 8 * q) * VB_LD + (lane & 7) * 16) = pk[(kb >> 1) & 1][4 * (kb & 1) + q];
                asm volatile("" ::: "memory");
#pragma unroll
                for (int t2 = 0; t2 < 2; ++t2) { const LAS unsigned char* kr = vb + (16 * t2 + hcol) * VB_LD + 16 * g;
                    const bf16x8 a0 = *(const LAS bf16x8*)kr, a1 = *(const LAS bf16x8*)(kr + 64);
                    f32x4 s = {0.f, 0.f, 0.f, 0.f};
                    s = __builtin_amdgcn_mfma_f32_16x16x32_bf16(a0, qf[0], s, 0, 0, 0);
                    S[2 * kb + t2] = __builtin_amdgcn_mfma_f32_16x16x32_bf16(a1, qf[1], s, 0, 0, 0); }
                asm volatile("" ::: "memory");
            }
#undef KLOAD
        }
        if (cnt < TOPK) {
#pragma unroll
            for (int tl = 0; tl < 16; ++tl) { const int p0i = 16 * tl + 4 * g;
                S[tl].x = p0i + 0 < cnt ? S[tl].x : -INFINITY; S[tl].y = p0i + 1 < cnt ? S[tl].y : -INFINITY; S[tl].z = p0i + 2 < cnt ? S[tl].z : -INFINITY; S[tl].w = p0i + 3 < cnt ? S[tl].w : -INFINITY; } }
        if (MODE == 3) { float sacc = 0.f;
#pragma unroll
            for (int tl = 0; tl < 16; ++tl) sacc += S[tl].x + S[tl].w; if (sacc == 1234.5f) *(float*)(B.X) = sacc; continue; }
#define VLOAD(dst, kb_, q_) do { const int kl_ = (lane >> 3) + 8 * (q_), part_ = lane & 7; const unsigned kidx_ = list[32 * (kb_) + kl_]; \
            if (SMP && kidx_ < (unsigned)PAST) { const float* vp_ = cvb + ((size_t)ptb[kidx_ >> 7] * PAGE + (kidx_ & 127u)) * KVD + 64 * nk + 8 * part_; \
                const f32x4 u0_ = *(const f32x4*)vp_, u1_ = *(const f32x4*)(vp_ + 4); (dst).x = pk_bf16(u0_.x, u0_.y); (dst).y = pk_bf16(u0_.z, u0_.w); (dst).z = pk_bf16(u1_.x, u1_.y); (dst).w = pk_bf16(u1_.z, u1_.w); \
            } else (dst) = *(const v4u*)(kvb + ((SMP ? kidx_ - PAST : kidx_) * 512u + (unsigned)(256 + 128 * nk + 16 * part_))); } while (0)
        v4u pv[2][8];
        if (!SMP) {
#pragma unroll
            for (int i = 0; i < 8; ++i) VLOAD(pv[0][i], i >> 2, i & 3);
        }
        float mx = -INFINITY;
#pragma unroll
        for (int tl = 0; tl < 16; ++tl) mx = fmaxf(fmaxf(mx, fmaxf(S[tl].x, S[tl].y)), fmaxf(S[tl].z, S[tl].w));
        mx = fmaxf(mx, __shfl_xor(mx, 16)); mx = fmaxf(mx, __shfl_xor(mx, 32));
        const float mx2 = mx * LOG2E; float sum = 0.f;
#pragma unroll
        for (int tl = 0; tl < 16; ++tl) { S[tl].x = __builtin_amdgcn_exp2f(S[tl].x * LOG2E - mx2); S[tl].y = __builtin_amdgcn_exp2f(S[tl].y * LOG2E - mx2); S[tl].z = __builtin_amdgcn_exp2f(S[tl].z * LOG2E - mx2); S[tl].w = __builtin_amdgcn_exp2f(S[tl].w * LOG2E - mx2);
            sum += (S[tl].x + S[tl].y) + (S[tl].z + S[tl].w); }
        sum += __shfl_xor(sum, 16); sum += __shfl_xor(sum, 32);
        f32x4 O[4];
#pragma unroll
        for (int dt = 0; dt < 4; ++dt) O[dt] = (f32x4){0.f, 0.f, 0.f, 0.f};
#pragma unroll
        for (int kb = 0; kb < 8; ++kb) {
            asm volatile("" ::: "memory");
            if (SMP) {
#pragma unroll
                for (int q = 0; q < 4; ++q) VLOAD(pv[0][q], kb, q);
            } else if ((kb & 1) == 0 && kb + 2 < 8) {
#pragma unroll
                for (int i = 0; i < 8; ++i) VLOAD(pv[((kb >> 1) + 1) & 1][i], kb + 2 + (i >> 2), i & 3);
            }
#pragma unroll
            for (int q = 0; q < 4; ++q) *(LAS v4u*)(vb + ((lane >> 3) + 8 * q) * VB_LD + (lane & 7) * 16) = SMP ? pv[0][q] : pv[(kb >> 1) & 1][4 * (kb & 1) + q];
            asm volatile("" ::: "memory");
            v4u pw; pw.x = pk_bf16(S[2 * kb].x, S[2 * kb].y); pw.y = pk_bf16(S[2 * kb].z, S[2 * kb].w); pw.z = pk_bf16(S[2 * kb + 1].x, S[2 * kb + 1].y); pw.w = pk_bf16(S[2 * kb + 1].z, S[2 * kb + 1].w);
            const bf16x8 pf = __builtin_bit_cast(bf16x8, pw);
#pragma unroll
            for (int dt = 0; dt < 4; ++dt) {
                const LAS unsigned char* ta = vb + (4 * g + (hcol >> 2)) * VB_LD + (16 * dt + 4 * (hcol & 3)) * 2;
                const s16x4 lo = __builtin_bit_cast(s16x4, __builtin_amdgcn_ds_read_tr16_b64_v4i16((LAS s16x4*)ta));
                const s16x4 hi = __builtin_bit_cast(s16x4, __builtin_amdgcn_ds_read_tr16_b64_v4i16((LAS s16x4*)(ta + 16 * VB_LD)));
                const bf16x8 af = {lo.x, lo.y, lo.z, lo.w, hi.x, hi.y, hi.z, hi.w};
                O[dt] = __builtin_amdgcn_mfma_f32_16x16x32_bf16(af, pf, O[dt], 0, 0, 0); }
            asm volatile("" ::: "memory");
        }
#undef VLOAD
        if (hcol < 4 && (MODE == 0 || sum == 123.456f)) { const float inv = 1.f / sum;
#pragma unroll
            for (int dt = 0; dt < 4; ++dt) { v2u w; w.x = pk_bf16(O[dt].x * inv, O[dt].y * inv); w.y = pk_bf16(O[dt].z * inv, O[dt].w * inv);
                *(v2u*)(B.CA + (size_t)m * DM + DCONV + (4 * nk + hcol) * 64 + 16 * dt + 4 * g) = w; } }
    }
    asm volatile("s_waitcnt lgkmcnt(0)" ::: "memory");
}
constexpr int NPHASE = 1 + 9 * DEPTH;
constexpr int I_IN = (DM / 64) * ((DIN + 31) / 32), I_C = (DCONV / 64) * (DM / 32), I_A = (DATT / 64) * (DM / 32), I_O = (DM / 64) * (DM / 32), I_1 = (DM / 64) * (DFF / 32), I_2 = (DFF / 64) * (DM / 32);
constexpr int I_L = I_IN + I_C + I_A + I_O + I_1 + I_2;
constexpr int I_HEAD = I_IN + I_C + I_A + I_O, I_FF = I_1 + I_2;
#ifndef PH_MASK
#define PH_MASK 0x3FF
#endif
#define PH_ON(k) (((PH_MASK) >> (k)) & 1)
#ifndef REP_PH
#define REP_PH -1
#endif
#ifndef REP_N
#define REP_N 1
#endif
#define REPS(k) for (int rep_ = 0; rep_ <= ((REP_PH) == (k) ? (REP_N) : 0); ++rep_)
__global__ void __launch_bounds__(NTHR, 2) fwd(Args args) {
    extern __shared__ __attribute__((aligned(16))) unsigned char lds_[];
    LAS unsigned char* lds = (LAS unsigned char*)lds_;
    volatile LAS unsigned* MISC = (volatile LAS unsigned*)(lds + MISC_OFF);
    const int tid = threadIdx.x, lane = tid & 63, wave = __builtin_amdgcn_readfirstlane(tid >> 6);
    const int G = gridDim.x; const int bx = blockIdx.x; const int vcu = (G % 8 == 0) ? (bx % 8) * (G / 8) + bx / 8 : bx;
    const int gw = vcu * NWAVES + wave, NGW = G * NWAVES;
    unsigned* ctl = (unsigned*)(args.ws + WS_CTL);
    for (int u = tid; u < (LDS_BYTES - LDSCTL_OFF) / 4; u += NTHR) ((LAS unsigned*)(lds + LDSCTL_OFF))[u] = 0u;
    __syncthreads();
    (void)xcd_barrier_post(ctl + CW_BAR, MISC + 8);
#define KAS __attribute__((address_space(4)))
#define ARGP(i) (*(const float* KAS const*)(ka_ + 8 * (i)))
#define MKBUFS() int tid_ = threadIdx.x; asm volatile("" : "+v"(tid_)); const int lane = tid_ & 63; (void)lane; const int wave = __builtin_amdgcn_readfirstlane(tid_ >> 6); (void)wave; \
    int G = gridDim.x, bx = blockIdx.x; asm volatile("" : "+s"(G), "+s"(bx)); const int vcu = (G % 8 == 0) ? (bx % 8) * (G / 8) + bx / 8 : bx; const int gw = vcu * NWAVES + wave, NGW = G * NWAVES; (void)gw; (void)NGW; \
    const KAS unsigned char* ka_ = (const KAS unsigned char*)__builtin_amdgcn_kernarg_segment_ptr(); asm volatile("" : "+s"(ka_)); \
    unsigned char* ws = *(unsigned char* KAS const*)(ka_ + 200); float* outp_ = *(float* KAS const*)(ka_ + 192); \
    Bufs B{}; B.X = (float*)(ws + WS_X); B.H = (bf16_t*)(ws + WS_H); B.U = (float*)(ws + WS_U); B.XC = (float*)(ws + WS_XC); B.QB = (bf16_t*)(ws + WS_QB); B.KV = (bf16_t*)(ws + WS_KV); \
    B.QI = (bf16_t*)(ws + WS_QI); B.KI = (bf16_t*)(ws + WS_KI); B.WI = (float*)(ws + WS_WI); B.G = (_Float16*)(ws + WS_G); B.CA = (bf16_t*)(ws + WS_CA); B.PA = (bf16_t*)(ws + WS_PA); \
    B.AT = (bf16_t*)(ws + WS_AT); B.MB = (bf16_t*)(ws + WS_MB); B.R = (bf16_t*)(ws + WS_R); B.SC = (_Float16*)(ws + WS_SC); B.SCS = (_Float16*)(ws + WS_SCS); \
    B.rc = (const float*)(ws + WS_ROPE); B.rs = B.rc + (T + ST) * 32; B.out = outp_;
#define IN(k) (args.ph_lo <= (k) && (k) < args.ph_hi)
#define GRIDBAR() do { XcdBarrier b_; b_.bar = (unsigned*)(args.ws + WS_CTL) + CW_BAR; b_.x = xb_xcc_id(); b_.st = (volatile LAS unsigned*)(lds + MISC_OFF) + 8; xcd_barrier(b_); } while (0)
#define SEAM(k) do { if (IN(k) && IN((k) + 1)) GRIDBAR(); } while (0)

    REPS(9) if (PH_ON(9) && IN(0)) { MKBUFS();
        LAS float* scr = (LAS float*)(lds + wave * 16384);
#define WCONV_ITEM(l_, r_in, scr_) do { const int wl_ = (l_); int r = (r_in); unsigned char* wb = ws + WS_W + (size_t)wl_ * W_LSTRIDE; \
            if (r < I_IN) { transpose_item<true>(ARGP(9) + (size_t)wl_ * DM * DIN, DM, DIN, (bf16_t*)(wb + WO_IN), scr_, r, lane, ARGP(8) + wl_ * DM); break; } r -= I_IN; \
            if (r < I_C) { transpose_item<false>(ARGP(14) + (size_t)wl_ * DCONV * DM, DCONV, DM, (bf16_t*)(wb + WO_C), scr_, r, lane, nullptr, DM, 0); break; } r -= I_C; \
            if (r < I_A) { transpose_item<false>(ARGP(15) + (size_t)wl_ * DATT * DM, DATT, DM, (bf16_t*)(wb + WO_C), scr_, r, lane, nullptr, DM, DCONV); break; } r -= I_A; \
            if (r < I_O) { transpose_item<false>(ARGP(19) + (size_t)wl_ * DM * DM, DM, DM, (bf16_t*)(wb + WO_O), scr_, r, lane); break; } r -= I_O; \
            if (r < I_1) { transpose_item<false>(ARGP(21) + (size_t)wl_ * DM * DFF, DM, DFF, (bf16_t*)(wb + WO_1), scr_, r, lane, ARGP(20) + wl_ * DM); break; } r -= I_1; \
            transpose_item<false>(ARGP(22) + (size_t)wl_ * DFF * DM, DFF, DM, (bf16_t*)(wb + WO_2), scr_, r, lane); } while (0)
        for (int it = gw; it < I_HEAD; it += NGW) WCONV_ITEM(0, it, scr);
        for (int it = gw; it < DEPTH * 184; it += NGW) { const int l = it / 184, r = 7 * 256 + 72 + it % 184; bf16_t* p = (bf16_t*)(ws + WS_W + (size_t)l * W_LSTRIDE + WO_IN) + (size_t)r * DM;
            *((v4u*)p + lane) = (v4u){0u, 0u, 0u, 0u}; *((v4u*)p + 64 + lane) = (v4u){0u, 0u, 0u, 0u}; }
        for (int it = gw; it < DEPTH * DM; it += NGW) { const int l = it / DM, j = it % DM; const int c0 = 4 * lane, g = c0 >> 6, cl = c0 & 63;
            const float* pw = ARGP(16) + (((size_t)l * 4 + g) * 64 + cl) * 64; const float* ps = ARGP(17) + l * DPOOL + 64 * g; const float* wo = ARGP(18) + ((size_t)l * DPOOL + 64 * g) * DM + j;
            float a0 = 0.f, a1 = 0.f, a2 = 0.f, a3 = 0.f;
#pragma unroll 16
            for (int d = 0; d < 64; ++d) { const float f = ps[d] * wo[(size_t)d * DM]; a0 += pw[d] * f; a1 += pw[64 + d] * f; a2 += pw[128 + d] * f; a3 += pw[192 + d] * f; }
            v2u w; w.x = pk_bf16(a0, a1); w.y = pk_bf16(a2, a3);
            *(v2u*)((bf16_t*)(ws + WS_W + (size_t)l * W_LSTRIDE + WO_C) + (size_t)j * DM + (DCONV + DATT) + c0) = w; }
        {
            const double invr = exp(-(double)(tid_ & 31) / 32.0 * log(10000.0)) * 0.15915494309189535;
            for (int i = (vcu * NTHR + tid_); i < (T + ST) * 32; i += G * NTHR) { const int p = i >> 5; const double pos = p < T ? (double)p : (double)(PAST + p - T);
                const double tr = pos * invr; const float fr = (float)(tr - rint(tr)); ((float*)B.rc)[i] = __builtin_amdgcn_cosf(fr); ((float*)B.rs)[i] = __builtin_amdgcn_sinf(fr); } }
        for (int m = gw; m < M; m += 2 * NGW) { const int m2 = m + NGW; const bool has2 = m2 < M, sa_ = m >= MP, sb_ = m2 >= MP;
            prep_row2(sa_ ? ARGP(1) + (size_t)(m - MP) * DM : ARGP(0) + (size_t)m * DM, B.H + (size_t)m * DM, sa_ ? (float*)(ws + WS_SSQBS) + (size_t)(m - MP) * 64 : (float*)(ws + WS_SSQB) + (size_t)m * 16, sa_ ? 64 : 16,
                      sb_ ? ARGP(1) + (size_t)(m2 - MP) * DM : ARGP(0) + (size_t)m2 * DM, B.H + (size_t)m2 * DM, sb_ ? (float*)(ws + WS_SSQBS) + (size_t)(m2 - MP) * 64 : (float*)(ws + WS_SSQB) + (size_t)m2 * 16, sb_ ? 64 : 16, has2, lane); }
    }
    SEAM(0);

    for (int l = 0; l < DEPTH; ++l) {
        const int pb = 1 + 9 * l;
#define MKW() unsigned char* wb = ws + WS_W + (size_t)l * W_LSTRIDE; \
        const bf16_t* Win_t = (const bf16_t*)(wb + WO_IN); const bf16_t* Wc_t = (const bf16_t*)(wb + WO_C); const bf16_t* Wa_t = (const bf16_t*)(wb + WO_A); const bf16_t* Wp_t = (const bf16_t*)(wb + WO_P); \
        const bf16_t* Wo_t = (const bf16_t*)(wb + WO_O); const bf16_t* W1_t = (const bf16_t*)(wb + WO_1); const bf16_t* W2_t = (const bf16_t*)(wb + WO_2); (void)Win_t; (void)Wc_t; (void)Wa_t; (void)Wp_t; (void)Wo_t; (void)W1_t; (void)W2_t;

        REPS(0) if (PH_ON(0) && IN(pb + 0)) { MKBUFS(); MKW();
            pg8::Gemm g{B.H, Win_t, M, NIN, DM}; pg8::StaticOrder S; S.init(M, NIN, G, bx);
            LAS float* rst = (LAS float*)(lds + RST_OFF);
            { int pms[8];
#pragma unroll
                for (int i = 0; i < 8; ++i) { pg8::Unit uu; pms[i] = S.next(i, uu) ? uu.pm : -1; }
                float rv[8]; const int r_ = tid_ & 255;
#pragma unroll
                for (int i = 0; i < 8; ++i) rv[i] = pms[i] >= 0 ? row_ms_inv(ws, WS_SSQB, WS_SSQBS, (unsigned)(pms[i] * 256 + r_)) : 0.f;
#pragma unroll
                for (int i = 0; i < 8; ++i) if (tid_ < 256) rst[i * 256 + r_] = sqrtf(rv[i]); }
            __syncthreads();
#ifdef INPROJ_NULL_REP
            if (rep_ > 0) { EpiNull EN{(float*)(ws + WS_TMP + 200 * MiB)}; pg8::gemm_phase<EpiNull, pg8::StaticOrder, true, true>(lds, g, S, EN); } else
#endif
            { EpiInproj E{ws, (unsigned char*)outp_, l, rst};
            pg8::gemm_phase<EpiInproj, pg8::StaticOrder, true, true>(lds, g, S, E); }
            if (rep_ == 0) { pg8::Unit uu; const int nfull = (M / 256) * (NIN / 256) - (G > 0 ? ((M / 256) * (NIN / 256) / G) * G : 0);
                if (!S.next(((M / 256) * (NIN / 256)) / G, uu)) { const int nlight = G - nfull; LAS float* scr2 = (LAS float*)(lds + wave * 16384);
                    const int ntail = I_FF + (l + 1 < DEPTH ? I_HEAD : 0);
                    for (int it = (bx - nfull) * NWAVES + wave; it < ntail; it += nlight * NWAVES) { if (it < I_FF) WCONV_ITEM(l, I_HEAD + it, scr2); else WCONV_ITEM(l + 1, it - I_FF, scr2); } } }
        }
        SEAM(pb + 0);
#ifdef EXTRA_BARS
        for (int eb = 0; eb < EXTRA_BARS; ++eb) GRIDBAR();
#endif
        REPS(1) if (PH_ON(1) && IN(pb + 1)) { MKBUFS();
            P2Args P{ARGP(5), ARGP(6), ARGP(10), ARGP(11), ARGP(12), ARGP(13), ARGP(4), (const int*)ARGP(7)};
            LAS float* wl = (LAS float*)(lds + 40960);
            for (int i = tid_; i < 48 * DCONV / 4; i += NTHR) { const int j = i / (DCONV / 4) - 8; ((LAS f32x4*)wl)[i] = (j >= 0 && j < CONVW) ? ((const f32x4*)(P.conv_w + (size_t)l * CONVW * DCONV))[i - 8 * (DCONV / 4)] : (f32x4){0.f, 0.f, 0.f, 0.f}; }
            __syncthreads();
#ifndef P2_REP_MODE
#define P2_REP_MODE 0
#endif
#ifndef P2_UNIT_ABL
#define P2_UNIT_ABL 0
#endif
            const int p2m = rep_ > 0 ? P2_REP_MODE : 0;
            {
                volatile LAS unsigned* q2 = MISC + 24 + l + 2 * rep_;
                const int vS = vcu, vC = (vcu + G - G / 3) % G, vT = (vcu + G - 2 * (G / 3)) % G;
                const int nS = (p2m == 0 || p2m == 1) ? (SB * NPAGES + SB - vS + G - 1) / G : 0, nC = (p2m == 0 || p2m == 2) ? (MP / 8 + SB - vC + G - 1) / G : 0, nT = (p2m == 0 || p2m == 2) ? (NB * 45 + SB * 45 - vT + G - 1) / G : 0;
                for (;;) { unsigned it = 0; if (lane == 0) it = __hip_atomic_fetch_add((LAS unsigned*)q2, 1u, __ATOMIC_RELAXED, __HIP_MEMORY_SCOPE_WORKGROUP); it = __builtin_amdgcn_readfirstlane(it);
                    int j = (int)it; if (j >= nS + 2 * nC + nT) break;
                    { const int ng = (nS >> 1) < nC ? (nS >> 1) : nC;
                        if (j < 3 * ng) { const int gq = j / 3, gr = j - 3 * gq;
                            if (gr < 2) scores_sample_task(B, P, l, vS + G * (2 * gq + gr), lane, lds + wave * (32 * KI_LD)); else conv_task(B, P, l, vC + G * gq, lane, wl);
                            continue; }
                        j -= 3 * ng;
                        if (j < nS - 2 * ng) { scores_sample_task(B, P, l, vS + G * (2 * ng + j), lane, lds + wave * (32 * KI_LD)); continue; } j -= nS - 2 * ng;
                        if (j < nC - ng) { conv_task(B, P, l, vC + G * (ng + j), lane, wl); continue; } j -= nC - ng; }
                    if (j < nC) { pool_task(B, P, l, vC + G * j, lane); continue; } j -= nC;
                    states_task(B, P, l, vT + G * j, lane); }
            }
            __syncthreads();
            int tid2 = threadIdx.x; asm volatile("" : "+v"(tid2));
            if (p2m == 0 || p2m == 3) for (int u = bx; u < 2 * (T / 32); u += G) { const int b = u < T / 32 ? 0 : 1, qb = u < T / 32 ? u : 2 * (T / 32) - 1 - u; scores_prompt_unit(B, lds, b, qb, tid2, rep_ > 0 ? P2_UNIT_ABL : 0); }
        }
        SEAM(pb + 1);
        REPS(2) if (PH_ON(2) && IN(pb + 2)) { MKBUFS();
            P3Args P3{ARGP(2), ARGP(3), (const int*)ARGP(7)};
            LAS unsigned char* wl = lds + wave * WL_BYTES;
            volatile LAS unsigned* qhead = MISC + 16 + l + 2 * rep_;
            const int nprompt = (MP - vcu + G - 1) / G; const int nconv = 0;
            for (;;) { unsigned it = 0; if (lane == 0) it = __hip_atomic_fetch_add((LAS unsigned*)qhead, 1u, __ATOMIC_RELAXED, __HIP_MEMORY_SCOPE_WORKGROUP); it = __builtin_amdgcn_readfirstlane(it);
                if ((int)it > nprompt + nconv) break;
                if ((int)it > nprompt) { WCONV_ITEM(1, vcu + G * ((int)it - nprompt - 1), (LAS float*)wl); continue; }
#ifdef P3_REP_SAMPLE_ONLY
                if (rep_ > 0 && it > 0) break;
                if (it == 0) { if (vcu < MS) select_attend_task<true>(B, P3, l, MP + vcu, lane, wl); }
#else
                if (it == 0) { if (vcu < MS && rep_ == 0) select_attend_task<true>(B, P3, l, MP + vcu, lane, wl); }
#endif
                else {
#ifdef P3_REP_MODE
                    if (rep_ > 0) select_attend_task<false, P3_REP_MODE>(B, P3, l, vcu + G * ((int)it - 1), lane, wl); else
#endif
                    select_attend_task<false>(B, P3, l, vcu + G * ((int)it - 1), lane, wl); } }
        }
        SEAM(pb + 2);
        REPS(3) if (PH_ON(3) && IN(pb + 3)) { MKBUFS(); MKW();
            const bf16_t* Wcat = Wc_t;
            for (int tk = wave * G + vcu; tk < 16 * (DM / 16); tk += NGW) { const int mt = tk & 15, nt = tk >> 4;
                const bf16_t* As = B.CA + (size_t)MP * DM;
                const f32x4 ya = sg_tile(As, DM, Wcat, DCONV, mt, nt, lane, DM), yb = sg_tile(As + DCONV, DM, Wcat + DCONV, DATT, mt, nt, lane, DM),
                            yc = sg_tile(As + DCONV + DATT, DM, Wcat + DCONV + DATT, DPOOL, mt, nt, lane, DM);
                const size_t row = (size_t)MP + 16 * mt + (lane & 15); const int col = 16 * nt + 4 * (lane >> 4); const _Float16* gp = B.G + row * 3072 + col;
                const f16x4 ga = *(const f16x4*)gp, gb = *(const f16x4*)(gp + 1024), gc = *(const f16x4*)(gp + 2048); float r[4];
#pragma unroll
                for (int e = 0; e < 4; ++e) r[e] = (float)ga[e] * ya[e] + (float)gb[e] * yb[e] + (float)gc[e] * yc[e];
                v2u w; w.x = pk_bf16(r[0], r[1]); w.y = pk_bf16(r[2], r[3]); *(v2u*)(B.MB + row * DM + col) = w; }
            pg8::Gemm g{B.CA, Wcat, MP, DM, DM}; pg8::StaticOrder S; S.init(MP, DM, G, bx); EpiGate E{B.MB, B.G};
            pg8::gemm_phase<EpiGate, pg8::StaticOrder, true, true>(lds, g, S, E);
        }
        SEAM(pb + 3);
        REPS(4) if (PH_ON(4) && IN(pb + 4)) { MKBUFS(); MKW();
            float* ssq_p = (float*)(ws + WS_SSQA); float* ssq_s = (float*)(ws + WS_SSQAS);
            for (int tk = (wave & 3) * G + vcu; tk < 16 * (DM / 16); tk += 4 * G) { const int mt = tk & 15, nt = tk >> 4;
                f32x4 y = sg_tile(B.MB + (size_t)MP * DM + (wave >> 2) * (DM / 2), DM, Wo_t + (wave >> 2) * (DM / 2), DM / 2, mt, nt, lane, DM);
                LAS f32x4* slot = (LAS f32x4*)(lds + RST_OFF) + (wave & 3) * 64 + lane;
                if (wave >= 4) *slot = y;
                __syncthreads();
                if (wave >= 4) continue;
                { const f32x4 y2 = *slot; y.x += y2.x; y.y += y2.y; y.z += y2.z; y.w += y2.w; }
                const size_t ro = ((size_t)MP + 16 * mt + (lane & 15)) * DM + 16 * nt + 4 * (lane >> 4);
                v2u* p = (v2u*)(B.H + ro); const v2u h = *p; f32x4 o; o.x = __uint_as_float(h.x << 16) + y.x; o.y = __uint_as_float(h.x & 0xffff0000u) + y.y; o.z = __uint_as_float(h.y << 16) + y.z; o.w = __uint_as_float(h.y & 0xffff0000u) + y.w;
                v2u hw; hw.x = pk_bf16(o.x, o.y); hw.y = pk_bf16(o.z, o.w); *p = hw;
                float ss = (o.x * o.x + o.y * o.y) + (o.z * o.z + o.w * o.w); ss += __shfl_xor(ss, 16); ss += __shfl_xor(ss, 32);
                if ((lane >> 4) == 0) ssq_s[(size_t)(16 * mt + (lane & 15)) * 64 + nt] = ss; }
            pg8::Gemm g{B.MB, Wo_t, MP, DM, DM}; pg8::StaticOrder S; S.init(MP, DM, G, bx); EpiResid E{B.H, ssq_p};
            pg8::gemm_phase<EpiResid, pg8::StaticOrder, true, true>(lds, g, S, E);
        }
        if (IN(pb + 4) && IN(pb + 6)) GRIDBAR();
        REPS(6) if (PH_ON(6) && IN(pb + 6)) { MKBUFS(); MKW();
            for (int tk = wave * G + vcu; tk < 16 * (DFF / 16); tk += NGW) { const int mt = tk & 15, nt = tk >> 4;
                const f32x4 y = sg_tile(B.H + (size_t)MP * DM, DM, W1_t, DM, mt, nt, lane); float r[4];
                const float r2 = row_ms_inv(ws, WS_SSQA, WS_SSQAS, (unsigned)(MP + 16 * mt + (lane & 15)));
#pragma unroll
                for (int e = 0; e < 4; ++e) { const float x = fmaxf(y[e], 0.f); r[e] = x * x * r2; }
                v2u w; w.x = pk_bf16(r[0], r[1]); w.y = pk_bf16(r[2], r[3]); *(v2u*)(B.R + ((size_t)MP + 16 * mt + (lane & 15)) * DFF + 16 * nt + 4 * (lane >> 4)) = w; }
            pg8::Gemm g{B.H, W1_t, MP, DFF, DM}; pg8::StaticOrder S; S.init(MP, DFF, G, bx);
            LAS float* rst = (LAS float*)(lds + RST_OFF);
            { int pms[4];
#pragma unroll
                for (int i = 0; i < 4; ++i) { pg8::Unit uu; pms[i] = S.next(i, uu) ? uu.pm : -1; }
                float rv[4]; const int r_ = tid_ & 255;
#pragma unroll
                for (int i = 0; i < 4; ++i) rv[i] = pms[i] >= 0 ? row_ms_inv(ws, WS_SSQA, WS_SSQAS, (unsigned)(pms[i] * 256 + r_)) : 0.f;
#pragma unroll
                for (int i = 0; i < 4; ++i) if (tid_ < 256) rst[i * 256 + r_] = rv[i]; }
            __syncthreads();
            EpiRelu2 E{B.R, DFF, rst};
            pg8::gemm_phase<EpiRelu2, pg8::StaticOrder, true, true>(lds, g, S, E);
        }
        SEAM(pb + 6);
        REPS(7) if (PH_ON(7) && IN(pb + 7)) { MKBUFS(); MKW();
            float* ssq_p = (float*)(ws + WS_SSQB); float* ssq_s = (float*)(ws + WS_SSQBS);
            for (int tk = (wave & 3) * G + vcu; tk < 16 * (DM / 16); tk += 4 * G) { const int mt = tk & 15, nt = tk >> 4;
                f32x4 y = sg_tile(B.R + (size_t)MP * DFF + (wave >> 2) * (DFF / 2), DFF, W2_t + (wave >> 2) * (DFF / 2), DFF / 2, mt, nt, lane, DFF);
                LAS f32x4* slot = (LAS f32x4*)(lds + RST_OFF) + (wave & 3) * 64 + lane;
                if (wave >= 4) *slot = y;
                __syncthreads();
                if (wave >= 4) continue;
                { const f32x4 y2 = *slot; y.x += y2.x; y.y += y2.y; y.z += y2.z; y.w += y2.w; }
                const size_t ro = ((size_t)MP + 16 * mt + (lane & 15)) * DM + 16 * nt + 4 * (lane >> 4);
                v2u* p = (v2u*)(B.H + ro); const v2u h = *p; f32x4 o; o.x = __uint_as_float(h.x << 16) + y.x; o.y = __uint_as_float(h.x & 0xffff0000u) + y.y; o.z = __uint_as_float(h.y << 16) + y.z; o.w = __uint_as_float(h.y & 0xffff0000u) + y.w;
                v2u hw; hw.x = pk_bf16(o.x, o.y); hw.y = pk_bf16(o.z, o.w); *p = hw;
                float ss = (o.x * o.x + o.y * o.y) + (o.z * o.z + o.w * o.w); ss += __shfl_xor(ss, 16); ss += __shfl_xor(ss, 32);
                if ((lane >> 4) == 0) ssq_s[(size_t)(16 * mt + (lane & 15)) * 64 + nt] = ss; }
            pg8::Gemm g{B.R, W2_t, MP, DM, DFF}; pg8::StaticOrder S; S.init(MP, DM, G, bx); EpiResid E{B.H, ssq_p};
            pg8::gemm_phase<EpiResid, pg8::StaticOrder, true, true>(lds, g, S, E);
        }
        if (l + 1 == DEPTH) { SEAM(pb + 7);
            REPS(8) if (PH_ON(8) && IN(pb + 8)) { MKBUFS(); MKW();
                for (int m = gw; m < M; m += 2 * NGW) { const int m2 = m + NGW; const bool has2 = m2 < M;
                    rms_row_bf2(B.H + (size_t)m * DM, B.out + (m < MP ? O_YP + (size_t)m * DM : O_YS + (size_t)(m - MP) * DM),
                                B.H + (size_t)m2 * DM, B.out + (m2 < MP ? O_YP + (size_t)m2 * DM : O_YS + (size_t)(m2 - MP) * DM), has2, ARGP(23), lane); } }
        } else { if (IN(pb + 7) && IN(pb + 9)) GRIDBAR(); }
    }
#undef IN
#undef SEAM
}
extern "C" void kernel_launch(void* const* d_in, const int* in_sizes, int n_in, void* d_out, int out_size, void* d_ws, size_t ws_size, hipStream_t stream) {
    if (n_in != 24 || (size_t)out_size != O_END || ws_size < WS_END) { fprintf(stderr, "kernel_launch: unexpected sizes n_in %d out %d ws %zu\n", n_in, out_size, ws_size); return; }
    static int grid = 0;
    if (grid == 0) {
        int dev = 0, cus = 0, per_cu = 0;
        if (hipGetDevice(&dev) != hipSuccess || hipDeviceGetAttribute(&cus, hipDeviceAttributeMultiprocessorCount, dev) != hipSuccess) { fprintf(stderr, "kernel_launch: device query failed\n"); grid = -1; return; }
        if (hipFuncSetAttribute((const void*)fwd, hipFuncAttributeMaxDynamicSharedMemorySize, LDS_BYTES) != hipSuccess) { fprintf(stderr, "kernel_launch: hipFuncSetAttribute failed\n"); grid = -1; return; }
        if (hipOccupancyMaxActiveBlocksPerMultiprocessor(&per_cu, (const void*)fwd, NTHR, LDS_BYTES) != hipSuccess || per_cu < 1) { fprintf(stderr, "kernel_launch: occupancy query says %d\n", per_cu); }
        (void)hipGetLastError();
        grid = cus;
    }
    if (grid < 0) return;
    unsigned char* ws = (unsigned char*)d_ws;
    Args a{}; for (int i = 0; i < 24; ++i) a.in[i] = (const float*)d_in[i]; a.out = (float*)d_out; a.ws = ws; a.ph_lo = 0; a.ph_hi = NPHASE;
    (void)hipMemsetAsync(ws + WS_CTL, 0, CTL_ZERO_BYTES, stream);
    hipLaunchKernelGGL(fwd, dim3(grid), dim3(NTHR), LDS_BYTES, stream, a);
}
```

```cpp
#include <hip/hip_runtime.h>
#include <cstdio>
#include <cstdint>

constexpr int DM = 1024, NB = 2, T = 8192, DEPTH = 2, SB = 32, ST = 8, PAST = 16384, PAGE = 128, NPAGES = PAST / PAGE;
constexpr int NPOOL = 5120;
constexpr int DCONV = 256, CONVW = 31, CHIST = 30, HD = 64, DATT = 512, NH = 8, NKV = 2, KVD = 128, IH = 8, ID = 64, TOPK = 256;
constexpr int DPOOL = 256, PHIST = 15, DFF = 4096, DIN = 5192;
constexpr int MP = NB * T, MS = SB * ST, M = MP + MS;
constexpr int C_AIN = 0, C_AGATE = 256, C_Q = 512, C_K = 1024, C_V = 1152, C_QI = 1280, C_KI = 1792, C_WI = 1856, C_XC = 1864, C_G = 2120;
constexpr int SCS_LD = 16896;
constexpr float RMS_EPS = 1e-6f, LN_EPS = 1e-5f;
constexpr float WI_SCALE = 0.04419417382415922f;

constexpr size_t O_YP = 0, O_YS = O_YP + (size_t)MP * DM, O_KP = O_YS + (size_t)MS * DM, O_VP = O_KP + (size_t)DEPTH * MP * KVD,
                 O_KIP = O_VP + (size_t)DEPTH * MP * KVD, O_CP = O_KIP + (size_t)DEPTH * MP * ID, O_PP = O_CP + (size_t)DEPTH * NB * CHIST * DCONV,
                 O_KS = O_PP + (size_t)DEPTH * NB * PHIST * DPOOL, O_VS = O_KS + (size_t)DEPTH * MS * KVD, O_KIS = O_VS + (size_t)DEPTH * MS * KVD,
                 O_CS = O_KIS + (size_t)DEPTH * MS * ID, O_PS = O_CS + (size_t)DEPTH * SB * CHIST * DCONV, O_END = O_PS + (size_t)DEPTH * SB * PHIST * DPOOL;

constexpr size_t MiB = 1u << 20;
constexpr size_t WS_ROPE = 64 * MiB;
constexpr size_t WS_X = 80 * MiB;
constexpr size_t WS_H = 160 * MiB;
constexpr size_t WS_U = 200 * MiB;
constexpr size_t WS_XC = 220 * MiB;
constexpr size_t WS_QB = 240 * MiB;
constexpr size_t WS_KV = 260 * MiB;
constexpr size_t WS_QI = 272 * MiB;
constexpr size_t WS_KI = 292 * MiB;
constexpr size_t WS_WI = 296 * MiB;
constexpr size_t WS_G = 300 * MiB;
constexpr size_t WS_CA = 404 * MiB;
constexpr size_t WS_PA = 414 * MiB;
constexpr size_t WS_AT = 424 * MiB;
constexpr size_t WS_MB = 444 * MiB;
constexpr size_t WS_R = 480 * MiB;
constexpr size_t WS_SC = 620 * MiB;
constexpr size_t WS_SCS = 880 * MiB;
constexpr size_t WS_TMP = 900 * MiB;
constexpr size_t WS_TMP2 = 1260 * MiB;
constexpr size_t WS_END = 1500 * MiB;

typedef unsigned short bf16_t;
__device__ __forceinline__ float bf2f(bf16_t v) { return __builtin_bit_cast(float, (unsigned)v << 16); }
__device__ __forceinline__ bf16_t f2bf(float f) { unsigned u = __builtin_bit_cast(unsigned, f); return (bf16_t)((u + 0x7fffu + ((u >> 16) & 1u)) >> 16); }
__device__ __forceinline__ float sigmoidf_(float x) { return 1.f / (1.f + __expf(-x)); }

__device__ __forceinline__ int rope_row(int m) { return m < MP ? (m & (T - 1)) : T + ((m - MP) & (ST - 1)); }

struct Bufs { float* X; bf16_t* H; float* U; float* XC; bf16_t* QB; bf16_t* KV; bf16_t* QI; bf16_t* KI; float* WI; _Float16* G; bf16_t* CA; bf16_t* PA; bf16_t* AT; bf16_t* MB; bf16_t* R;
              _Float16* SC; _Float16* SCS; const float* rc; const float* rs; float* out; };

namespace pg8 {
#define PG8_LAS __attribute__((address_space(3)))
typedef unsigned short bf16_t;
typedef short bf16x8 __attribute__((ext_vector_type(8)));
typedef float f32x4 __attribute__((ext_vector_type(4)));
typedef unsigned u32x4 __attribute__((ext_vector_type(4)));
constexpr int BM = 256, BK = 64, HALF = 128, HTB = HALF * BK * 2  , STAGE_BYTES = 8 * HTB, NXCD = 8, WGM = 8;

__host__ __device__ __forceinline__ int lds_byte(int r, int c) { const int st = (r >> 4) * 2 + (c >> 5), rr = r & 15, cc = c & 31, ob = rr * 64 + cc * 2; return st * 1024 + (ob ^ (((ob >> 9) & 1) << 5)); }
__host__ __device__ __forceinline__ void stage_rc(int b, int& R, int& C) { const int st = b / 1024, sb = b % 1024, swz = sb ^ (((sb >> 9) & 1) << 5); R = (st >> 1) * 16 + swz / 64; C = (st & 1) * 32 + (swz % 64) / 2; }
__host__ __device__ __forceinline__ int perm32(int rho) { const int n = rho >> 4, i = rho & 15; return 8 * (i >> 2) + 4 * n + (i & 3); }

struct Unit { int pm, pn, idx; };
struct Gemm { const bf16_t* A; const bf16_t* Bt; int M, N, K; };

struct StaticOrder {
    int nM, nN, nwg, G, c;
    __host__ __device__ __forceinline__ void init(int M, int N, int G_, int c_) { nM = M / BM; nN = N / BM; nwg = nM * nN; G = G_; c = c_; }
    __host__ __device__ __forceinline__ bool next(int i, Unit& u) const {
        const long L = (long)i * G + c; if (L >= nwg) return false;
        int wgid = (int)L; { const int q = nwg / NXCD, r = nwg % NXCD, xcd = wgid % NXCD, off = wgid / NXCD; wgid = (xcd < r ? xcd * (q + 1) : r * (q + 1) + (xcd - r) * q) + off; }
        const int nig = WGM * nN, gid = wgid / nig, fm = gid * WGM, gsz = (nM - fm) < WGM ? (nM - fm) : WGM;
        u.pm = fm + ((wgid % nig) % gsz); u.pn = (wgid % nig) / gsz; u.idx = i; return true;
    }
    __device__ __forceinline__ void a_ready(const Unit&) const {}
    __device__ __forceinline__ void done(const Unit&) const {}
};
typedef float f32x2 __attribute__((ext_vector_type(2)));
__device__ __forceinline__ unsigned cvt_pk_bf16(float lo, float hi) { unsigned r; asm volatile("v_cvt_pk_bf16_f32 %0, %1, %2" : "=v"(r) : "v"(lo), "v"(hi)); return r; }
template <class Epi, class Sched, bool ALIGN_EPI = false, bool SP2 = false>
__device__ __forceinline__ void gemm_phase(PG8_LAS unsigned char* lds, const Gemm g, const Sched& S, const Epi& E) {
    int tid = threadIdx.x; asm volatile("" : "+v"(tid));
    const int wid = __builtin_amdgcn_readfirstlane(tid >> 6), lane = tid & 63, wr = wid >> 2, wc = wid & 3, fr = lane & 15, fq = lane >> 4;
    const int K = g.K, nt = K / BK;
    unsigned voffA[2], voffB[2];
#pragma unroll
    for (int i = 0; i < 2; ++i) { int R, C; stage_rc(tid * 16 + i * 8192, R, C); const int Rb = Epi::COLMAP2 ? (64 * (R >> 5) + perm32(R & 31)) : (Epi::PERM ? ((R & ~31) + perm32(R & 31)) : R);
        voffA[i] = (unsigned)(R * K + C) * 2u; voffB[i] = (unsigned)(Rb * K + C) * 2u; }
    const size_t kstep = (size_t)(BK * 2);
    const size_t hstep = (size_t)HALF * K * 2;
    const size_t hstepB = Epi::COLMAP2 ? (size_t)32 * K * 2 : hstep;
    const size_t tstep = 2 * hstep;
    const unsigned ldsw = (unsigned)wid * 1024u;
    const int aoff = lds_byte(wr * 64 + fr, fq * 8), boff = lds_byte(wc * 32 + fr, fq * 8);
#define PG8_SA(b, h) (((b) * 2 + (h)) * HTB)
#define PG8_SB(b, h) ((4 + (b) * 2 + (h)) * HTB)
#define PG8_STAGE(bufoff, gbase, voff) do { _Pragma("unroll") for (int _i = 0; _i < 2; ++_i) \
        __builtin_amdgcn_global_load_lds((const unsigned*)((const char*)(gbase) + (voff)[_i]), (PG8_LAS unsigned*)(lds + (bufoff) + ldsw + _i * 8192), 16, 0, 0); } while (0)
#define PG8_LDA(dst, b, h) do { _Pragma("unroll") for (int m = 0; m < 4; ++m) _Pragma("unroll") for (int k = 0; k < 2; ++k) dst[m][k] = *(const PG8_LAS bf16x8*)(lds + PG8_SA(b, h) + aoff + m * 2048 + k * 1024); } while (0)
#define PG8_LDB(dst, b, h) do { _Pragma("unroll") for (int n = 0; n < 2; ++n) _Pragma("unroll") for (int k = 0; k < 2; ++k) dst[n][k] = *(const PG8_LAS bf16x8*)(lds + PG8_SB(b, h) + boff + n * 2048 + k * 1024); } while (0)
#define PG8_MMA(ai, bj, At, Bt) do { __builtin_amdgcn_s_setprio(1); _Pragma("unroll") for (int m = 0; m < 4; ++m) _Pragma("unroll") for (int n = 0; n < 2; ++n) _Pragma("unroll") for (int k = 0; k < 2; ++k) \
        acc[ai][bj][m][n] = __builtin_amdgcn_mfma_f32_16x16x32_bf16(Bt[n][k], At[m][k], acc[ai][bj][m][n], 0, 0, 0); __builtin_amdgcn_s_setprio(0); } while (0)
#define PG8_WAIT_V(n) asm volatile("s_waitcnt vmcnt(" #n ")" ::: "memory")
#define PG8_WAIT_L(n) asm volatile("s_waitcnt lgkmcnt(" #n ")" ::: "memory")
#define PG8_BAR __builtin_amdgcn_s_barrier()
#define PG8_SCHED __builtin_amdgcn_sched_barrier(0)
    Unit cur, nxt; int ui = 0;
    if (!S.next(0, cur)) return;
    f32x4 acc[2][2][4][2];
#pragma unroll
    for (int a = 0; a < 2; ++a)
#pragma unroll
        for (int b = 0; b < 2; ++b)
#pragma unroll
            for (int m = 0; m < 4; ++m)
#pragma unroll
                for (int n = 0; n < 2; ++n) acc[a][b][m][n] = (f32x4){0.f, 0.f, 0.f, 0.f};
    bf16x8 At[4][2], B0[2][2], B1[2][2];
    const char* cA = (const char*)g.A + (size_t)cur.pm * tstep; const char* cB = (const char*)g.Bt + (size_t)cur.pn * tstep;
    S.a_ready(cur);
    if constexpr (SP2) {
        PG8_STAGE(PG8_SB(0, 0), cB, voffB); PG8_STAGE(PG8_SB(0, 1), cB + hstepB, voffB); PG8_STAGE(PG8_SA(0, 0), cA, voffA); PG8_STAGE(PG8_SA(0, 1), cA + hstep, voffA);
        if (wr == 1) PG8_BAR;
        PG8_WAIT_V(2); PG8_BAR;
        PG8_STAGE(PG8_SB(1, 0), cB + kstep, voffB); PG8_STAGE(PG8_SA(1, 0), cA + kstep, voffA); PG8_STAGE(PG8_SB(1, 1), cB + hstepB + kstep, voffB);
        PG8_WAIT_V(6); PG8_BAR;
    } else {
        PG8_STAGE(PG8_SB(0, 0), cB, voffB); PG8_STAGE(PG8_SA(0, 0), cA, voffA); PG8_STAGE(PG8_SB(0, 1), cB + hstepB, voffB); PG8_STAGE(PG8_SA(0, 1), cA + hstep, voffA);
        if (wr == 1) PG8_BAR;
        PG8_WAIT_V(4); PG8_BAR;
        PG8_STAGE(PG8_SB(1, 0), cB + kstep, voffB); PG8_STAGE(PG8_SA(1, 0), cA + kstep, voffA); PG8_STAGE(PG8_SB(1, 1), cB + hstepB + kstep, voffB);
        PG8_WAIT_V(6); PG8_BAR;
    }
    for (;;) {
        const bool has_next = S.next(ui + 1, nxt);
        const char* nA = has_next ? (const char*)g.A + (size_t)nxt.pm * tstep : cA; const char* nB = has_next ? (const char*)g.Bt + (size_t)nxt.pn * tstep : cB;
        for (int t = 0; t < nt; t += 2) {
            if constexpr (Epi::HOOK) { if (t == Epi::HOOK_T0 || t == Epi::HOOK_T1) E.hook(acc, cur, t, wr, wc, fr, fq); }
            const bool last = (t == nt - 2);
            const char* a1 = cA + (size_t)(t + 1) * kstep;
            const char* a2 = last ? nA : cA + (size_t)(t + 2) * kstep; const char* b2 = last ? nB : cB + (size_t)(t + 2) * kstep;
            const char* a3 = a2 + kstep; const char* b3 = b2 + kstep;
            if (last && has_next) S.a_ready(nxt);
            if constexpr (SP2) {
            PG8_LDB(B0, 0, 0); PG8_LDB(B1, 0, 1); PG8_SCHED; PG8_LDA(At, 0, 0); PG8_STAGE(PG8_SA(1, 1), a1 + hstep, voffA);
            PG8_WAIT_V(8); PG8_WAIT_L(0); PG8_BAR; PG8_MMA(0, 0, At, B0); PG8_MMA(0, 1, At, B1); PG8_BAR; PG8_SCHED;
            PG8_LDA(At, 0, 1); PG8_STAGE(PG8_SB(0, 0), b2, voffB); PG8_STAGE(PG8_SB(0, 1), b2 + hstepB, voffB); PG8_STAGE(PG8_SA(0, 0), a2, voffA);
            PG8_WAIT_V(8); PG8_WAIT_L(0); PG8_BAR; PG8_MMA(1, 0, At, B0); PG8_MMA(1, 1, At, B1); PG8_BAR; PG8_SCHED;
            PG8_LDB(B0, 1, 0); PG8_LDB(B1, 1, 1); PG8_SCHED; PG8_LDA(At, 1, 0); PG8_STAGE(PG8_SA(0, 1), a2 + hstep, voffA);
            PG8_WAIT_V(8); PG8_WAIT_L(0); PG8_BAR; PG8_MMA(0, 0, At, B0); PG8_MMA(0, 1, At, B1); PG8_BAR; PG8_SCHED;
            PG8_LDA(At, 1, 1); PG8_STAGE(PG8_SB(1, 0), b3, voffB); PG8_STAGE(PG8_SB(1, 1), b3 + hstepB, voffB); PG8_STAGE(PG8_SA(1, 0), a3, voffA);
            PG8_WAIT_V(8); PG8_WAIT_L(0); PG8_BAR; PG8_MMA(1, 0, At, B0); PG8_MMA(1, 1, At, B1); PG8_BAR; PG8_SCHED;
            } else {
            PG8_LDB(B0, 0, 0); PG8_SCHED; PG8_LDA(At, 0, 0); PG8_STAGE(PG8_SA(1, 1), a1 + hstep, voffA);
            PG8_WAIT_L(8); PG8_BAR; PG8_WAIT_L(0); PG8_MMA(0, 0, At, B0); PG8_BAR; PG8_SCHED;
            PG8_LDB(B1, 0, 1); PG8_STAGE(PG8_SB(0, 0), b2, voffB);
            PG8_BAR; PG8_WAIT_L(0); PG8_MMA(0, 1, At, B1); PG8_BAR;
            PG8_LDA(At, 0, 1); PG8_STAGE(PG8_SA(0, 0), a2, voffA);
            PG8_BAR; PG8_WAIT_L(0); PG8_MMA(1, 0, At, B0); PG8_BAR; PG8_SCHED;
            PG8_STAGE(PG8_SB(0, 1), b2 + hstepB, voffB);
            PG8_WAIT_V(6); PG8_BAR; PG8_MMA(1, 1, At, B1); PG8_BAR;
            PG8_LDB(B0, 1, 0); PG8_SCHED; PG8_LDA(At, 1, 0); PG8_STAGE(PG8_SA(0, 1), a2 + hstep, voffA);
            PG8_WAIT_L(8); PG8_BAR; PG8_WAIT_L(0); PG8_MMA(0, 0, At, B0); PG8_BAR; PG8_SCHED;
            PG8_LDB(B1, 1, 1); PG8_STAGE(PG8_SB(1, 0), b3, voffB);
            PG8_BAR; PG8_WAIT_L(0); PG8_MMA(0, 1, At, B1); PG8_BAR;
            PG8_LDA(At, 1, 1); PG8_STAGE(PG8_SA(1, 0), a3, voffA);
            PG8_BAR; PG8_WAIT_L(0); PG8_MMA(1, 0, At, B0); PG8_BAR; PG8_SCHED;
            PG8_STAGE(PG8_SB(1, 1), b3 + hstepB, voffB);
            PG8_WAIT_V(6); PG8_BAR; PG8_MMA(1, 1, At, B1); PG8_BAR;
            }
        }
        if constexpr (ALIGN_EPI) { if (wr == 0) PG8_BAR; }
        if constexpr (!Epi::AFTER_DRAIN) { E(acc, cur, wr, wc, fr, fq); S.done(cur); }
        if (!has_next) break;
#pragma unroll
        for (int a = 0; a < 2; ++a)
#pragma unroll
            for (int b = 0; b < 2; ++b)
#pragma unroll
                for (int m = 0; m < 4; ++m)
#pragma unroll
                    for (int n = 0; n < 2; ++n) acc[a][b][m][n] = (f32x4){0.f, 0.f, 0.f, 0.f};
        cur = nxt; cA = nA; cB = nB; ++ui;
        if constexpr (ALIGN_EPI) { if (wr == 1) PG8_BAR; }
    }
    PG8_WAIT_V(0);
    if constexpr (!ALIGN_EPI) { if (wr == 0) PG8_BAR; }
    PG8_BAR;
    if constexpr (Epi::AFTER_DRAIN) { E.fused(acc, cur, wr, wc, fr, fq, lds, wid, lane); S.done(cur); }
#undef PG8_SA
#undef PG8_SB
#undef PG8_STAGE
#undef PG8_LDA
#undef PG8_LDB
#undef PG8_MMA
#undef PG8_WAIT_V
#undef PG8_WAIT_L
#undef PG8_BAR
#undef PG8_SCHED
}
}
#define LAS __attribute__((address_space(3)))
#define XB_TMO      128
#define XB_XCNT(j)  (256  + 64 * (j))
#define XB_XSUB(j)  (1280 + 64 * (j))
#define XB_XGEN(j)  (2304 + 64 * (j))
#define XB_TOP      3328
#define XB_TOPGEN   3392
#define XCD_BAR_WORDS 3456
#define XB_SPIN_CAP (1u << 23)

__device__ __forceinline__ unsigned xb_ld(unsigned* p)              { return __hip_atomic_load(p, __ATOMIC_RELAXED, __HIP_MEMORY_SCOPE_AGENT); }
__device__ __forceinline__ unsigned xb_add(unsigned* p, unsigned v) { return __hip_atomic_fetch_add(p, v, __ATOMIC_RELAXED, __HIP_MEMORY_SCOPE_AGENT); }
__device__ __forceinline__ unsigned xb_xcc_id() { return (unsigned)__builtin_amdgcn_s_getreg((3 << 11) | 20) & 0xFu; }
#define XB_SPIN(cond, bar) do { unsigned _sp = 0; while (cond) { __builtin_amdgcn_s_sleep(1); \
    if ((++_sp & 255u) == 0u) { if (xb_ld(&(bar)[XB_TMO])) break; if (_sp > XB_SPIN_CAP) { atomicAdd(&(bar)[XB_TMO], 1u); break; } } } } while (0)

struct XcdBarrier {
    unsigned* bar; unsigned x;
    volatile LAS unsigned* st;
};

__device__ __forceinline__ XcdBarrier xcd_barrier_post(unsigned* bar, volatile LAS unsigned* st) {
    XcdBarrier b; b.bar = bar; b.x = xb_xcc_id(); b.st = st;
    if (threadIdx.x == 0) (void)xb_add(&bar[XB_XCNT(b.x)], 1u);
    return b;
}
__device__ __forceinline__ void xcd_barrier_complete(unsigned* bar, unsigned x, unsigned& nloc, unsigned& nx) {
    const unsigned G = gridDim.x * gridDim.y * gridDim.z;
    unsigned sum, cnt, mine, sp = 0u;
    for (;;) {
        sum = 0u; cnt = 0u; mine = 0u;
#pragma unroll
        for (unsigned j = 0; j < 16; ++j) { const unsigned c = xb_ld(&bar[XB_XCNT(j)]); sum += c; cnt += (c > 0u) ? 1u : 0u; mine = (j == x) ? c : mine; }
        if (sum == G) break;
        __builtin_amdgcn_s_sleep(1);
        if ((++sp & 255u) == 0u) { if (xb_ld(&bar[XB_TMO])) break; if (sp > XB_SPIN_CAP) { atomicAdd(&bar[XB_TMO], 1u); break; } }
    }
    nloc = mine > 0u ? mine : 1u; nx = cnt > 0u ? cnt : 1u;
}

__device__ __attribute__((noinline)) void xcd_barrier(const XcdBarrier b) {
    asm volatile("s_waitcnt vmcnt(0)" ::: "memory");
    __syncthreads();
    if (threadIdx.x == 0) {
        unsigned* bar = b.bar;
        __builtin_amdgcn_s_waitcnt(0);
        unsigned nloc = b.st[0], nx = b.st[1];
        if (nloc == 0u) { xcd_barrier_complete(bar, b.x, nloc, nx); b.st[0] = nloc; b.st[1] = nx; }
        const unsigned old = xb_add(&bar[XB_XSUB(b.x)], 1u);
        const unsigned gen = old / nloc;
        if (old + 1u == (gen + 1u) * nloc) {
            __builtin_amdgcn_fence(__ATOMIC_RELEASE, "agent");
            asm volatile("s_waitcnt vmcnt(0)" ::: "memory");
            const unsigned og = xb_add(&bar[XB_TOP], 1u);
            const unsigned tg = og / nx;
            if (og + 1u == (tg + 1u) * nx) xb_add(&bar[XB_TOPGEN], 1u);
            else XB_SPIN(xb_ld(&bar[XB_TOPGEN]) == tg, bar);
            __builtin_amdgcn_fence(__ATOMIC_ACQUIRE, "agent");
            xb_add(&bar[XB_XGEN(b.x)], 1u);
            asm volatile("s_waitcnt vmcnt(0)" ::: "memory");
        } else {
            XB_SPIN(xb_ld(&bar[XB_XGEN(b.x)]) == gen, bar);
            __builtin_amdgcn_fence(__ATOMIC_ACQUIRE, "agent");
            asm volatile("s_waitcnt vmcnt(0)" ::: "memory");
        }
    }
    __syncthreads();
}
#define GAS __attribute__((address_space(1)))
#ifndef LAS
#define LAS __attribute__((address_space(3)))
#endif
typedef unsigned v4u __attribute__((ext_vector_type(4)));
typedef unsigned v2u __attribute__((ext_vector_type(2)));
typedef float f32x4 __attribute__((ext_vector_type(4)));
typedef short bf16x8 __attribute__((ext_vector_type(8)));
typedef _Float16 f16x2 __attribute__((ext_vector_type(2)));
typedef _Float16 f16x4 __attribute__((ext_vector_type(4)));
typedef _Float16 f16x8 __attribute__((ext_vector_type(8)));
#define LDS_WAIT() asm volatile("s_waitcnt lgkmcnt(0)" ::: "memory")
#define VM_WAIT() asm volatile("s_waitcnt vmcnt(0)" ::: "memory")

constexpr int NWAVES = 8, NTHR = 512;
constexpr int NIN = 5376;
constexpr size_t WS_CTL = 0, CTL_ZERO_BYTES = 64 * 1024;
constexpr size_t WS_W = 2 * MiB, W_LSTRIDE = 31 * MiB;
constexpr size_t WO_IN = 0, WO_C = WO_IN + (size_t)NIN * DM * 2, WO_A = WO_C + (size_t)DM * DCONV * 2, WO_P = WO_A + (size_t)DM * DATT * 2,
                 WO_O = WO_P + (size_t)DM * DPOOL * 2, WO_1 = WO_O + (size_t)DM * DM * 2, WO_2 = WO_1 + (size_t)DFF * DM * 2, WO_END = WO_2 + (size_t)DM * DFF * 2;
static_assert(WO_END <= W_LSTRIDE && WS_W + 2 * W_LSTRIDE <= WS_ROPE, "weight map");
constexpr size_t WS_SSQA = 900 * MiB, WS_SSQB = 902 * MiB, WS_SSQAS = 904 * MiB, WS_SSQBS = 905 * MiB;
constexpr int CW_BAR = 4096;
constexpr int RING_BYTES = 131072, LDSCTL_OFF = RING_BYTES, MISC_OFF = LDSCTL_OFF + 320, LDS_BYTES = 147456;
constexpr int RST_OFF = 132096;

__device__ __forceinline__ float fast_sigmoid(float x) { return __builtin_amdgcn_rcpf(1.f + __expf(-x)); }
typedef __bf16 bf16x2_t __attribute__((ext_vector_type(2)));
typedef float f32x2_t __attribute__((ext_vector_type(2)));
__device__ __forceinline__ unsigned pk_bf16(float lo, float hi) { const f32x2_t v = {lo, hi}; const bf16x2_t b = __builtin_convertvector(v, bf16x2_t); return __builtin_bit_cast(unsigned, b); }
__device__ __forceinline__ unsigned pk_f16(float lo, float hi) { f16x2 v = {(_Float16)lo, (_Float16)hi}; return __builtin_bit_cast(unsigned, v); }
__device__ __forceinline__ float wave_sum(float v) {
#pragma unroll
    for (int o = 1; o < 64; o <<= 1) v += __shfl_xor(v, o);
    return v;
}


__device__ __forceinline__ float row_ms_inv(const unsigned char* ws, size_t off_p, size_t off_s, unsigned row) {
    float s = 0.f;
    if (row < (unsigned)MP) { const f32x4* p = (const f32x4*)(ws + off_p) + (size_t)row * 4;
#pragma unroll
        for (int j = 0; j < 4; ++j) { const f32x4 v = p[j]; s += (v.x + v.y) + (v.z + v.w); } }
    else { const f32x4* p = (const f32x4*)(ws + off_s) + (size_t)(row - MP) * 16;
#pragma unroll
        for (int j = 0; j < 16; ++j) { const f32x4 v = p[j]; s += (v.x + v.y) + (v.z + v.w); } }
    return 1.f / (s * (1.f / DM) + RMS_EPS);
}

__host__ __device__ __forceinline__ int rope_perm(int d) { return 8 * ((d & 31) >> 2) + 4 * (d >> 5) + (d & 3); }
__host__ __device__ __forceinline__ int win_row(int n) {
    if (n < C_AGATE) { return 256 * (n >> 7) + 8 * ((n & 127) >> 2) + (n & 3); }
    if (n < C_Q) { int c = n - C_AGATE; return 256 * (c >> 7) + 8 * ((c & 127) >> 2) + 4 + (c & 3); }
    if (n < C_K) { int i = n - C_Q, hh = i >> 6; return 256 * (2 + (hh >> 2)) + 64 * (hh & 3) + rope_perm(i & 63); }
    if (n < C_V) { int i = n - C_K; return 256 * 4 + 64 * (i >> 6) + rope_perm(i & 63); }
    if (n < C_QI) { return 256 * 4 + 128 + (n - C_V); }
    if (n < C_KI) { int i = n - C_QI, hh = i >> 6; return 256 * (5 + (hh >> 2)) + 64 * (hh & 3) + rope_perm(i & 63); }
    if (n < C_WI) { return 256 * 7 + rope_perm(n - C_KI); }
    if (n < C_XC) { return 256 * 7 + 64 + (n - C_WI); }
    if (n < C_G) { return 256 * 8 + (n - C_XC); }
    return 256 * 9 + (n - C_G);
}

struct EpiRelu2 {
    static constexpr bool PERM = true, AFTER_DRAIN = false, HOOK = false, COLMAP2 = true; static constexpr int HOOK_T0 = -1, HOOK_T1 = -1; bf16_t* O; int ldc; const LAS float* rst;
    __device__ __forceinline__ void operator()(const pg8::f32x4 (&acc)[2][2][4][2], const pg8::Unit& u, int wr, int wc, int fr, int fq) const {
        asm volatile("" : "+v"(fr), "+v"(fq), "+s"(wr), "+s"(wc));
#pragma unroll
        for (int ai = 0; ai < 2; ++ai)
#pragma unroll
            for (int m = 0; m < 4; ++m) { const unsigned row = (unsigned)(u.pm * 256 + ai * 128 + wr * 64 + m * 16 + fr); bf16_t* rowp = O + (size_t)row * ldc + u.pn * 256 + wc * 64 + 8 * fq;
                const float r2 = rst[u.idx * 256 + ai * 128 + wr * 64 + m * 16 + fr];
#pragma unroll
                for (int bj = 0; bj < 2; ++bj) { pg8::f32x4 a = acc[ai][bj][m][0], b = acc[ai][bj][m][1]; float r[8];
#pragma unroll
                    for (int e = 0; e < 4; ++e) { float x = fmaxf(a[e], 0.f), y = fmaxf(b[e], 0.f); r[e] = x * x * r2; r[4 + e] = y * y * r2; }
                    v4u w; w.x = pk_bf16(r[0], r[1]); w.y = pk_bf16(r[2], r[3]); w.z = pk_bf16(r[4], r[5]); w.w = pk_bf16(r[6], r[7]);
                    *(v4u*)(rowp + bj * 32) = w; } }
    }
};
struct EpiResid {
    static constexpr bool PERM = true, AFTER_DRAIN = false, HOOK = false, COLMAP2 = true; static constexpr int HOOK_T0 = -1, HOOK_T1 = -1; bf16_t* H; float* SSQ;
    __device__ __forceinline__ void operator()(const pg8::f32x4 (&acc)[2][2][4][2], const pg8::Unit& u, int wr, int wc, int fr, int fq) const {
        asm volatile("" : "+v"(fr), "+v"(fq), "+s"(wr), "+s"(wc));
#pragma unroll
        for (int ai = 0; ai < 2; ++ai)
#pragma unroll
            for (int m = 0; m < 4; ++m) { const size_t row = (size_t)(u.pm * 256 + ai * 128 + wr * 64 + m * 16 + fr); const int col = u.pn * 256 + wc * 64 + 8 * fq; float ss = 0.f;
#pragma unroll
                for (int bj = 0; bj < 2; ++bj) { v4u* p = (v4u*)(H + row * DM + col + bj * 32); const v4u h = *p; const pg8::f32x4 a = acc[ai][bj][m][0], b = acc[ai][bj][m][1];
                    const float o0 = __uint_as_float(h.x << 16) + a[0], o1 = __uint_as_float(h.x & 0xffff0000u) + a[1], o2 = __uint_as_float(h.y << 16) + a[2], o3 = __uint_as_float(h.y & 0xffff0000u) + a[3];
                    const float o4 = __uint_as_float(h.z << 16) + b[0], o5 = __uint_as_float(h.z & 0xffff0000u) + b[1], o6 = __uint_as_float(h.w << 16) + b[2], o7 = __uint_as_float(h.w & 0xffff0000u) + b[3];
                    ss += ((o0 * o0 + o1 * o1) + (o2 * o2 + o3 * o3)) + ((o4 * o4 + o5 * o5) + (o6 * o6 + o7 * o7));
                    v4u w; w.x = pk_bf16(o0, o1); w.y = pk_bf16(o2, o3); w.z = pk_bf16(o4, o5); w.w = pk_bf16(o6, o7);
                    *p = w; }
                ss += __shfl_xor(ss, 16); ss += __shfl_xor(ss, 32);
                if (fq == 0) SSQ[row * 16 + u.pn * 4 + wc] = ss;
                if (m == 3) asm volatile("" ::: "memory"); }
    }
};
struct EpiGate {
    static constexpr bool PERM = true, AFTER_DRAIN = false, HOOK = true, COLMAP2 = true; static constexpr int HOOK_T0 = 4, HOOK_T1 = 12;
    bf16_t* MBp; const _Float16* G;
    __device__ __forceinline__ void hook(pg8::f32x4 (&acc)[2][2][4][2], const pg8::Unit& u, int t, int wr, int wc, int fr, int fq) const {
        asm volatile("" : "+v"(fr), "+v"(fq), "+s"(wr), "+s"(wc));
        const int br = t == HOOK_T0 ? 0 : 1;
#pragma unroll
        for (int ai = 0; ai < 2; ++ai)
#pragma unroll
            for (int m = 0; m < 4; ++m) { const size_t row = (size_t)(u.pm * 256 + ai * 128 + wr * 64 + m * 16 + fr); const int col = u.pn * 256 + wc * 64 + 8 * fq;
#pragma unroll
                for (int bj = 0; bj < 2; ++bj) { const _Float16* gp = G + row * 3072 + 1024 * br + col + bj * 32;
                    const f16x8 gn = *(const f16x8*)gp, gd = *(const f16x8*)(gp + 1024);
#pragma unroll
                    for (int e = 0; e < 4; ++e) { acc[ai][bj][m][0][e] *= (float)gn[e] * __builtin_amdgcn_rcpf(fmaxf((float)gd[e], 1e-7f)); acc[ai][bj][m][1][e] *= (float)gn[4 + e] * __builtin_amdgcn_rcpf(fmaxf((float)gd[4 + e], 1e-7f)); } }
                if (m == 3) asm volatile("" ::: "memory"); }
    }
    __device__ __forceinline__ void operator()(const pg8::f32x4 (&acc)[2][2][4][2], const pg8::Unit& u, int wr, int wc, int fr, int fq) const {
        asm volatile("" : "+v"(fr), "+v"(fq), "+s"(wr), "+s"(wc));
#pragma unroll
        for (int ai = 0; ai < 2; ++ai)
#pragma unroll
            for (int m = 0; m < 4; ++m) { const size_t row = (size_t)(u.pm * 256 + ai * 128 + wr * 64 + m * 16 + fr); const int col = u.pn * 256 + wc * 64 + 8 * fq;
#pragma unroll
                for (int bj = 0; bj < 2; ++bj) { pg8::f32x4 a = acc[ai][bj][m][0], b = acc[ai][bj][m][1];
                    const f16x8 gv = *(const f16x8*)(G + row * 3072 + 2048 + col + bj * 32); float r[8];
#pragma unroll
                    for (int e = 0; e < 4; ++e) { r[e] = (float)gv[e] * a[e]; r[4 + e] = (float)gv[4 + e] * b[e]; }
                    v4u w; w.x = pk_bf16(r[0], r[1]); w.y = pk_bf16(r[2], r[3]); w.z = pk_bf16(r[4], r[5]); w.w = pk_bf16(r[6], r[7]);
                    *(v4u*)(MBp + row * DM + col + bj * 32) = w; }
                if (m == 3) asm volatile("" ::: "memory"); }
    }
};
struct EpiNull {
    static constexpr bool PERM = true, AFTER_DRAIN = false, HOOK = false, COLMAP2 = false; static constexpr int HOOK_T0 = -1, HOOK_T1 = -1; float* sink;
    __device__ __forceinline__ void operator()(const pg8::f32x4 (&acc)[2][2][4][2], const pg8::Unit& u, int wr, int wc, int fr, int fq) const {
        float s = 0.f;
#pragma unroll
        for (int ai = 0; ai < 2; ++ai)
#pragma unroll
            for (int bj = 0; bj < 2; ++bj)
#pragma unroll
                for (int m = 0; m < 4; ++m) s += acc[ai][bj][m][0][0] + acc[ai][bj][m][1][3];
        if (s == 1234.5678f) sink[0] = s;
    }
};
struct EpiInproj {
    static constexpr bool PERM = true, AFTER_DRAIN = false, HOOK = false, COLMAP2 = false; static constexpr int HOOK_T0 = -1, HOOK_T1 = -1; unsigned char* ws; unsigned char* outb; int layer; const LAS float* rst;
    __device__ __forceinline__ void operator()(const pg8::f32x4 (&acc)[2][2][4][2], const pg8::Unit& u, int wr, int wc, int fr, int fq) const {
        const int pn = u.pn; const bool smp = (u.pm == MP / 256);
        asm volatile("" : "+v"(fr), "+v"(fq), "+s"(wr), "+s"(wc));
#pragma unroll
        for (int ai = 0; ai < 2; ++ai)
#pragma unroll
            for (int m = 0; m < 4; ++m) {
                const unsigned row = (unsigned)(u.pm * 256 + ai * 128 + wr * 64 + m * 16 + fr);
                const unsigned orow = smp ? (unsigned)layer * MS + (row - MP) : (unsigned)layer * MP + row;
                const float rsc = rst[u.idx * 256 + ai * 128 + wr * 64 + m * 16 + fr];
#pragma unroll
                for (int bj = 0; bj < 2; ++bj) {
                    const pg8::f32x4 a = acc[ai][bj][m][0] * rsc, b = acc[ai][bj][m][1] * rsc;
                    const unsigned cb = 128 * bj + 32 * wc + 8 * fq;
                    if (pn < 2) {
                        f32x4 o; o.x = a[0] * fast_sigmoid(b[0]); o.y = a[1] * fast_sigmoid(b[1]); o.z = a[2] * fast_sigmoid(b[2]); o.w = a[3] * fast_sigmoid(b[3]);
                        *(f32x4*)(ws + (unsigned)(WS_U + (row * 256u + 128u * pn + (cb >> 1)) * 4u)) = o;
                    } else if (pn == 8) {
                        const unsigned off = (unsigned)(WS_XC + (row * 256u + cb) * 4u);
                        *(f32x4*)(ws + off) = (f32x4){a[0], a[1], a[2], a[3]}; *(f32x4*)(ws + off + 16u) = (f32x4){b[0], b[1], b[2], b[3]};
                    } else if (pn >= 9) {
                        v4u w; w.x = pk_f16(fast_sigmoid(a[0]), fast_sigmoid(a[1])); w.y = pk_f16(fast_sigmoid(a[2]), fast_sigmoid(a[3]));
                        w.z = pk_f16(fast_sigmoid(b[0]), fast_sigmoid(b[1])); w.w = pk_f16(fast_sigmoid(b[2]), fast_sigmoid(b[3]));
                        __builtin_nontemporal_store(w, (v4u*)(ws + (unsigned)(WS_G + (row * 3072u + 256u * (pn - 9) + cb) * 2u)));
                    } else if (pn == 4 && bj == 1) {
                        const unsigned idx = cb - 128u; v4u w; w.x = pk_bf16(a[0], a[1]); w.y = pk_bf16(a[2], a[3]); w.z = pk_bf16(b[0], b[1]); w.w = pk_bf16(b[2], b[3]);
                        *(v4u*)(ws + (unsigned)(WS_KV + (row * 256u + 128u + idx) * 2u)) = w;
                        const unsigned oo = (unsigned)(((smp ? O_VS : O_VP) + (size_t)orow * KVD + idx) * 4u);
                        *(f32x4*)(outb + oo) = (f32x4){a[0], a[1], a[2], a[3]}; *(f32x4*)(outb + oo + 16u) = (f32x4){b[0], b[1], b[2], b[3]};
                    } else if (pn == 7 && (bj == 1 || wc >= 2)) {
                        if (bj == 0 && wc == 2 && fq == 0) { const unsigned off = (unsigned)(WS_WI + row * 32u);
                            *(f32x4*)(ws + off) = (f32x4){a[0] * WI_SCALE, a[1] * WI_SCALE, a[2] * WI_SCALE, a[3] * WI_SCALE};
                            *(f32x4*)(ws + off + 16u) = (f32x4){b[0] * WI_SCALE, b[1] * WI_SCALE, b[2] * WI_SCALE, b[3] * WI_SCALE}; }
                    } else {
                        const unsigned rr = smp ? T + (row & (ST - 1)) : (row & (T - 1)); const unsigned d0 = (cb & 56u) >> 1, hl = cb >> 6;
                        const unsigned roff = (unsigned)(WS_ROPE + (rr * 32u + d0) * 4u);
                        const f32x4 c4 = *(const f32x4*)(ws + roff), s4 = *(const f32x4*)(ws + roff + (unsigned)((T + ST) * 32 * 4));
                        float o1[4], o2[4];
#pragma unroll
                        for (int e = 0; e < 4; ++e) { o1[e] = a[e] * c4[e] - b[e] * s4[e]; o2[e] = b[e] * c4[e] + a[e] * s4[e]; }
                        unsigned dst; float sc = 1.f; unsigned of = 0u;
                        if (pn < 4) { dst = (unsigned)(WS_QB + (row * 512u + 64u * (4u * (pn - 2) + hl) + d0) * 2u); sc = 0.125f; }
                        else if (pn == 4) { dst = (unsigned)(WS_KV + (row * 256u + 64u * hl + d0) * 2u); of = (unsigned)(((smp ? O_KS : O_KP) + (size_t)orow * KVD + 64u * hl + d0) * 4u); }
                        else if (pn < 7) { dst = (unsigned)(WS_QI + (row * 512u + 64u * (4u * (pn - 5) + hl) + d0) * 2u); }
                        else { dst = (unsigned)(WS_KI + (row * 64u + d0) * 2u); of = (unsigned)(((smp ? O_KIS : O_KIP) + (size_t)orow * ID + d0) * 4u); }
                        v2u w1, w2; w1.x = pk_bf16(o1[0] * sc, o1[1] * sc); w1.y = pk_bf16(o1[2] * sc, o1[3] * sc); w2.x = pk_bf16(o2[0] * sc, o2[1] * sc); w2.y = pk_bf16(o2[2] * sc, o2[3] * sc);
                        *(v2u*)(ws + dst) = w1; *(v2u*)(ws + dst + 64u) = w2;
                        if (pn == 4 || pn == 7) { *(f32x4*)(outb + of) = (f32x4){o1[0], o1[1], o1[2], o1[3]}; *(f32x4*)(outb + of + 128u) = (f32x4){o2[0], o2[1], o2[2], o2[3]}; }
                    }
                }
                if (m == 3) asm volatile("" ::: "memory");
            }
    }
};

__device__ __forceinline__ f32x4 sg_tile(const bf16_t* A, int lda, const bf16_t* Bt, int K, int mt, int nt, int lane, int ldb = 0) {
    const bf16_t* ap = A + (size_t)(16 * mt + (lane & 15)) * lda + 8 * (lane >> 4);
    const bf16_t* bp = Bt + (size_t)(16 * nt + (lane & 15)) * (ldb ? ldb : K) + 8 * (lane >> 4);
    f32x4 acc = {0.f, 0.f, 0.f, 0.f};
    if (K >= 512) {
#pragma unroll 1
        for (int k = 0; k < K; k += 512) { bf16x8 a[16], b[16];
#pragma unroll
            for (int i = 0; i < 16; ++i) { a[i] = *(const bf16x8*)(ap + k + 32 * i); b[i] = *(const bf16x8*)(bp + k + 32 * i); }
#pragma unroll
            for (int i = 0; i < 16; ++i) acc = __builtin_amdgcn_mfma_f32_16x16x32_bf16(b[i], a[i], acc, 0, 0, 0); }
    } else {
#pragma unroll 1
        for (int k = 0; k < K; k += 256) { bf16x8 a[8], b[8];
#pragma unroll
            for (int i = 0; i < 8; ++i) { a[i] = *(const bf16x8*)(ap + k + 32 * i); b[i] = *(const bf16x8*)(bp + k + 32 * i); }
#pragma unroll
            for (int i = 0; i < 8; ++i) acc = __builtin_amdgcn_mfma_f32_16x16x32_bf16(b[i], a[i], acc, 0, 0, 0); }
    }
    return acc;
}

template <bool MAPPED>
__device__ __forceinline__ void transpose_item(const float* W, int K, int N, bf16_t* WT, LAS float* scr, int item, int lane, const float* gain = nullptr, int ldt = 0, int koff = 0) {
    const int nblk = (N + 31) / 32, kb = item / nblk, nb = item % nblk, k0 = 64 * kb, n0 = 32 * nb; const int nn = n0 + (lane & 31);
    (void)nn;
    f32x4 wv[8];
    const int np = n0 + 4 * (lane & 7);
#pragma unroll
    for (int i = 0; i < 8; ++i) { const int kk = 8 * i + (lane >> 3); wv[i] = np < N ? *(const f32x4*)(W + (size_t)(k0 + kk) * N + np) : (f32x4){0.f, 0.f, 0.f, 0.f}; }
#pragma unroll
    for (int i = 0; i < 8; ++i) { const int kk = 8 * i + (lane >> 3); f32x4 v = wv[i]; if (gain) { const float gk = gain[k0 + kk]; v.x *= gk; v.y *= gk; v.z *= gk; v.w *= gk; }
        LAS float* d = scr + kk * 33 + 4 * (lane & 7); d[0] = v.x; d[1] = v.y; d[2] = v.z; d[3] = v.w; }
    LDS_WAIT(); asm volatile("" ::: "memory");
    const int c = lane & 7;
#pragma unroll
    for (int j = 0; j < 4; ++j) { const int nl = (lane >> 3) + 8 * j, n = n0 + nl; const LAS float* s = scr + (8 * c) * 33 + nl;
        v4u o; o.x = pk_bf16(s[0 * 33], s[1 * 33]); o.y = pk_bf16(s[2 * 33], s[3 * 33]); o.z = pk_bf16(s[4 * 33], s[5 * 33]); o.w = pk_bf16(s[6 * 33], s[7 * 33]);
        if (n < N) { const int r = MAPPED ? win_row(n) : n; *(v4u*)(WT + (size_t)r * (ldt ? ldt : K) + koff + k0 + 8 * c) = o; } }
    LDS_WAIT(); asm volatile("" ::: "memory");
}
__device__ __forceinline__ void rms_row(const float* xrow, const float* g, float* xcopy, bf16_t* hout, float* yout, int lane) {
    const f32x4* xr = (const f32x4*)xrow + lane; f32x4 v[4]; float s = 0.f;
#pragma unroll
    for (int j = 0; j < 4; ++j) { v[j] = xr[64 * j]; s += (v[j].x * v[j].x + v[j].y * v[j].y) + (v[j].z * v[j].z + v[j].w * v[j].w); }
    const float r = 1.f / sqrtf(wave_sum(s) * (1.f / DM) + RMS_EPS);
#pragma unroll
    for (int j = 0; j < 4; ++j) { const f32x4 gg = *((const f32x4*)g + lane + 64 * j);
        if (xcopy) *((f32x4*)xcopy + lane + 64 * j) = v[j];
        f32x4 y; y.x = v[j].x * r * gg.x; y.y = v[j].y * r * gg.y; y.z = v[j].z * r * gg.z; y.w = v[j].w * r * gg.w;
        if (hout) { v2u w; w.x = pk_bf16(y.x, y.y); w.y = pk_bf16(y.z, y.w); *((v2u*)hout + lane + 64 * j) = w; }
        if (yout) *((f32x4*)yout + lane + 64 * j) = y; }
}

__device__ __forceinline__ void rms_row_bf(const bf16_t* hrow, const float* g, float* yout, int lane) {
    float v[16]; float s = 0.f;
#pragma unroll
    for (int j = 0; j < 2; ++j) { const v4u h = *((const v4u*)hrow + lane + 64 * j);
        v[8 * j + 0] = __uint_as_float(h.x << 16); v[8 * j + 1] = __uint_as_float(h.x & 0xffff0000u); v[8 * j + 2] = __uint_as_float(h.y << 16); v[8 * j + 3] = __uint_as_float(h.y & 0xffff0000u);
        v[8 * j + 4] = __uint_as_float(h.z << 16); v[8 * j + 5] = __uint_as_float(h.z & 0xffff0000u); v[8 * j + 6] = __uint_as_float(h.w << 16); v[8 * j + 7] = __uint_as_float(h.w & 0xffff0000u); }
#pragma unroll
    for (int e = 0; e < 16; ++e) s += v[e] * v[e];
    const float r = 1.f / sqrtf(wave_sum(s) * (1.f / DM) + RMS_EPS);
#pragma unroll
    for (int j = 0; j < 2; ++j) { const f32x4 g0 = *((const f32x4*)g + 2 * lane + 128 * j), g1 = *((const f32x4*)g + 2 * lane + 128 * j + 1);
        f32x4 y0, y1; y0.x = v[8 * j + 0] * r * g0.x; y0.y = v[8 * j + 1] * r * g0.y; y0.z = v[8 * j + 2] * r * g0.z; y0.w = v[8 * j + 3] * r * g0.w;
        y1.x = v[8 * j + 4] * r * g1.x; y1.y = v[8 * j + 5] * r * g1.y; y1.z = v[8 * j + 6] * r * g1.z; y1.w = v[8 * j + 7] * r * g1.w;
        *((f32x4*)yout + 2 * lane + 128 * j) = y0; *((f32x4*)yout + 2 * lane + 128 * j + 1) = y1; }
}
__device__ __forceinline__ void prep_row(const float* xrow, bf16_t* hout, float* ssq, int nslot, int lane) {
    const f32x4* xr = (const f32x4*)xrow + lane; float s = 0.f;
#pragma unroll
    for (int j = 0; j < 4; ++j) { const f32x4 v = xr[64 * j]; s += (v.x * v.x + v.y * v.y) + (v.z * v.z + v.w * v.w);
        v2u w; w.x = pk_bf16(v.x, v.y); w.y = pk_bf16(v.z, v.w); *((v2u*)hout + lane + 64 * j) = w; }
    s = wave_sum(s);
    if (lane < nslot) ssq[lane] = lane == 0 ? s : 0.f;
}

__device__ __forceinline__ void rms_row_bf2(const bf16_t* ha, float* ya, const bf16_t* hb, float* yb, bool has_b, const float* g, int lane) {
    v4u ra[2], rb[2];
#pragma unroll
    for (int j = 0; j < 2; ++j) ra[j] = *((const v4u*)ha + lane + 64 * j);
#pragma unroll
    for (int j = 0; j < 2; ++j) rb[j] = has_b ? *((const v4u*)hb + lane + 64 * j) : (v4u){0u, 0u, 0u, 0u};
    f32x4 gg[4];
#pragma unroll
    for (int j = 0; j < 2; ++j) { gg[2 * j] = *((const f32x4*)g + 2 * lane + 128 * j); gg[2 * j + 1] = *((const f32x4*)g + 2 * lane + 128 * j + 1); }
#pragma unroll
    for (int rw = 0; rw < 2; ++rw) { if (rw == 1 && !has_b) break;
        float v[16]; float s = 0.f;
#pragma unroll
        for (int j = 0; j < 2; ++j) { const v4u h = rw ? rb[j] : ra[j];
            v[8 * j + 0] = __uint_as_float(h.x << 16); v[8 * j + 1] = __uint_as_float(h.x & 0xffff0000u); v[8 * j + 2] = __uint_as_float(h.y << 16); v[8 * j + 3] = __uint_as_float(h.y & 0xffff0000u);
            v[8 * j + 4] = __uint_as_float(h.z << 16); v[8 * j + 5] = __uint_as_float(h.z & 0xffff0000u); v[8 * j + 6] = __uint_as_float(h.w << 16); v[8 * j + 7] = __uint_as_float(h.w & 0xffff0000u); }
#pragma unroll
        for (int e = 0; e < 16; ++e) s += v[e] * v[e];
        const float r = 1.f / sqrtf(wave_sum(s) * (1.f / DM) + RMS_EPS);
        float* yout = rw ? yb : ya;
#pragma unroll
        for (int j = 0; j < 2; ++j) { const f32x4 g0 = gg[2 * j], g1 = gg[2 * j + 1];
            f32x4 y0, y1; y0.x = v[8 * j + 0] * r * g0.x; y0.y = v[8 * j + 1] * r * g0.y; y0.z = v[8 * j + 2] * r * g0.z; y0.w = v[8 * j + 3] * r * g0.w;
            y1.x = v[8 * j + 4] * r * g1.x; y1.y = v[8 * j + 5] * r * g1.y; y1.z = v[8 * j + 6] * r * g1.z; y1.w = v[8 * j + 7] * r * g1.w;
            *((f32x4*)yout + 2 * lane + 128 * j) = y0; *((f32x4*)yout + 2 * lane + 128 * j + 1) = y1; } }
}
__device__ __forceinline__ void prep_row2(const float* xa, bf16_t* ha, float* sa, int na, const float* xb, bf16_t* hb, float* sb, int nb, bool has_b, int lane) {
    f32x4 va[4], vb[4];
#pragma unroll
    for (int j = 0; j < 4; ++j) va[j] = *((const f32x4*)xa + lane + 64 * j);
#pragma unroll
    for (int j = 0; j < 4; ++j) vb[j] = has_b ? *((const f32x4*)xb + lane + 64 * j) : (f32x4){0.f, 0.f, 0.f, 0.f};
    float s = 0.f, t = 0.f;
#pragma unroll
    for (int j = 0; j < 4; ++j) { const f32x4 v = va[j]; s += (v.x * v.x + v.y * v.y) + (v.z * v.z + v.w * v.w);
        v2u w; w.x = pk_bf16(v.x, v.y); w.y = pk_bf16(v.z, v.w); *((v2u*)ha + lane + 64 * j) = w; }
    s = wave_sum(s);
    if (lane < na) sa[lane] = lane == 0 ? s : 0.f;
    if (has_b) {
#pragma unroll
        for (int j = 0; j < 4; ++j) { const f32x4 v = vb[j]; t += (v.x * v.x + v.y * v.y) + (v.z * v.z + v.w * v.w);
            v2u w; w.x = pk_bf16(v.x, v.y); w.y = pk_bf16(v.z, v.w); *((v2u*)hb + lane + 64 * j) = w; }
        t = wave_sum(t);
        if (lane < nb) sb[lane] = lane == 0 ? t : 0.f; }
}

struct Args { const float* in[24]; float* out; unsigned char* ws; int ph_lo, ph_hi; };
typedef float f32x16 __attribute__((ext_vector_type(16)));
struct P2Args { const float* state_conv; const float* state_pool; const float* conv_w; const float* conv_b; const float* ln_g; const float* ln_b; const float* cache_kidx; const int* page_table; };

__device__ __forceinline__ void conv_task(const Bufs& B, const P2Args& P, int layer, int task, int lane, const LAS float* wl  ) {
    const bool smp = task >= MP / 8; const int b = smp ? task - MP / 8 : task / (T / 8); const int t0 = smp ? 0 : (task % (T / 8)) * 8; const int row0 = smp ? MP + b * ST : b * T;
    const f32x4 bias = *((const f32x4*)(P.conv_b + layer * DCONV) + lane);
    f32x4 acc[8];
#pragma unroll
    for (int i = 0; i < 8; ++i) acc[i] = bias;
#define CONV_LOADROW(dst, r_) do { const int r__ = (r_), tau__ = t0 - 30 + r__; (dst) = (f32x4){0.f, 0.f, 0.f, 0.f}; \
        if (r__ < 38) { if (tau__ >= 0) (dst) = *((const f32x4*)(B.U + (size_t)(row0 + tau__) * 256) + lane); \
            else if (smp) (dst) = *((const f32x4*)(P.state_conv + (((size_t)layer * SB + b) * CHIST + (30 + tau__)) * DCONV) + lane); } } while (0)
    f32x4 xa[4], xb[4], xd[4];
#pragma unroll
    for (int rr = 0; rr < 4; ++rr) CONV_LOADROW(xa[rr], rr);
#pragma unroll
    for (int rr = 0; rr < 4; ++rr) CONV_LOADROW(xb[rr], 4 + rr);
#define CONV_GROUP(XC, XL, r0_) do { const int r0 = (r0_); asm volatile("" ::: "memory");       \
        _Pragma("unroll") for (int rr = 0; rr < 4; ++rr) CONV_LOADROW(XL[rr], r0 + 8 + rr); \
        asm volatile("" ::: "memory"); \
        const LAS f32x4* wb = (const LAS f32x4*)(wl + (r0 + 8) * DCONV) + lane;       \
        _Pragma("unroll") for (int rr = 0; rr < 4; ++rr) { \
            _Pragma("unroll") for (int i = 0; i < 8; ++i) { const f32x4 w = wb[(rr - i) * (DCONV / 4)]; \
                acc[i].x += w.x * XC[rr].x; acc[i].y += w.y * XC[rr].y; acc[i].z += w.z * XC[rr].z; acc[i].w += w.w * XC[rr].w; } } } while (0)
#pragma nounroll
    for (int rg = 0; rg < 36; rg += 12) {
        CONV_GROUP(xa, xd, rg);
        CONV_GROUP(xb, xa, rg + 4);
        CONV_GROUP(xd, xb, rg + 8);
    }
    CONV_GROUP(xa, xd, 36);
#undef CONV_GROUP
#undef CONV_LOADROW
    const f32x4 lg = *((const f32x4*)(P.ln_g + layer * DCONV) + lane), lb = *((const f32x4*)(P.ln_b + layer * DCONV) + lane);
#pragma unroll
    for (int i = 0; i < 8; ++i) {
        const float mu = wave_sum((acc[i].x + acc[i].y) + (acc[i].z + acc[i].w)) * (1.f / 256);
        const f32x4 d = {acc[i].x - mu, acc[i].y - mu, acc[i].z - mu, acc[i].w - mu};
        const float var = wave_sum((d.x * d.x + d.y * d.y) + (d.z * d.z + d.w * d.w)) * (1.f / 256);
        const float rs = 1.f / sqrtf(var + LN_EPS);
        float y0 = d.x * rs * lg.x + lb.x, y1 = d.y * rs * lg.y + lb.y, y2 = d.z * rs * lg.z + lb.z, y3 = d.w * rs * lg.w + lb.w;
        y0 *= fast_sigmoid(y0); y1 *= fast_sigmoid(y1); y2 *= fast_sigmoid(y2); y3 *= fast_sigmoid(y3);
        v2u w; w.x = pk_bf16(y0, y1); w.y = pk_bf16(y2, y3);
        *((v2u*)(B.CA + (size_t)(row0 + t0 + i) * DM) + lane) = w; }
}
__device__ __forceinline__ void pool_task(const Bufs& B, const P2Args& P, int layer, int task, int lane) {
    const bool smp = task >= MP / 8; const int b = smp ? task - MP / 8 : task / (T / 8); const int t0 = smp ? 0 : (task % (T / 8)) * 8; const int row0 = smp ? MP + b * ST : b * T;
    f32x4 cs[24];
    f32x4 xr[8];
    cs[0] = (f32x4){0.f, 0.f, 0.f, 0.f};
#pragma unroll
    for (int r = 0; r < 23; ++r) { const int tau = t0 - 15 + r; f32x4 v;
        if (tau >= 0) v = *((const f32x4*)(B.XC + (size_t)(row0 + tau) * 256) + lane);
        else if (smp) v = *((const f32x4*)(P.state_pool + (((size_t)layer * SB + b) * PHIST + (15 + tau)) * DPOOL) + lane);
        else v = (f32x4){0.f, 0.f, 0.f, 0.f};
        cs[r + 1] = (f32x4){cs[r].x + v.x, cs[r].y + v.y, cs[r].z + v.z, cs[r].w + v.w}; if (r >= 15) xr[r - 15] = v; }
    const int g = lane >> 4, w = 2 << g;
#pragma unroll
    for (int i = 0; i < 8; ++i) {
        const f32x4 s2 = cs[14 + i], s4 = cs[12 + i], s8 = cs[8 + i], s16 = cs[i];
        const f32x4 st = g == 0 ? s2 : (g == 1 ? s4 : (g == 2 ? s8 : s16)); const f32x4 e = cs[16 + i];
        const int t = t0 + i; const float cnt = smp ? (float)w : (float)((t + 1) < w ? (t + 1) : w); const float ic = 1.f / cnt;
        v2u o; o.x = pk_bf16((e.x - st.x) * ic - xr[i].x, (e.y - st.y) * ic - xr[i].y); o.y = pk_bf16((e.z - st.z) * ic - xr[i].z, (e.w - st.w) * ic - xr[i].w);
        *((v2u*)(B.CA + (size_t)(row0 + t) * DM + (DCONV + DATT)) + lane) = o; }
}
__device__ __forceinline__ void states_task(const Bufs& B, const P2Args& P, int layer, int i, int lane) {
    const float* src; float* dst;
    if (i < NB * 30) { const int b = i / 30, r = i % 30; dst = B.out + O_CP + (((size_t)layer * NB + b) * CHIST + r) * DCONV; src = B.U + (size_t)(b * T + T - 30 + r) * 256; }
    else if ((i -= NB * 30) < NB * 15) { const int b = i / 15, r = i % 15; dst = B.out + O_PP + (((size_t)layer * NB + b) * PHIST + r) * DPOOL; src = B.XC + (size_t)(b * T + T - 15 + r) * 256; }
    else if ((i -= NB * 15) < SB * 30) { const int b = i / 30, r = i % 30; dst = B.out + O_CS + (((size_t)layer * SB + b) * CHIST + r) * DCONV;
        src = (ST + r < CHIST) ? P.state_conv + (((size_t)layer * SB + b) * CHIST + ST + r) * DCONV : B.U + (size_t)(MP + b * ST + (ST + r - CHIST)) * 256; }
    else { i -= SB * 30; const int b = i / 15, r = i % 15; dst = B.out + O_PS + (((size_t)layer * SB + b) * PHIST + r) * DPOOL;
        src = (ST + r < PHIST) ? P.state_pool + (((size_t)layer * SB + b) * PHIST + ST + r) * DPOOL : B.XC + (size_t)(MP + b * ST + (ST + r - PHIST)) * 256; }
    *((f32x4*)dst + lane) = *((const f32x4*)src + lane);
}

__device__ __forceinline__ void rho_map(int rho, int& qq, int& head) { const int hf = (rho >> 2) & 1, i = (rho & 3) + 4 * (rho >> 3); qq = 2 * hf + (i >> 3); head = i & 7; }
typedef float f32x2 __attribute__((ext_vector_type(2)));
__device__ __forceinline__ void head_reduce(const f32x16& acc, const float (&wv)[16], float& s0, float& s1) {
    f32x2 a = {0.f, 0.f}, c = {0.f, 0.f};
#pragma unroll
    for (int h = 0; h < 8; h += 2) {
        const float f0 = acc[h], f1 = acc[h + 1], f2 = acc[8 + h], f3 = acc[9 + h];
        const int i0 = __float_as_int(f0), i1 = __float_as_int(f1), i2 = __float_as_int(f2), i3 = __float_as_int(f3);
        const f32x2 x01 = {__int_as_float(i0 > 0 ? i0 : 0), __int_as_float(i1 > 0 ? i1 : 0)}, x23 = {__int_as_float(i2 > 0 ? i2 : 0), __int_as_float(i3 > 0 ? i3 : 0)};
        const f32x2 w01 = {wv[h], wv[h + 1]}, w23 = {wv[8 + h], wv[9 + h]};
        a = __builtin_elementwise_fma(w01, x01, a); c = __builtin_elementwise_fma(w23, x23, c); }
    s0 = a.x + a.y; s1 = c.x + c.y;
}
typedef short s16x2 __attribute__((ext_vector_type(2)));
__device__ __forceinline__ void wfrag_build(const float* wrow  , int lane, bf16x8 (&wf)[2]) {
    const int r = lane & 31, hh = lane >> 5, ssel = r - 2 * hh; v4u pk = {0u, 0u, 0u, 0u};
    if (r < 4) { const f32x4 w0 = *(const f32x4*)(wrow + r * 8), w1 = *(const f32x4*)(wrow + r * 8 + 4); pk.x = pk_bf16(w0.x, w0.y); pk.y = pk_bf16(w0.z, w0.w); pk.z = pk_bf16(w1.x, w1.y); pk.w = pk_bf16(w1.z, w1.w); }
    const v4u z = {0u, 0u, 0u, 0u};
    wf[0] = __builtin_bit_cast(bf16x8, (r < 4 && ssel == 0) ? pk : z); wf[1] = __builtin_bit_cast(bf16x8, (r < 4 && ssel == 1) ? pk : z);
}
__device__ __forceinline__ f32x16 head_reduce_mfma(const f32x16& acc, const bf16x8 (&wf)[2]) {
    f32x16 y;
#pragma unroll
    for (int i = 0; i < 16; ++i) y[i] = 0.f;
#pragma unroll
    for (int st = 0; st < 2; ++st) { unsigned d[4];
#pragma unroll
        for (int p = 0; p < 4; ++p) { const float f0 = acc[8 * st + 2 * p], f1 = acc[8 * st + 2 * p + 1]; const unsigned w = pk_bf16(f0, f1);
            const s16x2 v = {(short)(w & 0xFFFFu), (short)(w >> 16)}; const s16x2 m = __builtin_elementwise_max(v, (s16x2){0, 0});
            d[p] = (unsigned)(unsigned short)m.x | ((unsigned)(unsigned short)m.y << 16); }
        const v4u pk = {d[0], d[1], d[2], d[3]};
        y = __builtin_amdgcn_mfma_f32_32x32x16_bf16(wf[st], __builtin_bit_cast(bf16x8, pk), y, 0, 0, 0); }
    return y;
}
constexpr int KI_LD = 144;
constexpr int KI_BUF = 128 * KI_LD;

__device__ __forceinline__ void scores_prompt_unit(const Bufs& B, LAS unsigned char* lds, int b, int qb, int tid, int abl = 0) {
    const int lane = tid & 63, wave = __builtin_amdgcn_readfirstlane(tid >> 6), hf = lane >> 5, qg = wave & 3, kh = wave >> 2;
    const int t0 = qb * 32; const size_t mrow = (size_t)b * T + t0 + 8 * qg;
    int qq, head; rho_map(lane & 31, qq, head);
    bf16x8 af[2][4]; bf16x8 wf[2][2];
#pragma unroll
    for (int a = 0; a < 2; ++a) {
#pragma unroll
        for (int ks = 0; ks < 4; ++ks) af[a][ks] = *(const bf16x8*)(B.QI + (mrow + 4 * a + qq) * 512 + head * 64 + 16 * ks + 8 * hf);
        wfrag_build(B.WI + (mrow + 4 * a) * 8, lane, wf[a]); }
    const int nchunk = (t0 + 32 + 127) >> 7;
    const bf16_t* kbase = B.KI + (size_t)b * T * 64;
    const int p0 = tid, p1 = tid + 512; const unsigned so0 = (unsigned)((p0 >> 3) * KI_LD + (p0 & 7) * 16), so1 = (unsigned)((p1 >> 3) * KI_LD + (p1 & 7) * 16);
    const bf16_t* kp0 = kbase + (size_t)(p0 >> 3) * 64 + (p0 & 7) * 8; const bf16_t* kp1 = kbase + (size_t)(p1 >> 3) * 64 + (p1 & 7) * 8;
    v4u rA0 = *(const v4u*)kp0, rA1 = *(const v4u*)kp1, rB0 = rA0, rB1 = rA1;
    if (nchunk > 1) { rB0 = *(const v4u*)(kp0 + 128 * 64); rB1 = *(const v4u*)(kp1 + 128 * 64); }
    *(LAS v4u*)(lds + so0) = rA0; *(LAS v4u*)(lds + so1) = rA1;
    if (nchunk > 1) { *(LAS v4u*)(lds + KI_BUF + so0) = rB0; *(LAS v4u*)(lds + KI_BUF + so1) = rB1; }
    if (nchunk > 2) { rA0 = *(const v4u*)(kp0 + 2 * 128 * 64); rA1 = *(const v4u*)(kp1 + 2 * 128 * 64); }
    __syncthreads();
    constexpr int ST_OFF = 98304;
    _Float16* const scblk = B.SC + ((size_t)b * T + t0 + (tid >> 4)) * T + 8 * (tid & 15);
    const unsigned fro = (unsigned)((64 * kh + (lane & 31)) * KI_LD + 16 * hf);
    bf16x8 bqA[2][4], bqB[2][4];
#pragma unroll
    for (int kbl = 0; kbl < 2; ++kbl)
#pragma unroll
        for (int ks = 0; ks < 4; ++ks) bqA[kbl][ks] = *(const LAS bf16x8*)(lds + fro + (32 * kbl) * KI_LD + 32 * ks);
#define SCORE_MM(dst, a_, kbl_, BQ) do { _Pragma("unroll") for (int i = 0; i < 16; ++i) (dst)[i] = 0.f; \
            _Pragma("unroll") for (int ks = 0; ks < 4; ++ks) (dst) = __builtin_amdgcn_mfma_f32_32x32x16_bf16(af[a_][ks], BQ[kbl_][ks], (dst), 0, 0, 0); } while (0)
#define SCORE_HR(acc_, a_, j_) do { const f32x16 y = head_reduce_mfma(acc_, wf[a_]); LAS _Float16* sp = stile + (4 * ((j_) & 1)) * 128 + 32 * ((j_) >> 1); \
            sp[0] = (_Float16)y[0]; sp[128] = (_Float16)y[1]; sp[256] = (_Float16)y[2]; sp[384] = (_Float16)y[3]; } while (0)
#define SCORE_BODY(c_, BQC, BQN, RW0, RW1, RL0, RL1) { const int c = (c_); \
        if (c + 3 < nchunk && !(abl & 2)) { RL0 = *(const v4u*)(kp0 + (size_t)(c + 3) * 128 * 64); RL1 = *(const v4u*)(kp1 + (size_t)(c + 3) * 128 * 64); } \
        if (c > 0) { const v4u sv = *(const LAS v4u*)(lds + ST_OFF + ((c - 1) & 1) * 8192 + (tid >> 4) * 256 + (tid & 15) * 16); if (!(abl & 1)) __builtin_nontemporal_store(sv, (v4u*)(scblk + (size_t)(c - 1) * 128)); else if (sv.x == 0x12345u) *(v4u*)(scblk) = sv; } \
        if (c == nchunk) break; \
        LAS unsigned char* nxt = lds + ((c + 1) & 1) * KI_BUF; \
        if (c + 1 < nchunk) { _Pragma("unroll") for (int kbl = 0; kbl < 2; ++kbl) _Pragma("unroll") for (int ks = 0; ks < 4; ++ks) BQN[kbl][ks] = *(const LAS bf16x8*)(nxt + fro + (32 * kbl) * KI_LD + 32 * ks); } \
        f32x16 a0, a1; \
        LAS _Float16* stile = (LAS _Float16*)(lds + ST_OFF + (hf ? 2 : (c & 1)) * 8192) + (8 * qg) * 128 + 64 * kh + (lane & 31);        \
        { \
        SCORE_MM(a0, 0, 0, BQC); \
        SCORE_MM(a1, 1, 0, BQC); SCORE_HR(a0, 0, 0); \
        SCORE_MM(a0, 0, 1, BQC); SCORE_HR(a1, 1, 1); \
        SCORE_MM(a1, 1, 1, BQC); SCORE_HR(a0, 0, 2); \
        SCORE_HR(a1, 1, 3); } \
        if (c + 2 < nchunk) { LAS unsigned char* wb = lds + (c & 1) * KI_BUF; *(LAS v4u*)(wb + so0) = RW0; *(LAS v4u*)(wb + so1) = RW1; }        \
        __syncthreads(); }
    for (int c2 = 0; ; c2 += 2) { SCORE_BODY(c2, bqA, bqB, rA0, rA1, rB0, rB1) SCORE_BODY(c2 + 1, bqB, bqA, rB0, rB1, rA0, rA1) }
#undef SCORE_BODY
#undef SCORE_HR
#undef SCORE_MM
}
__device__ __forceinline__ void scores_sample_task(const Bufs& B, const P2Args& P, int layer, int task, int lane, LAS unsigned char* swl  ) {
    const int hf = lane >> 5; const bool newk = task >= SB * NPAGES; const int b = newk ? task - SB * NPAGES : task / NPAGES, pg = newk ? 0 : task % NPAGES;
    const size_t mrow = (size_t)MP + b * ST;
    int qq, head; rho_map(lane & 31, qq, head);
    bf16x8 af[2][4]; bf16x8 wf[2][2];
#pragma unroll
    for (int a = 0; a < 2; ++a) {
#pragma unroll
        for (int ks = 0; ks < 4; ++ks) af[a][ks] = *(const bf16x8*)(B.QI + (mrow + 4 * a + qq) * 512 + head * 64 + 16 * ks + 8 * hf);
        wfrag_build(B.WI + (mrow + 4 * a) * 8, lane, wf[a]); }
    _Float16* sc0 = B.SCS + (size_t)(b * ST) * SCS_LD + (lane & 31);
    if (!newk) {
        const float* pgp = P.cache_kidx + (((size_t)layer * NPOOL + P.page_table[b * NPAGES + pg]) * PAGE + (lane >> 4)) * ID + 4 * (lane & 15);
        f32x4 u[4][8];
#pragma unroll
        for (int kb = 0; kb < 4; ++kb)
#pragma unroll
            for (int q = 0; q < 8; ++q) u[kb][q] = *(const f32x4*)(pgp + (size_t)(32 * kb + 4 * q) * ID);
#pragma unroll
        for (int kb = 0; kb < 4; ++kb) {
            asm volatile("" ::: "memory");
#pragma unroll
            for (int q = 0; q < 8; ++q) { v2u p; p.x = pk_bf16(u[kb][q].x, u[kb][q].y); p.y = pk_bf16(u[kb][q].z, u[kb][q].w); *(LAS v2u*)(swl + (4 * q + (lane >> 4)) * KI_LD + (lane & 15) * 8) = p; }
            asm volatile("" ::: "memory");
            bf16x8 bfg[4];
#pragma unroll
            for (int ks = 0; ks < 4; ++ks) bfg[ks] = *(const LAS bf16x8*)(swl + (lane & 31) * KI_LD + 32 * ks + 16 * hf);
            asm volatile("" ::: "memory");
#pragma unroll
            for (int a = 0; a < 2; ++a) { f32x16 acc;
#pragma unroll
                for (int i = 0; i < 16; ++i) acc[i] = 0.f;
#pragma unroll
                for (int ks = 0; ks < 4; ++ks) acc = __builtin_amdgcn_mfma_f32_32x32x16_bf16(af[a][ks], bfg[ks], acc, 0, 0, 0);
                const f32x16 y = head_reduce_mfma(acc, wf[a]);
                if (hf == 0) { _Float16* sp = sc0 + (size_t)(4 * a) * SCS_LD + pg * PAGE + 32 * kb; sp[0] = (_Float16)y[0]; sp[SCS_LD] = (_Float16)y[1]; sp[2 * SCS_LD] = (_Float16)y[2]; sp[3 * SCS_LD] = (_Float16)y[3]; } }
        }
    } else {
        const int kr = (lane & 31) < ST ? (lane & 31) : 0;
        bf16x8 bfg[4];
#pragma unroll
        for (int ks = 0; ks < 4; ++ks) bfg[ks] = *(const bf16x8*)(B.KI + (mrow + kr) * 64 + 16 * ks + 8 * hf);
#pragma unroll
        for (int a = 0; a < 2; ++a) { f32x16 acc;
#pragma unroll
            for (int i = 0; i < 16; ++i) acc[i] = 0.f;
#pragma unroll
            for (int ks = 0; ks < 4; ++ks) acc = __builtin_amdgcn_mfma_f32_32x32x16_bf16(af[a][ks], bfg[ks], acc, 0, 0, 0);
            const f32x16 y = head_reduce_mfma(acc, wf[a]);
            if (lane < ST) { _Float16* sp = sc0 + (size_t)(4 * a) * SCS_LD + PAST; sp[0] = (_Float16)y[0]; sp[SCS_LD] = (_Float16)y[1]; sp[2 * SCS_LD] = (_Float16)y[2]; sp[3 * SCS_LD] = (_Float16)y[3]; } }
    }
}

struct P3Args { const float* cache_k; const float* cache_v; const int* page_table; };
typedef short s16x4 __attribute__((ext_vector_type(4)));
constexpr int WL_BYTES = 16384, WL_LIST = 4096, WL_VB = 5120, VB_LD = 160, NHC = 4;
__device__ __forceinline__ unsigned f16_sortkey(unsigned h) { return (h & 0x8000u) ? (~h & 0xFFFFu) : (h | 0x8000u); }
__device__ __forceinline__ void find_bin(const LAS unsigned* hist, int ncopy, int K, int lane, int& bin, int& above) {
    unsigned c0 = 0, c1 = 0, c2 = 0, c3 = 0;
    for (int cp = 0; cp < ncopy; ++cp) { const v4u h = *(const LAS v4u*)(hist + cp * 256 + 4 * lane); c0 += h.x; c1 += h.y; c2 += h.z; c3 += h.w; }
    const int tot = (int)(c0 + c1 + c2 + c3); int v = tot;
#pragma unroll
    for (int o = 1; o < 64; o <<= 1) { const int tmp = __shfl_down(v, o); if (lane + o < 64) v += tmp; }
    const int S = v - tot;
    const bool mine = (S < K) && (v >= K);
    const unsigned long long mk = __ballot(mine); const int L = mk ? (int)__builtin_ctzll(mk) : 0;
    int run = S, lb = 4 * lane, la = S; bool found = false;
    if (run + (int)c3 >= K) { lb = 4 * lane + 3; la = run; found = true; } else run += (int)c3;
    if (!found) { if (run + (int)c2 >= K) { lb = 4 * lane + 2; la = run; found = true; } else run += (int)c2; }
    if (!found) { if (run + (int)c1 >= K) { lb = 4 * lane + 1; la = run; found = true; } else run += (int)c1; }
    if (!found) { lb = 4 * lane; la = run; }
    bin = __shfl(lb, L); above = __shfl(la, L);
}
__device__ __forceinline__ unsigned sortkey2(unsigned x) { const unsigned sgn = (x >> 15) & 0x00010001u; return x ^ ((sgn * 0x7FFFu) | 0x80008000u); }
template <bool SMP, int MODE = 0>
__device__ __forceinline__ void select_attend_task(const Bufs& B, const P3Args& P, int layer, int m_in, int lane_in, LAS unsigned char* wl) {
    int m = m_in, lane = lane_in; asm volatile("" : "+s"(m)); asm volatile("" : "+v"(lane));
    constexpr int CIT = SMP ? 11 : 16, NCH = SMP ? 3 : 1;
    const int b = SMP ? (m - MP) / ST : m / T, t = SMP ? (m - MP) % ST : m % T; const int n = SMP ? PAST + t + 1 : t + 1;
    const unsigned char* scb = (const unsigned char*)(SMP ? B.SCS + (size_t)(m - MP) * SCS_LD : B.SC + (size_t)m * T);
    LAS unsigned* hist = (LAS unsigned*)wl; LAS unsigned* list = (LAS unsigned*)(wl + WL_LIST);
    const int cnt = n < TOPK ? n : TOPK;
    asm volatile("" ::: "memory");
    if (MODE == 2 || MODE == 3) {
#pragma unroll
        for (int q = 0; q < 4; ++q) list[lane + 64 * q] = (unsigned)((lane + 64 * q) * 29 % (n > 1 ? n : 1));
    } else if (n <= TOPK) {
#pragma unroll
        for (int q = 0; q < 4; ++q) { const int i = lane + 64 * q; list[i] = i < n ? (unsigned)i : 0u; }
    } else {
        const int nIt = (n + 511) >> 9;
        v4u kk[CIT];
#define LOADCHUNK(ch_) do { _Pragma("unroll") for (int it = 0; it < CIT; ++it) { kk[it] = (v4u){0u, 0u, 0u, 0u}; if ((ch_) * CIT + it < nIt) kk[it] = __builtin_nontemporal_load((const v4u*)(scb + ((ch_) * CIT + it) * 1024 + (unsigned)(lane * 16))); } \
        _Pragma("unroll") for (int it = 0; it < CIT; ++it) { const int e0 = ((ch_) * CIT + it) * 512 + lane * 8; unsigned w[4] = {kk[it].x, kk[it].y, kk[it].z, kk[it].w}; \
            _Pragma("unroll") for (int d = 0; d < 4; ++d) { unsigned k2 = sortkey2(w[d]); if (e0 + 2 * d >= n) k2 = 0u; else if (e0 + 2 * d + 1 >= n) k2 &= 0xFFFFu; w[d] = k2; } \
            kk[it] = (v4u){w[0], w[1], w[2], w[3]}; } } while (0)
#define FOR_KEYS(ch_) _Pragma("unroll") for (int it = 0; it < CIT; ++it) if ((ch_) * CIT + it < nIt) { const int e0 = ((ch_) * CIT + it) * 512 + lane * 8; (void)e0; unsigned w[4] = {kk[it].x, kk[it].y, kk[it].z, kk[it].w}; \
            asm volatile("" : "+v"(w[0]), "+v"(w[1]), "+v"(w[2]), "+v"(w[3])); _Pragma("unroll") for (int d = 0; d < 4; ++d) { const unsigned k0 = w[d] & 0xFFFFu, k1 = w[d] >> 16; (void)k0; (void)k1;
#define END_KEYS } }
#pragma unroll
        for (int q = 0; q < 4 * NHC; ++q) hist[lane + 64 * q] = 0u;
        if (NCH == 1) LOADCHUNK(0);
        asm volatile("s_waitcnt lgkmcnt(0)" ::: "memory");
        LAS unsigned* hc = hist + (lane & (NHC - 1)) * 256;
#pragma unroll 1
        for (int ch = 0; ch < NCH; ++ch) { if (NCH > 1) LOADCHUNK(ch);
            FOR_KEYS(ch) __hip_atomic_fetch_add(hc + (k0 >> 8), 1u, __ATOMIC_RELAXED, __HIP_MEMORY_SCOPE_WORKGROUP); __hip_atomic_fetch_add(hc + (k1 >> 8), 1u, __ATOMIC_RELAXED, __HIP_MEMORY_SCOPE_WORKGROUP); END_KEYS }
        asm volatile("s_waitcnt lgkmcnt(0)" ::: "memory");
        int B1, above1; find_bin(hist, NHC, TOPK, lane, B1, above1);
        if (MODE == 11) { if (B1 == 12345) list[lane] = (unsigned)above1; return; }
        asm volatile("" ::: "memory");
#pragma unroll
        for (int q = 0; q < 4; ++q) hist[lane + 64 * q] = 0u;
        asm volatile("s_waitcnt lgkmcnt(0)" ::: "memory");
#pragma unroll 1
        for (int ch = 0; ch < NCH; ++ch) { if (NCH > 1) LOADCHUNK(ch);
            FOR_KEYS(ch) if ((int)(k0 >> 8) == B1) __hip_atomic_fetch_add(hist + (k0 & 255u), 1u, __ATOMIC_RELAXED, __HIP_MEMORY_SCOPE_WORKGROUP);
                         if ((int)(k1 >> 8) == B1) __hip_atomic_fetch_add(hist + (k1 & 255u), 1u, __ATOMIC_RELAXED, __HIP_MEMORY_SCOPE_WORKGROUP); END_KEYS }
        asm volatile("s_waitcnt lgkmcnt(0)" ::: "memory");
        int B2, above2; find_bin(hist, 1, TOPK - above1, lane, B2, above2);
        const unsigned tau = ((unsigned)B1 << 8) | (unsigned)B2; const int cnt_gt = above1 + above2;
        if (MODE == 12) { if (tau == 0x12345u) list[lane] = (unsigned)cnt_gt; return; }
        constexpr int NMW = (CIT + 3) / 4;
#define BUILD_MASKS(ch_) do { _Pragma("unroll") for (int wq = 0; wq < NMW; ++wq) { mg[wq] = 0u; me[wq] = 0u; } \
            FOR_KEYS(ch_) const unsigned g2 = ((tau - k0) >> 31) | (((tau - k1) >> 31) << 1), q2 = (((k0 ^ tau) - 1u) >> 31) | ((((k1 ^ tau) - 1u) >> 31) << 1); \
                mg[it >> 2] |= g2 << (8 * (it & 3) + 2 * d); me[it >> 2] |= q2 << (8 * (it & 3) + 2 * d); END_KEYS } while (0)
        unsigned mg[NMW], me[NMW];
        int cg = 0, ce = 0;
#pragma unroll 1
        for (int ch = 0; ch < NCH; ++ch) { if (NCH > 1) LOADCHUNK(ch);
            BUILD_MASKS(ch);
#pragma unroll
            for (int wq = 0; wq < NMW; ++wq) { cg += __popc(mg[wq]); ce += __popc(me[wq]); } }
        if (MODE == 13) { if (cg == 12345) list[lane] = (unsigned)ce; return; }
        int pg = cg, pe = ce;
#pragma unroll
        for (int o = 1; o < 64; o <<= 1) { const int tg = __shfl_up(pg, o), te = __shfl_up(pe, o); if (lane >= o) { pg += tg; pe += te; } }
        pg -= cg; pe = cnt_gt + (pe - ce);
        asm volatile("" ::: "memory");
#pragma unroll 1
        for (int ch = 0; ch < NCH; ++ch) { if (NCH > 1) { LOADCHUNK(ch); BUILD_MASKS(ch); }
#pragma unroll
            for (int wq = 0; wq < NMW; ++wq) { const int ebase = ((ch * CIT + 4 * wq) * 512) + lane * 8;
                unsigned m = mg[wq];
                while (m) { const int bb = __builtin_ctz(m); m &= m - 1u; list[pg] = (unsigned)(ebase + ((bb >> 3) << 9) + (bb & 7)); ++pg; }
                m = me[wq];
                while (m) { const int bb = __builtin_ctz(m); m &= m - 1u; if (pe < TOPK) list[pe] = (unsigned)(ebase + ((bb >> 3) << 9) + (bb & 7)); ++pe; } } }
#undef BUILD_MASKS
#undef LOADCHUNK
#undef FOR_KEYS
#undef END_KEYS
    }
    asm volatile("s_waitcnt lgkmcnt(0)" ::: "memory");
    if (MODE == 1) return;
    const int hcol = lane & 15, g = lane >> 4;
    const float* ckb = nullptr; const float* cvb = nullptr; const int* ptb = nullptr;
    if (SMP) { ckb = P.cache_k + (size_t)layer * NPOOL * PAGE * KVD; cvb = P.cache_v + (size_t)layer * NPOOL * PAGE * KVD; ptb = P.page_table + b * NPAGES; }
    const unsigned char* kvb = (const unsigned char*)(SMP ? B.KV + (size_t)(MP + b * ST) * 256 : B.KV + (size_t)b * T * 256);
    LAS unsigned char* vb = wl + WL_VB;
    constexpr float LOG2E = 1.4426950408889634f;
#pragma unroll 1
    for (int nk = 0; nk < 2; ++nk) {
        bf16x8 qf[2];
#pragma unroll
        for (int ks = 0; ks < 2; ++ks) { qf[ks] = (bf16x8){0, 0, 0, 0, 0, 0, 0, 0}; if (hcol < 4) qf[ks] = *(const bf16x8*)(B.QB + (size_t)m * 512 + (4 * nk + hcol) * 64 + 32 * ks + 8 * g); }
        f32x4 S[16];
        if (SMP) {
#pragma unroll
            for (int tl = 0; tl < 16; ++tl) {
                const unsigned kidx = list[16 * tl + hcol]; bf16x8 a0, a1;
                if (kidx < (unsigned)PAST) { const float* kp = ckb + ((size_t)ptb[kidx >> 7] * PAGE + (kidx & 127u)) * KVD + 64 * nk + 8 * g;
                    const f32x4 u0 = *(const f32x4*)kp, u1 = *(const f32x4*)(kp + 4), u2 = *(const f32x4*)(kp + 32), u3 = *(const f32x4*)(kp + 36);
                    v4u p0, p1; p0.x = pk_bf16(u0.x, u0.y); p0.y = pk_bf16(u0.z, u0.w); p0.z = pk_bf16(u1.x, u1.y); p0.w = pk_bf16(u1.z, u1.w);
                    p1.x = pk_bf16(u2.x, u2.y); p1.y = pk_bf16(u2.z, u2.w); p1.z = pk_bf16(u3.x, u3.y); p1.w = pk_bf16(u3.z, u3.w);
                    a0 = __builtin_bit_cast(bf16x8, p0); a1 = __builtin_bit_cast(bf16x8, p1);
                } else { const unsigned off = (kidx - PAST) * 512u + (unsigned)(128 * nk + 16 * g); a0 = *(const bf16x8*)(kvb + off); a1 = *(const bf16x8*)(kvb + off + 64u); }
                f32x4 s = {0.f, 0.f, 0.f, 0.f};
                s = __builtin_amdgcn_mfma_f32_16x16x32_bf16(a0, qf[0], s, 0, 0, 0);
                S[tl] = __builtin_amdgcn_mfma_f32_16x16x32_bf16(a1, qf[1], s, 0, 0, 0);
            }
        } else {
#define KLOAD(dst, kb_, q_) do { const int kl_ = (lane >> 3) + 8 * (q_), part_ = lane & 7; const unsigned kidx_ = list[32 * (kb_) + kl_]; \
                (dst) = *(const v4u*)(kvb + (kidx_ * 512u + (unsigned)(128 * nk + 16 * part_))); } while (0)
            v4u pk[2][8];
#pragma unroll
            for (int i = 0; i < 8; ++i) KLOAD(pk[0][i], i >> 2, i & 3);
#pragma unroll
            for (int kb = 0; kb < 8; ++kb) {
                asm volatile("" ::: "memory");
                if ((kb & 1) == 0 && kb + 2 < 8) {
#pragma unroll
                    for (int i = 0; i < 8; ++i) KLOAD(pk[((kb >> 1) + 1) & 1][i], kb + 2 + (i >> 2), i & 3);
                }
#pragma unroll
                for (int q = 0; q < 4; ++q) *(LAS v4u*)(vb + ((lane >> 3) + 8 * q) * VB_LD + (lane & 7) * 16) = pk[(kb >> 1) & 1][4 * (kb & 1) + q];
                asm volatile("" ::: "memory");
#pragma unroll
                for (int t2 = 0; t2 < 2; ++t2) { const LAS unsigned char* kr = vb + (16 * t2 + hcol) * VB_LD + 16 * g;
                    const bf16x8 a0 = *(const LAS bf16x8*)kr, a1 = *(const LAS bf16x8*)(kr + 64);
                    f32x4 s = {0.f, 0.f, 0.f, 0.f};
                    s = __builtin_amdgcn_mfma_f32_16x16x32_bf16(a0, qf[0], s, 0, 0, 0);
                    S[2 * kb + t2] = __builtin_amdgcn_mfma_f32_16x16x32_bf16(a1, qf[1], s, 0, 0, 0); }
                asm volatile("" ::: "memory");
            }
#undef KLOAD
        }
        if (cnt < TOPK) {
#pragma unroll
            for (int tl = 0; tl < 16; ++tl) { const int p0i = 16 * tl + 4 * g;
                S[tl].x = p0i + 0 < cnt ? S[tl].x : -INFINITY; S[tl].y = p0i + 1 < cnt ? S[tl].y : -INFINITY; S[tl].z = p0i + 2 < cnt ? S[tl].z : -INFINITY; S[tl].w = p0i + 3 < cnt ? S[tl].w : -INFINITY; } }
        if (MODE == 3) { float sacc = 0.f;
#pragma unroll
            for (int tl = 0; tl < 16; ++tl) sacc += S[tl].x + S[tl].w; if (sacc == 1234.5f) *(float*)(B.X) = sacc; continue; }
#define VLOAD(dst, kb_, q_) do { const int kl_ = (lane >> 3) + 8 * (q_), part_ = lane & 7; const unsigned kidx_ = list[32 * (kb_) + kl_]; \
            if (SMP && kidx_ < (unsigned)PAST) { const float* vp_ = cvb + ((size_t)ptb[kidx_ >> 7] * PAGE + (kidx_ & 127u)) * KVD + 64 * nk + 8 * part_; \
                const f32x4 u0_ = *(const f32x4*)vp_, u1_ = *(const f32x4*)(vp_ + 4); (dst).x = pk_bf16(u0_.x, u0_.y); (dst).y = pk_bf16(u0_.z, u0_.w); (dst).z = pk_bf16(u1_.x, u1_.y); (dst).w = pk_bf16(u1_.z, u1_.w); \
            } else (dst) = *(const v4u*)(kvb + ((SMP ? kidx_ - PAST : kidx_) * 512u + (unsigned)(256 + 128 * nk + 16 * part_))); } while (0)
        v4u pv[2][8];
        if (!SMP) {
#pragma unroll
            for (int i = 0; i < 8; ++i) VLOAD(pv[0][i], i >> 2, i & 3);
        }
        float mx = -INFINITY;
#pragma unroll
        for (int tl = 0; tl < 16; ++tl) mx = fmaxf(fmaxf(mx, fmaxf(S[tl].x, S[tl].y)), fmaxf(S[tl].z, S[tl].w));
        mx = fmaxf(mx, __shfl_xor(mx, 16)); mx = fmaxf(mx, __shfl_xor(mx, 32));
        const float mx2 = mx * LOG2E; float sum = 0.f;
#pragma unroll
        for (int tl = 0; tl < 16; ++tl) { S[tl].x = __builtin_amdgcn_exp2f(S[tl].x * LOG2E - mx2); S[tl].y = __builtin_amdgcn_exp2f(S[tl].y * LOG2E - mx2); S[tl].z = __builtin_amdgcn_exp2f(S[tl].z * LOG2E - mx2); S[tl].w = __builtin_amdgcn_exp2f(S[tl].w * LOG2E - mx2);
            sum += (S[tl].x + S[tl].y) + (S[tl].z + S[tl].w); }
        sum += __shfl_xor(sum, 16); sum += __shfl_xor(sum, 32);
        f32x4 O[4];
#pragma unroll
        for (int dt = 0; dt < 4; ++dt) O[dt] = (f32x4){0.f, 0.f, 0.f, 0.f};
#pragma unroll
        for (int kb = 0; kb < 8; ++kb) {
            asm volatile("" ::: "memory");
            if (SMP) {
#pragma unroll
                for (int q = 0; q < 4; ++q) VLOAD(pv[0][q], kb, q);
            } else if ((kb & 1) == 0 && kb + 2 < 8) {
#pragma unroll
                for (int i = 0; i < 8; ++i) VLOAD(pv[((kb >> 1) + 1) & 1][i], kb + 2 + (i >> 2), i & 3);
            }
#pragma unroll
            for (int q = 0; q < 4; ++q) *(LAS v4u*)(vb + ((lane >> 3) + 8 * q) * VB_LD + (lane & 7) * 16) = SMP ? pv[0][q] : pv[(kb >> 1) & 1][4 * (kb & 1) + q];
            asm volatile("" ::: "memory");
            v4u pw; pw.x = pk_bf16(S[2 * kb].x, S[2 * kb].y); pw.y = pk_bf16(S[2 * kb].z, S[2 * kb].w); pw.z = pk_bf16(S[2 * kb + 1].x, S[2 * kb + 1].y); pw.w = pk_bf16(S[2 * kb + 1].z, S[2 * kb + 1].w);
            const bf16x8 pf = __builtin_bit_cast(bf16x8, pw);
#pragma unroll
            for (int dt = 0; dt < 4; ++dt) {
                const LAS unsigned char* ta = vb + (4 * g + (hcol >> 2)) * VB_LD + (16 * dt + 4 * (hcol & 3)) * 2;
                const s16x4 lo = __builtin_bit_cast(s16x4, __builtin_amdgcn_ds_read_tr16_b64_v4i16((LAS s16x4*)ta));
                const s16x4 hi = __builtin_bit_cast(s16x4, __builtin_amdgcn_ds_read_tr16_b64_v4i16((LAS s16x4*)(ta + 16 * VB_LD)));
                const bf16x8 af = {lo.x, lo.y, lo.z, lo.w, hi.x, hi.y, hi.z, hi.w};
                O[dt] = __builtin_amdgcn_mfma_f32_16x16x32_bf16(af, pf, O[dt], 0, 0, 0); }
            asm volatile("" ::: "memory");
        }
#undef VLOAD
        if (hcol < 4 && (MODE == 0 || sum == 123.456f)) { const float inv = 1.f / sum;
#pragma unroll
            for (int dt = 0; dt < 4; ++dt) { v2u w; w.x = pk_bf16(O[dt].x * inv, O[dt].y * inv); w.y = pk_bf16(O[dt].z * inv, O[dt].w * inv);
                *(v2u*)(B.CA + (size_t)m * DM + DCONV + (4 * nk + hcol) * 64 + 16 * dt + 4 * g) = w; } }
    }
    asm volatile("s_waitcnt lgkmcnt(0)" ::: "memory");
}
constexpr int NPHASE = 1 + 9 * DEPTH;
constexpr int I_IN = (DM / 64) * ((DIN + 31) / 32), I_C = (DCONV / 64) * (DM / 32), I_A = (DATT / 64) * (DM / 32), I_O = (DM / 64) * (DM / 32), I_1 = (DM / 64) * (DFF / 32), I_2 = (DFF / 64) * (DM / 32);
constexpr int I_L = I_IN + I_C + I_A + I_O + I_1 + I_2;
constexpr int I_HEAD = I_IN + I_C + I_A + I_O, I_FF = I_1 + I_2;
#ifndef PH_MASK
#define PH_MASK 0x3FF
#endif
#define PH_ON(k) (((PH_MASK) >> (k)) & 1)
#ifndef REP_PH
#define REP_PH -1
#endif
#ifndef REP_N
#define REP_N 1
#endif
#define REPS(k) for (int rep_ = 0; rep_ <= ((REP_PH) == (k) ? (REP_N) : 0); ++rep_)
__global__ void __launch_bounds__(NTHR, 2) fwd(Args args) {
    extern __shared__ __attribute__((aligned(16))) unsigned char lds_[];
    LAS unsigned char* lds = (LAS unsigned char*)lds_;
    volatile LAS unsigned* MISC = (volatile LAS unsigned*)(lds + MISC_OFF);
    const int tid = threadIdx.x, lane = tid & 63, wave = __builtin_amdgcn_readfirstlane(tid >> 6);
    const int G = gridDim.x; const int bx = blockIdx.x; const int vcu = (G % 8 == 0) ? (bx % 8) * (G / 8) + bx / 8 : bx;
    const int gw = vcu * NWAVES + wave, NGW = G * NWAVES;
    unsigned* ctl = (unsigned*)(args.ws + WS_CTL);
    for (int u = tid; u < (LDS_BYTES - LDSCTL_OFF) / 4; u += NTHR) ((LAS unsigned*)(lds + LDSCTL_OFF))[u] = 0u;
    __syncthreads();
    (void)xcd_barrier_post(ctl + CW_BAR, MISC + 8);
#define KAS __attribute__((address_space(4)))
#define ARGP(i) (*(const float* KAS const*)(ka_ + 8 * (i)))
#define MKBUFS() int tid_ = threadIdx.x; asm volatile("" : "+v"(tid_)); const int lane = tid_ & 63; (void)lane; const int wave = __builtin_amdgcn_readfirstlane(tid_ >> 6); (void)wave; \
    int G = gridDim.x, bx = blockIdx.x; asm volatile("" : "+s"(G), "+s"(bx)); const int vcu = (G % 8 == 0) ? (bx % 8) * (G / 8) + bx / 8 : bx; const int gw = vcu * NWAVES + wave, NGW = G * NWAVES; (void)gw; (void)NGW; \
    const KAS unsigned char* ka_ = (const KAS unsigned char*)__builtin_amdgcn_kernarg_segment_ptr(); asm volatile("" : "+s"(ka_)); \
    unsigned char* ws = *(unsigned char* KAS const*)(ka_ + 200); float* outp_ = *(float* KAS const*)(ka_ + 192); \
    Bufs B{}; B.X = (float*)(ws + WS_X); B.H = (bf16_t*)(ws + WS_H); B.U = (float*)(ws + WS_U); B.XC = (float*)(ws + WS_XC); B.QB = (bf16_t*)(ws + WS_QB); B.KV = (bf16_t*)(ws + WS_KV); \
    B.QI = (bf16_t*)(ws + WS_QI); B.KI = (bf16_t*)(ws + WS_KI); B.WI = (float*)(ws + WS_WI); B.G = (_Float16*)(ws + WS_G); B.CA = (bf16_t*)(ws + WS_CA); B.PA = (bf16_t*)(ws + WS_PA); \
    B.AT = (bf16_t*)(ws + WS_AT); B.MB = (bf16_t*)(ws + WS_MB); B.R = (bf16_t*)(ws + WS_R); B.SC = (_Float16*)(ws + WS_SC); B.SCS = (_Float16*)(ws + WS_SCS); \
    B.rc = (const float*)(ws + WS_ROPE); B.rs = B.rc + (T + ST) * 32; B.out = outp_;
#define IN(k) (args.ph_lo <= (k) && (k) < args.ph_hi)
#define GRIDBAR() do { XcdBarrier b_; b_.bar = (unsigned*)(args.ws + WS_CTL) + CW_BAR; b_.x = xb_xcc_id(); b_.st = (volatile LAS unsigned*)(lds + MISC_OFF) + 8; xcd_barrier(b_); } while (0)
#define SEAM(k) do { if (IN(k) && IN((k) + 1)) GRIDBAR(); } while (0)

    REPS(9) if (PH_ON(9) && IN(0)) { MKBUFS();
        LAS float* scr = (LAS float*)(lds + wave * 16384);
#define WCONV_ITEM(l_, r_in, scr_) do { const int wl_ = (l_); int r = (r_in); unsigned char* wb = ws + WS_W + (size_t)wl_ * W_LSTRIDE; \
            if (r < I_IN) { transpose_item<true>(ARGP(9) + (size_t)wl_ * DM * DIN, DM, DIN, (bf16_t*)(wb + WO_IN), scr_, r, lane, ARGP(8) + wl_ * DM); break; } r -= I_IN; \
            if (r < I_C) { transpose_item<false>(ARGP(14) + (size_t)wl_ * DCONV * DM, DCONV, DM, (bf16_t*)(wb + WO_C), scr_, r, lane, nullptr, DM, 0); break; } r -= I_C; \
            if (r < I_A) { transpose_item<false>(ARGP(15) + (size_t)wl_ * DATT * DM, DATT, DM, (bf16_t*)(wb + WO_C), scr_, r, lane, nullptr, DM, DCONV); break; } r -= I_A; \
            if (r < I_O) { transpose_item<false>(ARGP(19) + (size_t)wl_ * DM * DM, DM, DM, (bf16_t*)(wb + WO_O), scr_, r, lane); break; } r -= I_O; \
            if (r < I_1) { transpose_item<false>(ARGP(21) + (size_t)wl_ * DM * DFF, DM, DFF, (bf16_t*)(wb + WO_1), scr_, r, lane, ARGP(20) + wl_ * DM); break; } r -= I_1; \
            transpose_item<false>(ARGP(22) + (size_t)wl_ * DFF * DM, DFF, DM, (bf16_t*)(wb + WO_2), scr_, r, lane); } while (0)
#define WEFF_ITEM(l_, j_) do { const int wl_ = (l_), j = (j_); const int c0 = 4 * lane, g = c0 >> 6, cl = c0 & 63; \
            const float* pw = ARGP(16) + (((size_t)wl_ * 4 + g) * 64 + cl) * 64; const float* ps = ARGP(17) + wl_ * DPOOL + 64 * g; const float* wo = ARGP(18) + ((size_t)wl_ * DPOOL + 64 * g) * DM + j; \
            float a0 = 0.f, a1 = 0.f, a2 = 0.f, a3 = 0.f; \
            _Pragma("unroll 16") for (int d = 0; d < 64; ++d) { const float f = ps[d] * wo[(size_t)d * DM]; a0 += pw[d] * f; a1 += pw[64 + d] * f; a2 += pw[128 + d] * f; a3 += pw[192 + d] * f; } \
            v2u w; w.x = pk_bf16(a0, a1); w.y = pk_bf16(a2, a3); \
            *(v2u*)((bf16_t*)(ws + WS_W + (size_t)wl_ * W_LSTRIDE + WO_C) + (size_t)j * DM + (DCONV + DATT) + c0) = w; } while (0)
        for (int it = gw; it < I_IN; it += NGW) WCONV_ITEM(0, it, scr);
        for (int it = gw; it < DEPTH * 184; it += NGW) { const int l = it / 184, r = 7 * 256 + 72 + it % 184; bf16_t* p = (bf16_t*)(ws + WS_W + (size_t)l * W_LSTRIDE + WO_IN) + (size_t)r * DM;
            *((v4u*)p + lane) = (v4u){0u, 0u, 0u, 0u}; *((v4u*)p + 64 + lane) = (v4u){0u, 0u, 0u, 0u}; }
        {
            const double invr = exp(-(double)(tid_ & 31) / 32.0 * log(10000.0)) * 0.15915494309189535;
            for (int i = (vcu * NTHR + tid_); i < (T + ST) * 32; i += G * NTHR) { const int p = i >> 5; const double pos = p < T ? (double)p : (double)(PAST + p - T);
                const double tr = pos * invr; const float fr = (float)(tr - rint(tr)); ((float*)B.rc)[i] = __builtin_amdgcn_cosf(fr); ((float*)B.rs)[i] = __builtin_amdgcn_sinf(fr); } }
        for (int m = gw; m < M; m += 2 * NGW) { const int m2 = m + NGW; const bool has2 = m2 < M, sa_ = m >= MP, sb_ = m2 >= MP;
            prep_row2(sa_ ? ARGP(1) + (size_t)(m - MP) * DM : ARGP(0) + (size_t)m * DM, B.H + (size_t)m * DM, sa_ ? (float*)(ws + WS_SSQBS) + (size_t)(m - MP) * 64 : (float*)(ws + WS_SSQB) + (size_t)m * 16, sa_ ? 64 : 16,
                      sb_ ? ARGP(1) + (size_t)(m2 - MP) * DM : ARGP(0) + (size_t)m2 * DM, B.H + (size_t)m2 * DM, sb_ ? (float*)(ws + WS_SSQBS) + (size_t)(m2 - MP) * 64 : (float*)(ws + WS_SSQB) + (size_t)m2 * 16, sb_ ? 64 : 16, has2, lane); }
    }
    SEAM(0);

    for (int l = 0; l < DEPTH; ++l) {
        const int pb = 1 + 9 * l;
#define MKW() unsigned char* wb = ws + WS_W + (size_t)l * W_LSTRIDE; \
        const bf16_t* Win_t = (const bf16_t*)(wb + WO_IN); const bf16_t* Wc_t = (const bf16_t*)(wb + WO_C); const bf16_t* Wa_t = (const bf16_t*)(wb + WO_A); const bf16_t* Wp_t = (const bf16_t*)(wb + WO_P); \
        const bf16_t* Wo_t = (const bf16_t*)(wb + WO_O); const bf16_t* W1_t = (const bf16_t*)(wb + WO_1); const bf16_t* W2_t = (const bf16_t*)(wb + WO_2); (void)Win_t; (void)Wc_t; (void)Wa_t; (void)Wp_t; (void)Wo_t; (void)W1_t; (void)W2_t;

        REPS(0) if (PH_ON(0) && IN(pb + 0)) { MKBUFS(); MKW();
            pg8::Gemm g{B.H, Win_t, M, NIN, DM}; pg8::StaticOrder S; S.init(M, NIN, G, bx);
            LAS float* rst = (LAS float*)(lds + RST_OFF);
            { int pms[8];
#pragma unroll
                for (int i = 0; i < 8; ++i) { pg8::Unit uu; pms[i] = S.next(i, uu) ? uu.pm : -1; }
                float rv[8]; const int r_ = tid_ & 255;
#pragma unroll
                for (int i = 0; i < 8; ++i) rv[i] = pms[i] >= 0 ? row_ms_inv(ws, WS_SSQB, WS_SSQBS, (unsigned)(pms[i] * 256 + r_)) : 0.f;
#pragma unroll
                for (int i = 0; i < 8; ++i) if (tid_ < 256) rst[i * 256 + r_] = sqrtf(rv[i]); }
            __syncthreads();
#ifdef INPROJ_NULL_REP
            if (rep_ > 0) { EpiNull EN{(float*)(ws + WS_TMP + 200 * MiB)}; pg8::gemm_phase<EpiNull, pg8::StaticOrder, true, true>(lds, g, S, EN); } else
#endif
            { EpiInproj E{ws, (unsigned char*)outp_, l, rst};
            pg8::gemm_phase<EpiInproj, pg8::StaticOrder, true, true>(lds, g, S, E); }
            if (rep_ == 0) { pg8::Unit uu; const int nfull = (M / 256) * (NIN / 256) - (G > 0 ? ((M / 256) * (NIN / 256) / G) * G : 0);
                if (!S.next(((M / 256) * (NIN / 256)) / G, uu)) { const int nlight = G - nfull; LAS float* scr2 = (LAS float*)(lds + wave * 16384);
                    const int nown = I_L - I_IN, ntail = nown + (l + 1 < DEPTH ? I_IN : 0);
                    for (int it = (bx - nfull) * NWAVES + wave; it < ntail; it += nlight * NWAVES) { if (it < nown) WCONV_ITEM(l, I_IN + it, scr2); else WCONV_ITEM(l + 1, it - nown, scr2); }
                    for (int it = (bx - nfull) * NWAVES + wave; it < DM; it += nlight * NWAVES) WEFF_ITEM(l, it); } }
        }
        SEAM(pb + 0);
#ifdef EXTRA_BARS
        for (int eb = 0; eb < EXTRA_BARS; ++eb) GRIDBAR();
#endif
        REPS(1) if (PH_ON(1) && IN(pb + 1)) { MKBUFS();
            P2Args P{ARGP(5), ARGP(6), ARGP(10), ARGP(11), ARGP(12), ARGP(13), ARGP(4), (const int*)ARGP(7)};
            LAS float* wl = (LAS float*)(lds + 40960);
            for (int i = tid_; i < 48 * DCONV / 4; i += NTHR) { const int j = i / (DCONV / 4) - 8; ((LAS f32x4*)wl)[i] = (j >= 0 && j < CONVW) ? ((const f32x4*)(P.conv_w + (size_t)l * CONVW * DCONV))[i - 8 * (DCONV / 4)] : (f32x4){0.f, 0.f, 0.f, 0.f}; }
            __syncthreads();
#ifndef P2_REP_MODE
#define P2_REP_MODE 0
#endif
#ifndef P2_UNIT_ABL
#define P2_UNIT_ABL 0
#endif
            const int p2m = rep_ > 0 ? P2_REP_MODE : 0;
            {
                volatile LAS unsigned* q2 = MISC + 24 + l + 2 * rep_;
                const int vS = vcu, vC = (vcu + G - G / 3) % G, vT = (vcu + G - 2 * (G / 3)) % G;
                const int nS = (p2m == 0 || p2m == 1) ? (SB * NPAGES + SB - vS + G - 1) / G : 0, nC = (p2m == 0 || p2m == 2) ? (MP / 8 + SB - vC + G - 1) / G : 0, nT = (p2m == 0 || p2m == 2) ? (NB * 45 + SB * 45 - vT + G - 1) / G : 0;
                for (;;) { unsigned it = 0; if (lane == 0) it = __hip_atomic_fetch_add((LAS unsigned*)q2, 1u, __ATOMIC_RELAXED, __HIP_MEMORY_SCOPE_WORKGROUP); it = __builtin_amdgcn_readfirstlane(it);
                    int j = (int)it; if (j >= nS + 2 * nC + nT) break;
                    { const int ng = (nS >> 1) < nC ? (nS >> 1) : nC;
                        if (j < 3 * ng) { const int gq = j / 3, gr = j - 3 * gq;
                            if (gr < 2) scores_sample_task(B, P, l, vS + G * (2 * gq + gr), lane, lds + wave * (32 * KI_LD)); else conv_task(B, P, l, vC + G * gq, lane, wl);
                            continue; }
                        j -= 3 * ng;
                        if (j < nS - 2 * ng) { scores_sample_task(B, P, l, vS + G * (2 * ng + j), lane, lds + wave * (32 * KI_LD)); continue; } j -= nS - 2 * ng;
                        if (j < nC - ng) { conv_task(B, P, l, vC + G * (ng + j), lane, wl); continue; } j -= nC - ng; }
                    if (j < nC) { pool_task(B, P, l, vC + G * j, lane); continue; } j -= nC;
                    states_task(B, P, l, vT + G * j, lane); }
            }
            __syncthreads();
            int tid2 = threadIdx.x; asm volatile("" : "+v"(tid2));
            if (p2m == 0 || p2m == 3) for (int u = bx; u < 2 * (T / 32); u += G) { const int b = u < T / 32 ? 0 : 1, qb = u < T / 32 ? u : 2 * (T / 32) - 1 - u; scores_prompt_unit(B, lds, b, qb, tid2, rep_ > 0 ? P2_UNIT_ABL : 0); }
        }
        SEAM(pb + 1);
        REPS(2) if (PH_ON(2) && IN(pb + 2)) { MKBUFS();
            P3Args P3{ARGP(2), ARGP(3), (const int*)ARGP(7)};
            LAS unsigned char* wl = lds + wave * WL_BYTES;
            volatile LAS unsigned* qhead = MISC + 16 + l + 2 * rep_;
            const int nprompt = (MP - vcu + G - 1) / G; const int nconv = 0;
            for (;;) { unsigned it = 0; if (lane == 0) it = __hip_atomic_fetch_add((LAS unsigned*)qhead, 1u, __ATOMIC_RELAXED, __HIP_MEMORY_SCOPE_WORKGROUP); it = __builtin_amdgcn_readfirstlane(it);
                if ((int)it > nprompt + nconv) break;
                if ((int)it > nprompt) { WCONV_ITEM(1, vcu + G * ((int)it - nprompt - 1), (LAS float*)wl); continue; }
#ifdef P3_REP_SAMPLE_ONLY
                if (rep_ > 0 && it > 0) break;
                if (it == 0) { if (vcu < MS) select_attend_task<true>(B, P3, l, MP + vcu, lane, wl); }
#else
                if (it == 0) { if (vcu < MS && rep_ == 0) select_attend_task<true>(B, P3, l, MP + vcu, lane, wl); }
#endif
                else {
#ifdef P3_REP_MODE
                    if (rep_ > 0) select_attend_task<false, P3_REP_MODE>(B, P3, l, vcu + G * ((int)it - 1), lane, wl); else
#endif
                    select_attend_task<false>(B, P3, l, vcu + G * ((int)it - 1), lane, wl); } }
        }
        SEAM(pb + 2);
        REPS(3) if (PH_ON(3) && IN(pb + 3)) { MKBUFS(); MKW();
            const bf16_t* Wcat = Wc_t;
            for (int tk = wave * G + vcu; tk < 16 * (DM / 16); tk += NGW) { const int mt = tk & 15, nt = tk >> 4;
                const bf16_t* As = B.CA + (size_t)MP * DM;
                const f32x4 ya = sg_tile(As, DM, Wcat, DCONV, mt, nt, lane, DM), yb = sg_tile(As + DCONV, DM, Wcat + DCONV, DATT, mt, nt, lane, DM),
                            yc = sg_tile(As + DCONV + DATT, DM, Wcat + DCONV + DATT, DPOOL, mt, nt, lane, DM);
                const size_t row = (size_t)MP + 16 * mt + (lane & 15); const int col = 16 * nt + 4 * (lane >> 4); const _Float16* gp = B.G + row * 3072 + col;
                const f16x4 ga = *(const f16x4*)gp, gb = *(const f16x4*)(gp + 1024), gc = *(const f16x4*)(gp + 2048); float r[4];
#pragma unroll
                for (int e = 0; e < 4; ++e) r[e] = (float)ga[e] * ya[e] + (float)gb[e] * yb[e] + (float)gc[e] * yc[e];
                v2u w; w.x = pk_bf16(r[0], r[1]); w.y = pk_bf16(r[2], r[3]); *(v2u*)(B.MB + row * DM + col) = w; }
            pg8::Gemm g{B.CA, Wcat, MP, DM, DM}; pg8::StaticOrder S; S.init(MP, DM, G, bx); EpiGate E{B.MB, B.G};
            pg8::gemm_phase<EpiGate, pg8::StaticOrder, true, true>(lds, g, S, E);
        }
        SEAM(pb + 3);
        REPS(4) if (PH_ON(4) && IN(pb + 4)) { MKBUFS(); MKW();
            float* ssq_p = (float*)(ws + WS_SSQA); float* ssq_s = (float*)(ws + WS_SSQAS);
            for (int tk = (wave & 3) * G + vcu; tk < 16 * (DM / 16); tk += 4 * G) { const int mt = tk & 15, nt = tk >> 4;
                f32x4 y = sg_tile(B.MB + (size_t)MP * DM + (wave >> 2) * (DM / 2), DM, Wo_t + (wave >> 2) * (DM / 2), DM / 2, mt, nt, lane, DM);
                LAS f32x4* slot = (LAS f32x4*)(lds + RST_OFF) + (wave & 3) * 64 + lane;
                if (wave >= 4) *slot = y;
                __syncthreads();
                if (wave >= 4) continue;
                { const f32x4 y2 = *slot; y.x += y2.x; y.y += y2.y; y.z += y2.z; y.w += y2.w; }
                const size_t ro = ((size_t)MP + 16 * mt + (lane & 15)) * DM + 16 * nt + 4 * (lane >> 4);
                v2u* p = (v2u*)(B.H + ro); const v2u h = *p; f32x4 o; o.x = __uint_as_float(h.x << 16) + y.x; o.y = __uint_as_float(h.x & 0xffff0000u) + y.y; o.z = __uint_as_float(h.y << 16) + y.z; o.w = __uint_as_float(h.y & 0xffff0000u) + y.w;
                v2u hw; hw.x = pk_bf16(o.x, o.y); hw.y = pk_bf16(o.z, o.w); *p = hw;
                float ss = (o.x * o.x + o.y * o.y) + (o.z * o.z + o.w * o.w); ss += __shfl_xor(ss, 16); ss += __shfl_xor(ss, 32);
                if ((lane >> 4) == 0) ssq_s[(size_t)(16 * mt + (lane & 15)) * 64 + nt] = ss; }
            pg8::Gemm g{B.MB, Wo_t, MP, DM, DM}; pg8::StaticOrder S; S.init(MP, DM, G, bx); EpiResid E{B.H, ssq_p};
            pg8::gemm_phase<EpiResid, pg8::StaticOrder, true, true>(lds, g, S, E);
        }
        if (IN(pb + 4) && IN(pb + 6)) GRIDBAR();
        REPS(6) if (PH_ON(6) && IN(pb + 6)) { MKBUFS(); MKW();
            for (int tk = wave * G + vcu; tk < 16 * (DFF / 16); tk += NGW) { const int mt = tk & 15, nt = tk >> 4;
                const f32x4 y = sg_tile(B.H + (size_t)MP * DM, DM, W1_t, DM, mt, nt, lane); float r[4];
                const float r2 = row_ms_inv(ws, WS_SSQA, WS_SSQAS, (unsigned)(MP + 16 * mt + (lane & 15)));
#pragma unroll
                for (int e = 0; e < 4; ++e) { const float x = fmaxf(y[e], 0.f); r[e] = x * x * r2; }
                v2u w; w.x = pk_bf16(r[0], r[1]); w.y = pk_bf16(r[2], r[3]); *(v2u*)(B.R + ((size_t)MP + 16 * mt + (lane & 15)) * DFF + 16 * nt + 4 * (lane >> 4)) = w; }
            pg8::Gemm g{B.H, W1_t, MP, DFF, DM}; pg8::StaticOrder S; S.init(MP, DFF, G, bx);
            LAS float* rst = (LAS float*)(lds + RST_OFF);
            { int pms[4];
#pragma unroll
                for (int i = 0; i < 4; ++i) { pg8::Unit uu; pms[i] = S.next(i, uu) ? uu.pm : -1; }
                float rv[4]; const int r_ = tid_ & 255;
#pragma unroll
                for (int i = 0; i < 4; ++i) rv[i] = pms[i] >= 0 ? row_ms_inv(ws, WS_SSQA, WS_SSQAS, (unsigned)(pms[i] * 256 + r_)) : 0.f;
#pragma unroll
                for (int i = 0; i < 4; ++i) if (tid_ < 256) rst[i * 256 + r_] = rv[i]; }
            __syncthreads();
            EpiRelu2 E{B.R, DFF, rst};
            pg8::gemm_phase<EpiRelu2, pg8::StaticOrder, true, true>(lds, g, S, E);
        }
        SEAM(pb + 6);
        REPS(7) if (PH_ON(7) && IN(pb + 7)) { MKBUFS(); MKW();
            float* ssq_p = (float*)(ws + WS_SSQB); float* ssq_s = (float*)(ws + WS_SSQBS);
            for (int tk = (wave & 3) * G + vcu; tk < 16 * (DM / 16); tk += 4 * G) { const int mt = tk & 15, nt = tk >> 4;
                f32x4 y = sg_tile(B.R + (size_t)MP * DFF + (wave >> 2) * (DFF / 2), DFF, W2_t + (wave >> 2) * (DFF / 2), DFF / 2, mt, nt, lane, DFF);
                LAS f32x4* slot = (LAS f32x4*)(lds + RST_OFF) + (wave & 3) * 64 + lane;
                if (wave >= 4) *slot = y;
                __syncthreads();
                if (wave >= 4) continue;
                { const f32x4 y2 = *slot; y.x += y2.x; y.y += y2.y; y.z += y2.z; y.w += y2.w; }
                const size_t ro = ((size_t)MP + 16 * mt + (lane & 15)) * DM + 16 * nt + 4 * (lane >> 4);
                v2u* p = (v2u*)(B.H + ro); const v2u h = *p; f32x4 o; o.x = __uint_as_float(h.x << 16) + y.x; o.y = __uint_as_float(h.x & 0xffff0000u) + y.y; o.z = __uint_as_float(h.y << 16) + y.z; o.w = __uint_as_float(h.y & 0xffff0000u) + y.w;
                v2u hw; hw.x = pk_bf16(o.x, o.y); hw.y = pk_bf16(o.z, o.w); *p = hw;
                float ss = (o.x * o.x + o.y * o.y) + (o.z * o.z + o.w * o.w); ss += __shfl_xor(ss, 16); ss += __shfl_xor(ss, 32);
                if ((lane >> 4) == 0) ssq_s[(size_t)(16 * mt + (lane & 15)) * 64 + nt] = ss; }
            pg8::Gemm g{B.R, W2_t, MP, DM, DFF}; pg8::StaticOrder S; S.init(MP, DM, G, bx); EpiResid E{B.H, ssq_p};
            pg8::gemm_phase<EpiResid, pg8::StaticOrder, true, true>(lds, g, S, E);
        }
        if (l + 1 == DEPTH) { SEAM(pb + 7);
            REPS(8) if (PH_ON(8) && IN(pb + 8)) { MKBUFS(); MKW();
                for (int m = gw; m < M; m += 2 * NGW) { const int m2 = m + NGW; const bool has2 = m2 < M;
                    rms_row_bf2(B.H + (size_t)m * DM, B.out + (m < MP ? O_YP + (size_t)m * DM : O_YS + (size_t)(m - MP) * DM),
                                B.H + (size_t)m2 * DM, B.out + (m2 < MP ? O_YP + (size_t)m2 * DM : O_YS + (size_t)(m2 - MP) * DM), has2, ARGP(23), lane); } }
        } else { if (IN(pb + 7) && IN(pb + 9)) GRIDBAR(); }
    }
#undef IN
#undef SEAM
}
extern "C" void kernel_launch(void* const* d_in, const int* in_sizes, int n_in, void* d_out, int out_size, void* d_ws, size_t ws_size, hipStream_t stream) {
    if (n_in != 24 || (size_t)out_size != O_END || ws_size < WS_END) { fprintf(stderr, "kernel_launch: unexpected sizes n_in %d out %d ws %zu\n", n_in, out_size, ws_size); return; }
    static int grid = 0;
    if (grid == 0) {
        int dev = 0, cus = 0, per_cu = 0;
        if (hipGetDevice(&dev) != hipSuccess || hipDeviceGetAttribute(&cus, hipDeviceAttributeMultiprocessorCount, dev) != hipSuccess) { fprintf(stderr, "kernel_launch: device query failed\n"); grid = -1; return; }
        if (hipFuncSetAttribute((const void*)fwd, hipFuncAttributeMaxDynamicSharedMemorySize, LDS_BYTES) != hipSuccess) { fprintf(stderr, "kernel_launch: hipFuncSetAttribute failed\n"); grid = -1; return; }
        if (hipOccupancyMaxActiveBlocksPerMultiprocessor(&per_cu, (const void*)fwd, NTHR, LDS_BYTES) != hipSuccess || per_cu < 1) { fprintf(stderr, "kernel_launch: occupancy query says %d\n", per_cu); }
        (void)hipGetLastError();
        grid = cus;
    }
    if (grid < 0) return;
    unsigned char* ws = (unsigned char*)d_ws;
    Args a{}; for (int i = 0; i < 24; ++i) a.in[i] = (const float*)d_in[i]; a.out = (float*)d_out; a.ws = ws; a.ph_lo = 0; a.ph_hi = NPHASE;
    (void)hipMemsetAsync(ws + WS_CTL, 0, CTL_ZERO_BYTES, stream);
    hipLaunchKernelGGL(fwd, dim3(grid), dim3(NTHR), LDS_BYTES, stream, a);
}
```
